# Optimizing an MI355X kernel written in HIP

```python
import jax, jax.numpy as jnp
from jax import lax
import numpy as np

D_MODEL = 2048
BATCH = 4
SEQ = 4096
DEPTH = 1

N_ATTN_HEADS = 8
ATTN_HEAD_DIM = 128
ATTN_WIDTH = N_ATTN_HEADS * ATTN_HEAD_DIM
Q_BLOCK = 128
LRU_WIDTH = D_MODEL // 2
LRU_BLOCKS = 8
LRU_BLOCK = LRU_WIDTH // LRU_BLOCKS
CONV_WIDTH = 4
LRU_C = 8.0
D_FF = ((8 * D_MODEL // 3 + 255) // 256) * 256
N_MOD = 9
EPS = 1e-6

IN_WIDTHS = (ATTN_WIDTH, ATTN_WIDTH, ATTN_WIDTH, LRU_WIDTH, LRU_WIDTH, D_MODEL, D_MODEL)
IN_TOTAL = sum(IN_WIDTHS)
IN_SPLITS = tuple(int(s) for s in np.cumsum(IN_WIDTHS)[:-1])

kernel_name = "hybrid_stickbreak_rglru_macaron_adaln"


def rms_norm(x, g):
    xf = x.astype(jnp.float32)
    y = xf * lax.rsqrt(jnp.mean(xf * xf, axis=-1, keepdims=True) + EPS)
    return (y * g.astype(jnp.float32)).astype(x.dtype)


def modulate(x, shift, scale):
    return x * (1.0 + scale[:, None, :]) + shift[:, None, :]


def swiglu(x, w_in, w_out):
    gate, up = jnp.split(x @ w_in, 2, axis=-1)
    return (jax.nn.silu(gate) * up) @ w_out


def causal_depthwise_conv(x, w, b):
    y = lax.conv_general_dilated(
        x, w[:, None, :].astype(x.dtype), window_strides=(1,),
        padding=[(CONV_WIDTH - 1, 0)],
        dimension_numbers=("NWC", "WIO", "NWC"),
        feature_group_count=x.shape[-1])
    return y + b


def stick_breaking_attention(q, k, v):
    S = q.shape[2]
    scale = ATTN_HEAD_DIM ** -0.5
    outs = []
    for blk in range(S // Q_BLOCK):
        q0 = blk * Q_BLOCK
        n_keys = q0 + Q_BLOCK
        qb = q[:, :, q0:n_keys]
        kb = k[:, :, :n_keys]
        vb = v[:, :, :n_keys]
        z = jnp.einsum("bhqd,bhkd->bhqk", qb, kb).astype(jnp.float32) * scale
        t_idx = q0 + jnp.arange(Q_BLOCK)[:, None]
        s_idx = jnp.arange(n_keys)[None, :]
        before = s_idx < t_idx
        log_keep = jnp.where(before, jax.nn.log_sigmoid(-z), 0.0)
        rev = lax.cumsum(log_keep, axis=3, reverse=True)
        between = jnp.concatenate([rev[..., 1:], jnp.zeros_like(rev[..., :1])], axis=-1)
        w = jnp.where(before, jnp.exp(jax.nn.log_sigmoid(z) + between), 0.0)
        outs.append(jnp.einsum("bhqk,bhkd->bhqd", w.astype(vb.dtype), vb))
    return jnp.concatenate(outs, axis=2)


def rg_lru(x, w_r, b_r, w_i, b_i, lam):
    B, S, C = x.shape
    xb = x.reshape(B, S, LRU_BLOCKS, LRU_BLOCK)
    r = jax.nn.sigmoid(jnp.einsum("bsnc,ncd->bsnd", xb, w_r).reshape(B, S, C) + b_r)
    i = jax.nn.sigmoid(jnp.einsum("bsnc,ncd->bsnd", xb, w_i).reshape(B, S, C) + b_i)
    log_a = -LRU_C * r.astype(jnp.float32) * jax.nn.softplus(-lam.astype(jnp.float32))
    a = jnp.exp(log_a)
    u = jnp.sqrt(-jnp.expm1(2.0 * log_a)) * (i * x).astype(jnp.float32)

    def combine(left, right):
        a_l, b_l = left
        a_r, b_r2 = right
        return a_l * a_r, a_r * b_l + b_r2

    _, h = lax.associative_scan(combine, (a, u), axis=1)
    return h.astype(x.dtype)


def hybrid_mixer(h, w_in, conv_w, conv_b, w_r, b_r, w_i, b_i, lam, w_br_attn, w_br_lru, w_out):
    B, S, _ = h.shape
    q, k, v, xr, gr, g_attn, g_lru = jnp.split(h @ w_in, IN_SPLITS, axis=-1)

    def heads(t):
        return t.reshape(B, S, N_ATTN_HEADS, ATTN_HEAD_DIM).transpose(0, 2, 1, 3)

    y_attn = stick_breaking_attention(heads(q), heads(k), heads(v))
    y_attn = y_attn.transpose(0, 2, 1, 3).reshape(B, S, ATTN_WIDTH)

    xr = causal_depthwise_conv(xr, conv_w, conv_b)
    y_lru = rg_lru(xr, w_r, b_r, w_i, b_i, lam) * jax.nn.gelu(gr)

    merged = (jax.nn.sigmoid(g_attn) * (y_attn @ w_br_attn)
              + jax.nn.sigmoid(g_lru) * (y_lru @ w_br_lru))
    return merged @ w_out


def setup_inputs(seed: int = 0) -> dict:
    key = jax.random.key(seed)
    ks = jax.random.split(key, 24)
    f32 = jnp.float32

    def nrm(k, shape, std):
        return jax.random.normal(k, shape, f32) * std

    u = jax.random.uniform(ks[13], (DEPTH, LRU_WIDTH), f32, 0.9, 0.999)
    a0 = u ** (1.0 / LRU_C)
    lam = jnp.log(a0) - jnp.log1p(-a0)

    return {
        "x": nrm(ks[0], (BATCH, SEQ, D_MODEL), 1.0),
        "c": nrm(ks[1], (BATCH, D_MODEL), 1.0),
        "w_ada": nrm(ks[2], (DEPTH, D_MODEL, N_MOD * D_MODEL), 0.5 * D_MODEL ** -0.5),
        "b_ada": nrm(ks[3], (DEPTH, N_MOD * D_MODEL), 0.01),
        "norm_ffn1": 1.0 + nrm(ks[4], (DEPTH, D_MODEL), 0.01),
        "w_ffn1_in": nrm(ks[5], (DEPTH, D_MODEL, 2 * D_FF), D_MODEL ** -0.5),
        "w_ffn1_out": nrm(ks[6], (DEPTH, D_FF, D_MODEL), D_FF ** -0.5),
        "norm_mix": 1.0 + nrm(ks[7], (DEPTH, D_MODEL), 0.01),
        "w_in": nrm(ks[8], (DEPTH, D_MODEL, IN_TOTAL), D_MODEL ** -0.5),
        "conv_w": nrm(ks[9], (DEPTH, CONV_WIDTH, LRU_WIDTH), CONV_WIDTH ** -0.5),
        "conv_b": nrm(ks[10], (DEPTH, LRU_WIDTH), 0.01),
        "w_rg_gate": nrm(ks[11], (DEPTH, LRU_BLOCKS, LRU_BLOCK, LRU_BLOCK), LRU_BLOCK ** -0.5),
        "b_rg_gate": nrm(ks[12], (DEPTH, LRU_WIDTH), 0.01),
        "w_in_gate": nrm(ks[14], (DEPTH, LRU_BLOCKS, LRU_BLOCK, LRU_BLOCK), LRU_BLOCK ** -0.5),
        "b_in_gate": nrm(ks[15], (DEPTH, LRU_WIDTH), 0.01),
        "lru_lambda": lam,
        "w_branch_attn": nrm(ks[16], (DEPTH, ATTN_WIDTH, D_MODEL), ATTN_WIDTH ** -0.5),
        "w_branch_lru": nrm(ks[17], (DEPTH, LRU_WIDTH, D_MODEL), LRU_WIDTH ** -0.5),
        "w_out": nrm(ks[18], (DEPTH, D_MODEL, D_MODEL), D_MODEL ** -0.5),
        "norm_ffn2": 1.0 + nrm(ks[19], (DEPTH, D_MODEL), 0.01),
        "w_ffn2_in": nrm(ks[20], (DEPTH, D_MODEL, 2 * D_FF), D_MODEL ** -0.5),
        "w_ffn2_out": nrm(ks[21], (DEPTH, D_FF, D_MODEL), D_FF ** -0.5),
        "norm_final": 1.0 + nrm(ks[22], (D_MODEL,), 0.01),
    }


def reference(x, c, w_ada, b_ada, norm_ffn1, w_ffn1_in, w_ffn1_out, norm_mix, w_in,
              conv_w, conv_b, w_rg_gate, b_rg_gate, w_in_gate, b_in_gate, lru_lambda,
              w_branch_attn, w_branch_lru, w_out, norm_ffn2, w_ffn2_in, w_ffn2_out,
              norm_final):
    h = x
    c_act = jax.nn.silu(c)
    for l in range(DEPTH):
        mod = c_act @ w_ada[l] + b_ada[l]
        sh1, sc1, g1, sh2, sc2, g2, sh3, sc3, g3 = jnp.split(mod, N_MOD, axis=-1)

        y = modulate(rms_norm(h, norm_ffn1[l]), sh1, sc1)
        h = h + 0.5 * g1[:, None, :] * swiglu(y, w_ffn1_in[l], w_ffn1_out[l])

        y = modulate(rms_norm(h, norm_mix[l]), sh2, sc2)
        h = h + g2[:, None, :] * hybrid_mixer(
            y, w_in[l], conv_w[l], conv_b[l], w_rg_gate[l], b_rg_gate[l],
            w_in_gate[l], b_in_gate[l], lru_lambda[l],
            w_branch_attn[l], w_branch_lru[l], w_out[l])

        y = modulate(rms_norm(h, norm_ffn2[l]), sh3, sc3)
        h = h + 0.5 * g3[:, None, :] * swiglu(y, w_ffn2_in[l], w_ffn2_out[l])
    return rms_norm(h, norm_final)
```

```cpp
#include <hip/hip_runtime.h>
#include <hip/hip_cooperative_groups.h>
#include <cstdio>
#include <cstdint>
namespace cg = cooperative_groups;

#define DI __device__ __forceinline__
#define LAS __attribute__((address_space(3)))

constexpr int T = 16384, D = 2048, DFF = 5632, SEQ = 4096;
constexpr int NMOD = 9 * D;
constexpr int PW = 8192;
constexpr float EPS = 1e-6f;
constexpr float LOG2E = 1.4426950408889634f;
constexpr float QSCALE = 0.08838834764831845f * 1.4426950408889634f;
constexpr int LDS_BYTES = 131072;

constexpr size_t WS_MOD   = 4096;
constexpr size_t WS_LSUM  = WS_MOD + (size_t)4 * NMOD * 4;
constexpr size_t WS_W1IN  = WS_LSUM + (size_t)256 * 1024 * 8;
constexpr size_t WS_W1OUT = WS_W1IN + (size_t)2 * DFF * D * 2;
constexpr size_t WS_W2IN  = WS_W1OUT + (size_t)D * DFF * 2;
constexpr size_t WS_W2OUT = WS_W2IN + (size_t)2 * DFF * D * 2;
constexpr size_t WS_WINM  = WS_W2OUT + (size_t)D * DFF * 2;
constexpr size_t WS_WV    = WS_WINM + (size_t)8192 * D * 2;
constexpr size_t WS_WBR   = WS_WV + (size_t)1024 * D * 2;
constexpr size_t WS_WO    = WS_WBR + (size_t)D * D * 2;
constexpr size_t WS_WG    = WS_WO + (size_t)D * D * 2;
constexpr size_t WS_Y     = WS_WG + (size_t)2 * 8 * 128 * 128 * 2;
constexpr size_t WS_P     = WS_Y + (size_t)T * D * 2;
constexpr size_t WS_VT    = WS_P + (size_t)T * PW * 2;
constexpr size_t WS_YM    = WS_VT + (size_t)1024 * T * 2;
constexpr size_t WS_END   = WS_YM + (size_t)T * D * 2;

typedef unsigned short bf16_t;
typedef short bf16x8 __attribute__((ext_vector_type(8)));
typedef float f32x4 __attribute__((ext_vector_type(4)));
typedef float f32x16 __attribute__((ext_vector_type(16)));
typedef float f32x2v __attribute__((ext_vector_type(2)));
typedef __bf16 bf16x2v __attribute__((ext_vector_type(2)));
typedef unsigned u32x4 __attribute__((ext_vector_type(4)));
typedef unsigned u32x2 __attribute__((ext_vector_type(2)));

DI unsigned pk_bf16(float lo, float hi) { f32x2v f = {lo, hi}; bf16x2v b = __builtin_convertvector(f, bf16x2v); return __builtin_bit_cast(unsigned, b); }
DI bf16_t to_bf16(float x) { return (bf16_t)(pk_bf16(x, 0.f) & 0xffffu); }
DI float bf_lo(unsigned u) { return __uint_as_float(u << 16); }
DI float bf_hi(unsigned u) { return __uint_as_float(u & 0xffff0000u); }
DI float bf_f(bf16_t h) { return __uint_as_float(((unsigned)h) << 16); }
DI float fast_exp2(float x) { return __builtin_amdgcn_exp2f(x); }
DI float fast_rcp(float x) { return __builtin_amdgcn_rcpf(x); }
DI float sigmoidf_(float x) { return fast_rcp(1.0f + fast_exp2(-x * LOG2E)); }

namespace pg8 {
#define PG8_LAS __attribute__((address_space(3)))
constexpr int BM = 256, BK = 64, HALF = 128, HTB = HALF * BK * 2, STAGE_BYTES = 8 * HTB, NXCD = 8, WGM = 8;
__host__ __device__ __forceinline__ int lds_byte(int r, int c) { const int st = (r >> 4) * 2 + (c >> 5), rr = r & 15, cc = c & 31, ob = rr * 64 + cc * 2; return st * 1024 + (ob ^ (((ob >> 9) & 1) << 5)); }
__host__ __device__ __forceinline__ void stage_rc(int b, int& R, int& C) { const int st = b / 1024, sb = b % 1024, swz = sb ^ (((sb >> 9) & 1) << 5); R = (st >> 1) * 16 + swz / 64; C = (st & 1) * 32 + (swz % 64) / 2; }
__host__ __device__ __forceinline__ int perm32(int rho) { const int n = rho >> 4, i = rho & 15; return 8 * (i >> 2) + 4 * n + (i & 3); }
struct Unit { int pm, pn; };
struct Gemm { const bf16_t* A; const bf16_t* Bt; int M, N, K; };
struct StaticOrder {
    int nM, nN, nwg, G, c, wgm;
    __host__ __device__ void init(int M, int N, int G_, int c_, int wgm_ = WGM) { nM = M / BM; nN = N / BM; nwg = nM * nN; G = G_; c = c_; wgm = wgm_; }
    __host__ __device__ bool next(int i, Unit& u) const {
        const long L = (long)i * G + c; if (L >= nwg) return false;
        int wgid = (int)L; { const int q = nwg / NXCD, r = nwg % NXCD, xcd = wgid % NXCD, off = wgid / NXCD; wgid = (xcd < r ? xcd * (q + 1) : r * (q + 1) + (xcd - r) * q) + off; }
        const int nig = wgm * nN, gid = wgid / nig, fm = gid * wgm, gsz = (nM - fm) < wgm ? (nM - fm) : wgm;
        u.pm = fm + ((wgid % nig) % gsz); u.pn = (wgid % nig) / gsz; return true;
    }
    __device__ __forceinline__ void a_ready(const Unit&) const {}
    __device__ __forceinline__ void done(const Unit&) const {}
};

struct EpiSwiGLU {
    static constexpr bool PERM = true, AFTER_DRAIN = false, MID = false;
    bf16_t* H;
    DI void mid(f32x4 (&)[2][2][4][2], const Unit&, int, int, int, int) const {}
    DI void operator()(const f32x4 (&acc)[2][2][4][2], const Unit& u, int wr, int wc, int fr, int fq) const {
        const int row0 = u.pm * BM + wr * 64 + fr, col0 = u.pn * HALF + wc * 32 + 8 * fq;
#pragma unroll
        for (int ai = 0; ai < 2; ++ai)
#pragma unroll
            for (int m = 0; m < 4; ++m) {
                float o[8];
#pragma unroll
                for (int n = 0; n < 2; ++n)
#pragma unroll
                    for (int j = 0; j < 4; ++j) { const float g = acc[ai][0][m][n][j], up = acc[ai][1][m][n][j]; o[n * 4 + j] = g * sigmoidf_(g) * up; }
                u32x4 w; w.x = pk_bf16(o[0], o[1]); w.y = pk_bf16(o[2], o[3]); w.z = pk_bf16(o[4], o[5]); w.w = pk_bf16(o[6], o[7]);
                *(u32x4*)(H + (size_t)(row0 + ai * HALF + m * 16) * DFF + col0) = w;
            }
    }
};
struct EpiResid {
    static constexpr bool PERM = false, AFTER_DRAIN = false, MID = false;
    const float* resid; float* out; const float* gmod; float coef;
    DI void mid(f32x4 (&)[2][2][4][2], const Unit&, int, int, int, int) const {}
    DI void operator()(const f32x4 (&acc)[2][2][4][2], const Unit& u, int wr, int wc, int fr, int fq) const {
        const int row0 = u.pm * BM + wr * 64 + fr, col0 = u.pn * BM + wc * 32 + 4 * fq;
        const float* gv = gmod + (size_t)(u.pm >> 4) * NMOD + col0;
        f32x4 g[2][2];
#pragma unroll
        for (int bj = 0; bj < 2; ++bj)
#pragma unroll
            for (int n = 0; n < 2; ++n) g[bj][n] = *(const f32x4*)(gv + bj * HALF + n * 16) * coef;
#pragma unroll
        for (int ai = 0; ai < 2; ++ai)
#pragma unroll
            for (int m = 0; m < 4; ++m) { const size_t off = (size_t)(row0 + ai * HALF + m * 16) * D + col0;
#pragma unroll
                for (int bj = 0; bj < 2; ++bj)
#pragma unroll
                    for (int n = 0; n < 2; ++n) { const f32x4 r = *(const f32x4*)(resid + off + bj * HALF + n * 16); *(f32x4*)(out + off + bj * HALF + n * 16) = r + g[bj][n] * acc[ai][bj][m][n]; }
                asm volatile("" ::: "memory"); }
    }
};
struct EpiP {
    static constexpr bool PERM = true, AFTER_DRAIN = false, MID = false;
    bf16_t* O; int ldc; int nscale; float scale;
    DI void mid(f32x4 (&)[2][2][4][2], const Unit&, int, int, int, int) const {}
    DI void operator()(const f32x4 (&acc)[2][2][4][2], const Unit& u, int wr, int wc, int fr, int fq) const {
        const int row0 = u.pm * BM + wr * 64 + fr, col0 = u.pn * BM + wc * 32 + 8 * fq;
        const float s = (u.pn < nscale) ? scale : 1.0f;
#pragma unroll
        for (int ai = 0; ai < 2; ++ai)
#pragma unroll
            for (int m = 0; m < 4; ++m) { bf16_t* p = O + (size_t)(row0 + ai * HALF + m * 16) * ldc + col0;
#pragma unroll
                for (int bj = 0; bj < 2; ++bj) { const f32x4 v0 = acc[ai][bj][m][0] * s, v1 = acc[ai][bj][m][1] * s;
                    u32x4 w; w.x = pk_bf16(v0[0], v0[1]); w.y = pk_bf16(v0[2], v0[3]); w.z = pk_bf16(v1[0], v1[1]); w.w = pk_bf16(v1[2], v1[3]);
                    *(u32x4*)(p + bj * HALF) = w; } }
    }
};
struct EpiBranch {
    #ifdef TEST_NOMID
    static constexpr bool PERM = true, AFTER_DRAIN = false, MID = false;
#else
    static constexpr bool PERM = true, AFTER_DRAIN = false, MID = true;
#endif
    const bf16_t* P; bf16_t* O;
    DI static float cl(float x) { return fminf(fmaxf(x, -60.f), 60.f); }
    DI void mid(f32x4 (&acc)[2][2][4][2], const Unit& u, int wr, int wc, int fr, int fq) const {
        int row0 = u.pm * BM + wr * 64 + fr, col0 = u.pn * BM + wc * 32 + 8 * fq;
        asm volatile("" : "+v"(row0), "+v"(col0));
#pragma unroll
        for (int ai = 0; ai < 2; ++ai)
#pragma unroll
            for (int m = 0; m < 4; ++m) { const bf16_t* gp = P + (size_t)(row0 + ai * HALF + m * 16) * PW + 4096 + col0;
#pragma unroll
                for (int bj = 0; bj < 2; ++bj) { const u32x4 ga = *(const u32x4*)(gp + bj * HALF), gl = *(const u32x4*)(gp + 2048 + bj * HALF);
#pragma unroll
                    for (int q = 0; q < 4; ++q) { const float a0 = cl(bf_lo(ga[q])), a1 = cl(bf_hi(ga[q])), l0 = cl(bf_lo(gl[q])), l1 = cl(bf_hi(gl[q]));
                        const float r0 = (1.0f + fast_exp2(-l0 * LOG2E)) * fast_rcp(1.0f + fast_exp2(-a0 * LOG2E));
                        const float r1 = (1.0f + fast_exp2(-l1 * LOG2E)) * fast_rcp(1.0f + fast_exp2(-a1 * LOG2E));
                        acc[ai][bj][m][q >> 1][(q & 1) * 2] *= r0; acc[ai][bj][m][q >> 1][(q & 1) * 2 + 1] *= r1; } }
                asm volatile("" ::: "memory"); }
    }
    DI void operator()(const f32x4 (&acc)[2][2][4][2], const Unit& u, int wr, int wc, int fr, int fq) const {
        const int row0 = u.pm * BM + wr * 64 + fr, col0 = u.pn * BM + wc * 32 + 8 * fq;
#pragma unroll
        for (int ai = 0; ai < 2; ++ai)
#pragma unroll
            for (int m = 0; m < 4; ++m) { const size_t r = (size_t)(row0 + ai * HALF + m * 16); const bf16_t* gp = P + r * PW + 6144 + col0;
#pragma unroll
                for (int bj = 0; bj < 2; ++bj) { const u32x4 gl = *(const u32x4*)(gp + bj * HALF); float o[8];
#pragma unroll
                    for (int q = 0; q < 4; ++q) { const float l0 = cl(bf_lo(gl[q])), l1 = cl(bf_hi(gl[q]));
                        o[q * 2] = acc[ai][bj][m][q >> 1][(q & 1) * 2] * fast_rcp(1.0f + fast_exp2(-l0 * LOG2E));
                        o[q * 2 + 1] = acc[ai][bj][m][q >> 1][(q & 1) * 2 + 1] * fast_rcp(1.0f + fast_exp2(-l1 * LOG2E)); }
                    u32x4 w; w.x = pk_bf16(o[0], o[1]); w.y = pk_bf16(o[2], o[3]); w.z = pk_bf16(o[4], o[5]); w.w = pk_bf16(o[6], o[7]);
                    *(u32x4*)(O + r * D + col0 + bj * HALF) = w; }
                asm volatile("" ::: "memory"); }
    }
};

template <class Epi, class Sched, bool ALIGN_EPI = false, bool SP2 = false>
__device__ __forceinline__ void gemm_phase(PG8_LAS unsigned char* lds, const Gemm g, const Sched& S, const Epi& E) {
    const int tid = threadIdx.x, wid = __builtin_amdgcn_readfirstlane(tid >> 6), lane = tid & 63, wr = wid >> 2, wc = wid & 3, fr = lane & 15, fq = lane >> 4;
    const int K = g.K, nt = K / BK;
    unsigned voffA[2], voffB[2];
#pragma unroll
    for (int i = 0; i < 2; ++i) { int R, C; stage_rc(tid * 16 + i * 8192, R, C); const int Rb = Epi::PERM ? ((R & ~31) + perm32(R & 31)) : R;
        voffA[i] = (unsigned)(R * K + C) * 2u; voffB[i] = (unsigned)(Rb * K + C) * 2u; }
    const size_t kstep = (size_t)(BK * 2);
    const size_t hstep = (size_t)HALF * K * 2;
    const size_t tstep = 2 * hstep;
    const unsigned ldsw = (unsigned)wid * 1024u;
    const int aoff = lds_byte(wr * 64 + fr, fq * 8), boff = lds_byte(wc * 32 + fr, fq * 8);
#define PG8_SA(b, h) (((b) * 2 + (h)) * HTB)
#define PG8_SB(b, h) ((4 + (b) * 2 + (h)) * HTB)
#define PG8_STAGE(bufoff, gbase, voff) do { _Pragma("unroll") for (int _i = 0; _i < 2; ++_i) \
        __builtin_amdgcn_global_load_lds((const unsigned*)((const char*)(gbase) + (voff)[_i]), (PG8_LAS unsigned*)(lds + (bufoff) + ldsw + _i * 8192), 16, 0, 0); } while (0)
#define PG8_LDA(dst, b, h) do { _Pragma("unroll") for (int m = 0; m < 4; ++m) _Pragma("unroll") for (int k = 0; k < 2; ++k) dst[m][k] = *(const PG8_LAS bf16x8*)(lds + PG8_SA(b, h) + aoff + m * 2048 + k * 1024); } while (0)
#define PG8_LDB(dst, b, h) do { _Pragma("unroll") for (int n = 0; n < 2; ++n) _Pragma("unroll") for (int k = 0; k < 2; ++k) dst[n][k] = *(const PG8_LAS bf16x8*)(lds + PG8_SB(b, h) + boff + n * 2048 + k * 1024); } while (0)
#define PG8_MMA(ai, bj, At, Bt) do { __builtin_amdgcn_s_setprio(1); _Pragma("unroll") for (int m = 0; m < 4; ++m) _Pragma("unroll") for (int n = 0; n < 2; ++n) _Pragma("unroll") for (int k = 0; k < 2; ++k) \
        acc[ai][bj][m][n] = __builtin_amdgcn_mfma_f32_16x16x32_bf16(Bt[n][k], At[m][k], acc[ai][bj][m][n], 0, 0, 0); __builtin_amdgcn_s_setprio(0); } while (0)
#define PG8_WAIT_V(n) asm volatile("s_waitcnt vmcnt(" #n ")" ::: "memory")
#define PG8_WAIT_L(n) asm volatile("s_waitcnt lgkmcnt(" #n ")" ::: "memory")
#define PG8_BAR __builtin_amdgcn_s_barrier()
#define PG8_SCHED __builtin_amdgcn_sched_barrier(0)
    Unit cur, nxt; int ui = 0;
    if (!S.next(0, cur)) return;
    f32x4 acc[2][2][4][2];
#pragma unroll
    for (int a = 0; a < 2; ++a)
#pragma unroll
        for (int b = 0; b < 2; ++b)
#pragma unroll
            for (int m = 0; m < 4; ++m)
#pragma unroll
                for (int n = 0; n < 2; ++n) acc[a][b][m][n] = (f32x4){0.f, 0.f, 0.f, 0.f};
    bf16x8 At[4][2], B0[2][2], B1[2][2];
    const char* cA = (const char*)g.A + (size_t)cur.pm * tstep; const char* cB = (const char*)g.Bt + (size_t)cur.pn * tstep;
    S.a_ready(cur);
    if constexpr (SP2) {
        PG8_STAGE(PG8_SB(0, 0), cB, voffB); PG8_STAGE(PG8_SB(0, 1), cB + hstep, voffB); PG8_STAGE(PG8_SA(0, 0), cA, voffA); PG8_STAGE(PG8_SA(0, 1), cA + hstep, voffA);
        if (wr == 1) PG8_BAR;
        PG8_WAIT_V(2); PG8_BAR;
        PG8_STAGE(PG8_SB(1, 0), cB + kstep, voffB); PG8_STAGE(PG8_SA(1, 0), cA + kstep, voffA); PG8_STAGE(PG8_SB(1, 1), cB + hstep + kstep, voffB);
        PG8_WAIT_V(6); PG8_BAR;
    } else {
        PG8_STAGE(PG8_SB(0, 0), cB, voffB); PG8_STAGE(PG8_SA(0, 0), cA, voffA); PG8_STAGE(PG8_SB(0, 1), cB + hstep, voffB); PG8_STAGE(PG8_SA(0, 1), cA + hstep, voffA);
        if (wr == 1) PG8_BAR;
        PG8_WAIT_V(4); PG8_BAR;
        PG8_STAGE(PG8_SB(1, 0), cB + kstep, voffB); PG8_STAGE(PG8_SA(1, 0), cA + kstep, voffA); PG8_STAGE(PG8_SB(1, 1), cB + hstep + kstep, voffB);
        PG8_WAIT_V(6); PG8_BAR;
    }
    for (;;) {
        const bool has_next = S.next(ui + 1, nxt);
        const char* nA = has_next ? (const char*)g.A + (size_t)nxt.pm * tstep : cA; const char* nB = has_next ? (const char*)g.Bt + (size_t)nxt.pn * tstep : cB;
        for (int t = 0; t < nt; t += 2) {
            const bool last = (t == nt - 2);
            const char* a1 = cA + (size_t)(t + 1) * kstep;
            const char* a2 = last ? nA : cA + (size_t)(t + 2) * kstep; const char* b2 = last ? nB : cB + (size_t)(t + 2) * kstep;
            const char* a3 = a2 + kstep; const char* b3 = b2 + kstep;
            if (last && has_next) S.a_ready(nxt);
            if constexpr (Epi::MID) { PG8_SCHED; if (t == nt / 2) E.mid(acc, cur, wr, wc, fr, fq); PG8_SCHED; }
            if constexpr (SP2) {
            PG8_LDB(B0, 0, 0); PG8_LDB(B1, 0, 1); PG8_SCHED; PG8_LDA(At, 0, 0); PG8_STAGE(PG8_SA(1, 1), a1 + hstep, voffA);
            PG8_WAIT_V(8); PG8_WAIT_L(0); PG8_BAR; PG8_MMA(0, 0, At, B0); PG8_MMA(0, 1, At, B1); PG8_BAR; PG8_SCHED;
            PG8_LDA(At, 0, 1); PG8_STAGE(PG8_SB(0, 0), b2, voffB); PG8_STAGE(PG8_SB(0, 1), b2 + hstep, voffB); PG8_STAGE(PG8_SA(0, 0), a2, voffA);
            PG8_WAIT_V(8); PG8_WAIT_L(0); PG8_BAR; PG8_MMA(1, 0, At, B0); PG8_MMA(1, 1, At, B1); PG8_BAR; PG8_SCHED;
            PG8_LDB(B0, 1, 0); PG8_LDB(B1, 1, 1); PG8_SCHED; PG8_LDA(At, 1, 0); PG8_STAGE(PG8_SA(0, 1), a2 + hstep, voffA);
            PG8_WAIT_V(8); PG8_WAIT_L(0); PG8_BAR; PG8_MMA(0, 0, At, B0); PG8_MMA(0, 1, At, B1); PG8_BAR; PG8_SCHED;
            PG8_LDA(At, 1, 1); PG8_STAGE(PG8_SB(1, 0), b3, voffB); PG8_STAGE(PG8_SB(1, 1), b3 + hstep, voffB); PG8_STAGE(PG8_SA(1, 0), a3, voffA);
            PG8_WAIT_V(8); PG8_WAIT_L(0); PG8_BAR; PG8_MMA(1, 0, At, B0); PG8_MMA(1, 1, At, B1); PG8_BAR; PG8_SCHED;
            } else {
            PG8_LDB(B0, 0, 0); PG8_SCHED; PG8_LDA(At, 0, 0); PG8_STAGE(PG8_SA(1, 1), a1 + hstep, voffA);
            PG8_WAIT_L(8); PG8_BAR; PG8_WAIT_L(0); PG8_MMA(0, 0, At, B0); PG8_BAR; PG8_SCHED;
            PG8_LDB(B1, 0, 1); PG8_STAGE(PG8_SB(0, 0), b2, voffB);
            PG8_BAR; PG8_WAIT_L(0); PG8_MMA(0, 1, At, B1); PG8_BAR;
            PG8_LDA(At, 0, 1); PG8_STAGE(PG8_SA(0, 0), a2, voffA);
            PG8_BAR; PG8_WAIT_L(0); PG8_MMA(1, 0, At, B0); PG8_BAR; PG8_SCHED;
            PG8_STAGE(PG8_SB(0, 1), b2 + hstep, voffB);
            PG8_WAIT_V(6); PG8_BAR; PG8_MMA(1, 1, At, B1); PG8_BAR;
            PG8_LDB(B0, 1, 0); PG8_SCHED; PG8_LDA(At, 1, 0); PG8_STAGE(PG8_SA(0, 1), a2 + hstep, voffA);
            PG8_WAIT_L(8); PG8_BAR; PG8_WAIT_L(0); PG8_MMA(0, 0, At, B0); PG8_BAR; PG8_SCHED;
            PG8_LDB(B1, 1, 1); PG8_STAGE(PG8_SB(1, 0), b3, voffB);
            PG8_BAR; PG8_WAIT_L(0); PG8_MMA(0, 1, At, B1); PG8_BAR;
            PG8_LDA(At, 1, 1); PG8_STAGE(PG8_SA(1, 0), a3, voffA);
            PG8_BAR; PG8_WAIT_L(0); PG8_MMA(1, 0, At, B0); PG8_BAR; PG8_SCHED;
            PG8_STAGE(PG8_SB(1, 1), b3 + hstep, voffB);
            PG8_WAIT_V(6); PG8_BAR; PG8_MMA(1, 1, At, B1); PG8_BAR;
            }
        }
        if constexpr (ALIGN_EPI) { if (wr == 0) PG8_BAR; }
        if constexpr (!Epi::AFTER_DRAIN) { E(acc, cur, wr, wc, fr, fq); S.done(cur); }
        if (!has_next) break;
#pragma unroll
        for (int a = 0; a < 2; ++a)
#pragma unroll
            for (int b = 0; b < 2; ++b)
#pragma unroll
                for (int m = 0; m < 4; ++m)
#pragma unroll
                    for (int n = 0; n < 2; ++n) acc[a][b][m][n] = (f32x4){0.f, 0.f, 0.f, 0.f};
        cur = nxt; cA = nA; cB = nB; ++ui;
        if constexpr (ALIGN_EPI) { if (wr == 1) PG8_BAR; }
    }
    PG8_WAIT_V(0);
    if constexpr (!ALIGN_EPI) { if (wr == 0) PG8_BAR; }
    PG8_BAR;
    if constexpr (Epi::AFTER_DRAIN) { E.fused(acc, cur, wr, wc, fr, fq, lds, wid, lane); S.done(cur); }
#undef PG8_SA
#undef PG8_SB
#undef PG8_STAGE
#undef PG8_LDA
#undef PG8_LDB
#undef PG8_MMA
#undef PG8_WAIT_V
#undef PG8_WAIT_L
#undef PG8_BAR
#undef PG8_SCHED
}
}

struct Args { const float* in[23]; float* out; unsigned char* ws; int ph_lo, ph_hi; };
enum { I_X = 0, I_C, I_WADA, I_BADA, I_N1, I_W1IN, I_W1OUT, I_NMIX, I_WIN, I_CONVW, I_CONVB, I_WRG, I_BRG, I_WIG, I_BIG, I_LAM, I_WBA, I_WBL, I_WOUT, I_N2, I_W2IN, I_W2OUT, I_NF };

DI void conv_tile(LAS float* buf, const float* src, int lds_, bf16_t* dst, int ldd) {
    const int tid = threadIdx.x;
    float4 v[8];
#pragma unroll
    for (int i = 0; i < 8; ++i) { const int k = (tid >> 4) + 32 * i, cgp = tid & 15; v[i] = *(const float4*)(src + (size_t)k * lds_ + cgp * 4); }
#pragma unroll
    for (int i = 0; i < 8; ++i) { const int k = (tid >> 4) + 32 * i, cgp = tid & 15; LAS float* p = buf + k * 65 + cgp * 4; p[0] = v[i].x; p[1] = v[i].y; p[2] = v[i].z; p[3] = v[i].w; }
    __syncthreads();
#pragma unroll
    for (int i = 0; i < 4; ++i) { const int q = tid + 512 * i, g = q >> 6, kg = (g & 3) * 8 + (q & 7), n = (g >> 2) * 8 + ((q >> 3) & 7); float f[8];
#pragma unroll
        for (int j = 0; j < 8; ++j) f[j] = buf[(kg * 8 + j) * 65 + n];
        u32x4 o; o.x = pk_bf16(f[0], f[1]); o.y = pk_bf16(f[2], f[3]); o.z = pk_bf16(f[4], f[5]); o.w = pk_bf16(f[6], f[7]);
        *(u32x4*)(dst + (size_t)n * ldd + kg * 8) = o; }
    __syncthreads();
}
DI void conv_tile64(LAS float* buf, const float* src, int lds_, bf16_t* dst, int ldd) {
    const int tid = threadIdx.x;
#pragma unroll
    for (int i = 0; i < 2; ++i) { const int k = (tid >> 4) + 32 * i, cgp = tid & 15; const float4 v = *(const float4*)(src + (size_t)k * lds_ + cgp * 4);
        LAS float* p = buf + k * 65 + cgp * 4; p[0] = v.x; p[1] = v.y; p[2] = v.z; p[3] = v.w; }
    __syncthreads();
    { const int kg = tid & 7, n = tid >> 3; float f[8];
#pragma unroll
        for (int j = 0; j < 8; ++j) f[j] = buf[(kg * 8 + j) * 65 + n];
        u32x4 o; o.x = pk_bf16(f[0], f[1]); o.y = pk_bf16(f[2], f[3]); o.z = pk_bf16(f[4], f[5]); o.w = pk_bf16(f[6], f[7]);
        *(u32x4*)(dst + (size_t)n * ldd + kg * 8) = o; }
    __syncthreads();
}
DI void conv_job(LAS float* buf, int& rot, const float* src, int ldsrc, int K, int Nd, bf16_t* dst, int lddst, int koff, int map) {
    const int G = gridDim.x, KT = (map == 4) ? 64 : 256, tn_n = Nd >> 6, ntile = tn_n * (K / KT);
    for (int t = (int)((blockIdx.x + rot) % G); t < ntile; t += G) {
        const int tn = t % tn_n, tk = t / tn_n, n0 = tn * 64, k0 = tk * KT;
        if (map == 4) { conv_tile64(buf, src + (size_t)(n0 >> 7) * 16384 + (size_t)k0 * 128 + (n0 & 127), ldsrc, dst + (size_t)n0 * lddst + koff + k0, lddst); continue; }
        int c0 = n0;
        if (map == 1) { const int pn = n0 >> 8, rr = n0 & 255; c0 = rr < 128 ? 128 * pn + rr : DFF + 128 * pn + rr - 128; }
        else if (map == 2) c0 = n0 < 2048 ? n0 : n0 + 1024;
        else if (map == 3) c0 = 2048 + n0;
        conv_tile(buf, src + (size_t)k0 * ldsrc + c0, ldsrc, dst + (size_t)n0 * lddst + koff + k0, lddst);
    }
    rot = (rot + G - ntile % G) % G;
}
DI void mod_items(LAS float* lf, const float* c, const float* w_ada, const float* b_ada, float* mod) {
    const int tid = threadIdx.x;
    if (blockIdx.x >= 288) return;
    for (int i = tid; i < 8192; i += 512) { const float v = c[i]; lf[i] = v * sigmoidf_(v); }
    __syncthreads();
    LAS float* part = lf + 8192;
    for (int it = blockIdx.x; it < 288; it += gridDim.x) {
        const int col0 = it * 64, cgp = tid & 15, ks = tid >> 4;
        float acc[4][4];
#pragma unroll
        for (int b = 0; b < 4; ++b)
#pragma unroll
            for (int j = 0; j < 4; ++j) acc[b][j] = 0.f;
        const float* wp = w_ada + (size_t)(ks * 64) * NMOD + col0 + cgp * 4;
#pragma unroll 16
        for (int k = 0; k < 64; ++k) { const float4 w = *(const float4*)(wp + (size_t)k * NMOD);
#pragma unroll
            for (int b = 0; b < 4; ++b) { const float cv = lf[b * 2048 + ks * 64 + k]; acc[b][0] += cv * w.x; acc[b][1] += cv * w.y; acc[b][2] += cv * w.z; acc[b][3] += cv * w.w; } }
#pragma unroll
        for (int b = 0; b < 4; ++b)
#pragma unroll
            for (int j = 0; j < 4; ++j) part[(ks * 16 + cgp) * 16 + b * 4 + j] = acc[b][j];
        __syncthreads();
        if (tid < 256) { const int b = tid >> 6, cc = tid & 63; float s = 0.f;
            for (int k2 = 0; k2 < 32; ++k2) s += part[(k2 * 16 + (cc >> 2)) * 16 + b * 4 + (cc & 3)];
            mod[b * NMOD + col0 + cc] = s + b_ada[col0 + cc]; }
        __syncthreads();
    }
}

template <bool FINAL>
DI void norm_phase(const float* src, const float* gain, const float* mod, int ish, bf16_t* dst, float* dstf) {
    const int lane = threadIdx.x & 63, wave = threadIdx.x >> 6;
    for (int r = blockIdx.x * 8 + wave; r < T; r += gridDim.x * 8) {
        const float* xp = src + (size_t)r * D; f32x4 v[8]; float ss = 0.f;
#pragma unroll
        for (int i = 0; i < 8; ++i) { v[i] = *(const f32x4*)(xp + (i * 64 + lane) * 4); ss += v[i][0] * v[i][0] + v[i][1] * v[i][1] + v[i][2] * v[i][2] + v[i][3] * v[i][3]; }
#pragma unroll
        for (int off = 32; off >= 1; off >>= 1) ss += __shfl_xor(ss, off);
        const float rstd = rsqrtf(ss * (1.0f / D) + EPS);
        const float* sh = mod + (size_t)(r >> 12) * NMOD + ish * D; const float* sc = sh + D;
#pragma unroll
        for (int i = 0; i < 8; ++i) { const int col = (i * 64 + lane) * 4; const f32x4 g = *(const f32x4*)(gain + col);
            f32x4 y = v[i] * rstd * g;
            if (FINAL) *(f32x4*)(dstf + (size_t)r * D + col) = y;
            else { const f32x4 s4 = *(const f32x4*)(sh + col), c4 = *(const f32x4*)(sc + col); y = y * (1.0f + c4) + s4;
                u32x2 w; w.x = pk_bf16(y[0], y[1]); w.y = pk_bf16(y[2], y[3]); *(u32x2*)(dst + (size_t)r * D + col) = w; } }
    }
}

constexpr int AT_KROW = 272, AT_VROW = 144, AT_KB = 64 * AT_KROW, AT_BUF = AT_KB + 128 * AT_VROW;
DI f32x16 attn_qk(const LAS unsigned char* kp, const bf16x8 (&qf)[8]) {
    f32x16 s;
#pragma unroll
    for (int i = 0; i < 16; ++i) s[i] = 0.f;
#pragma unroll
    for (int ks = 0; ks < 8; ++ks) { const bf16x8 a = *(const LAS bf16x8*)(kp + ks * 32); s = __builtin_amdgcn_mfma_f32_32x32x16_bf16(a, qf[ks], s, 0, 0, 0); }
    return s;
}
template <bool MASKED>
DI void attn_ew(const f32x16& s, float& C, int half, int ks0, int tq, bf16x8& pf0, bf16x8& pf1) {
    float kp_[16];
#pragma unroll
    for (int i = 0; i < 16; ++i) kp_[i] = fast_rcp(1.0f + fast_exp2(s[i]));
    if (MASKED) {
#pragma unroll
        for (int i = 0; i < 16; ++i) { const int key = ks0 + 16 * (i >> 3) + 8 * half + (i & 7); kp_[i] = key < tq ? kp_[i] : 1.0f; } }
    float d[16]; float PA = 1.0f, PB = 1.0f;
#pragma unroll
    for (int i = 15; i >= 8; --i) { const float nx = PB * kp_[i]; d[i] = PB - nx; PB = nx; }
#pragma unroll
    for (int i = 7; i >= 0; --i) { const float nx = PA * kp_[i]; d[i] = PA - nx; PA = nx; }
    const float PAo = __shfl_xor(PA, 32), PBo = __shfl_xor(PB, 32);
    const float stB = half ? C : C * PBo;
    const float stA = half ? C * (PB * PBo) : C * (PBo * PB) * PAo;
    C = C * ((PA * PAo) * (PB * PBo));
    u32x4 p0, p1;
    p0.x = pk_bf16(d[0] * stA, d[1] * stA); p0.y = pk_bf16(d[2] * stA, d[3] * stA); p0.z = pk_bf16(d[4] * stA, d[5] * stA); p0.w = pk_bf16(d[6] * stA, d[7] * stA);
    p1.x = pk_bf16(d[8] * stB, d[9] * stB); p1.y = pk_bf16(d[10] * stB, d[11] * stB); p1.z = pk_bf16(d[12] * stB, d[13] * stB); p1.w = pk_bf16(d[14] * stB, d[15] * stB);
    pf0 = __builtin_bit_cast(bf16x8, p0); pf1 = __builtin_bit_cast(bf16x8, p1);
}
DI void attn_pv(const LAS unsigned char* vp0, const bf16x8& pf0, const bf16x8& pf1, f32x16 (&o)[4]) {
#pragma unroll
    for (int d = 0; d < 4; ++d) { const LAS unsigned char* vp = vp0 + d * 32 * AT_VROW;
        const bf16x8 v0 = *(const LAS bf16x8*)(vp), v1 = *(const LAS bf16x8*)(vp + 32);
        o[d] = __builtin_amdgcn_mfma_f32_32x32x16_bf16(v0, pf0, o[d], 0, 0, 0);
        o[d] = __builtin_amdgcn_mfma_f32_32x32x16_bf16(v1, pf1, o[d], 0, 0, 0); }
}
DI void attn_item(LAS unsigned char* lds, const bf16_t* P, const bf16_t* VT, bf16_t* YM, int b, int h, int qb) {
    const int tid = threadIdx.x, lane = tid & 63, wave = __builtin_amdgcn_readfirstlane(tid >> 6), l32 = lane & 31, half = lane >> 5;
    const int t0 = qb * 256 + wave * 32, tq = t0 + l32;
    const size_t tokbase = (size_t)b * SEQ;
    bf16x8 qf[8];
    { const bf16_t* qp = P + (tokbase + tq) * PW + h * 128 + 8 * half;
#pragma unroll
      for (int ks = 0; ks < 8; ++ks) qf[ks] = *(const bf16x8*)(qp + 16 * ks); }
    f32x16 o[4];
#pragma unroll
    for (int d = 0; d < 4; ++d)
#pragma unroll
        for (int i = 0; i < 16; ++i) o[d][i] = 0.f;
    float C = 1.0f;
    const int ktmax = qb * 4 + 3;
    const bf16_t* Kg = P + tokbase * PW + 1024 + h * 128;
    const bf16_t* Vg = VT + (size_t)(h * 128) * T + tokbase;
    unsigned ko[2], vo[2]; int kl[2], vl[2];
#pragma unroll
    for (int i = 0; i < 2; ++i) { const int p = tid + 512 * i; const int key = p >> 4, part = p & 15; ko[i] = (unsigned)(key * PW + part * 8); kl[i] = key * AT_KROW + part * 16;
        const int d = p >> 3, pv = p & 7; vo[i] = (unsigned)(d * T + pv * 8); vl[i] = AT_KB + d * AT_VROW + pv * 16; }
    u32x4 rk[2], rv[2];
    { const bf16_t* kb = Kg + (size_t)ktmax * 64 * PW; const bf16_t* vb = Vg + ktmax * 64;
#pragma unroll
      for (int i = 0; i < 2; ++i) { rk[i] = *(const u32x4*)(kb + ko[i]); rv[i] = *(const u32x4*)(vb + vo[i]); } }
#pragma unroll
    for (int i = 0; i < 2; ++i) { *(LAS u32x4*)(lds + kl[i]) = rk[i]; *(LAS u32x4*)(lds + vl[i]) = rv[i]; }
#pragma unroll
    for (int ks = 0; ks < 8; ++ks) asm volatile("" : "+v"(qf[ks]));
    __syncthreads();
    const int pir = (l32 & 0x13) | ((l32 & 8) >> 1) | ((l32 & 4) << 1);
    const int koff = pir * AT_KROW + half * 16, voff = l32 * AT_VROW + half * 16;
    int cur = 0;
    for (int kt = ktmax; kt >= 0; --kt) {
        if (kt > 0) { const bf16_t* kb = Kg + (size_t)(kt - 1) * 64 * PW; const bf16_t* vb = Vg + (kt - 1) * 64;
#pragma unroll
            for (int i = 0; i < 2; ++i) { rk[i] = *(const u32x4*)(kb + ko[i]); rv[i] = *(const u32x4*)(vb + vo[i]); } }
        const LAS unsigned char* Kb = lds + cur * AT_BUF + koff; const LAS unsigned char* Vb = lds + cur * AT_BUF + AT_KB + voff;
        if (kt * 64 + 63 < t0) {
            bf16x8 pa0, pa1, pb0, pb1;
            const f32x16 s1 = attn_qk(Kb + 32 * AT_KROW, qf);
            const f32x16 s0 = attn_qk(Kb, qf);
            attn_ew<false>(s1, C, half, 0, 0, pa0, pa1);
            attn_pv(Vb + 64, pa0, pa1, o);
            attn_ew<false>(s0, C, half, 0, 0, pb0, pb1);
            attn_pv(Vb, pb0, pb1, o);
        } else {
#pragma unroll
            for (int sub = 1; sub >= 0; --sub) {
                const int ks0 = kt * 64 + 32 * sub;
                if (ks0 >= t0 + 31) continue;
                bf16x8 pa0, pa1;
                const f32x16 s = attn_qk(Kb + sub * 32 * AT_KROW, qf);
                attn_ew<true>(s, C, half, ks0, tq, pa0, pa1);
                attn_pv(Vb + 64 * sub, pa0, pa1, o);
            }
        }
        if (kt > 0) { LAS unsigned char* nb = lds + (cur ^ 1) * AT_BUF;
#pragma unroll
            for (int i = 0; i < 2; ++i) { *(LAS u32x4*)(nb + kl[i]) = rk[i]; *(LAS u32x4*)(nb + vl[i]) = rv[i]; } }
        __syncthreads();
        cur ^= 1;
    }
    bf16_t* yp = YM + (tokbase + tq) * D + h * 128 + 4 * half;
#pragma unroll
    for (int d = 0; d < 4; ++d)
#pragma unroll
        for (int q4 = 0; q4 < 4; ++q4) { u32x2 w; w.x = pk_bf16(o[d][q4 * 4], o[d][q4 * 4 + 1]); w.y = pk_bf16(o[d][q4 * 4 + 2], o[d][q4 * 4 + 3]); *(u32x2*)(yp + d * 32 + q4 * 8) = w; }
}

struct LruP { const bf16_t* P; const bf16_t* WG; const float* conv_w; const float* conv_b; const float* b_r; const float* b_i; const float* lam; float* lsum; bf16_t* YM; };
DI void lru_item(LAS unsigned char* lds, const LruP& q, int ck, int n, int pass) {
    const int tid = threadIdx.x, lane = tid & 63, wave = __builtin_amdgcn_readfirstlane(tid >> 6);
    const int bq = ck >> 6, lc = ck & 63; const size_t tok0 = (size_t)ck * 64;
    LAS float* xcf = (LAS float*)lds;
    LAS float* la = xcf + 64 * 129;
    LAS float* lu = la + 64 * 129;
    LAS float* sg = lu + 64 * 129;
    LAS unsigned char* xcb = (LAS unsigned char*)(sg + 2048);
    const int c = tid & 127, sgi = tid >> 7, ch = n * 128 + c;
    const int fr = lane & 15, fq = lane >> 4;
    const bf16_t* xp = q.P + (tok0 + sgi * 16) * PW + 2048 + ch;
    const bool has_prev = (lc * 64 + sgi * 16) > 0;
    bf16_t xr[19];
#pragma unroll
    for (int t = 0; t < 3; ++t) xr[t] = has_prev ? xp[(t - 3) * PW] : (bf16_t)0;
#pragma unroll
    for (int t = 0; t < 16; ++t) xr[3 + t] = xp[(size_t)t * PW];
    bf16x8 wbr[4], wbi[4];
    { const bf16_t* wrp = q.WG + (size_t)(n * 128 + wave * 16 + fr) * 128 + fq * 8; const bf16_t* wip = wrp + 8 * 128 * 128;
#pragma unroll
      for (int ks = 0; ks < 4; ++ks) { wbr[ks] = *(const bf16x8*)(wrp + ks * 32); wbi[ks] = *(const bf16x8*)(wip + ks * 32); } }
    bf16_t grv[16]; float cA = 1.0f, cH = 0.f;
    if (pass == 2) {
        const bf16_t* gp = q.P + (tok0 + sgi * 16) * PW + 3072 + ch;
#pragma unroll
        for (int t = 0; t < 16; ++t) grv[t] = gp[(size_t)t * PW];
        const float* sp = q.lsum + ((size_t)(bq * 64 + sgi * 16) * 1024 + ch) * 2;
        f32x2v sv[16];
#pragma unroll
        for (int j = 0; j < 16; ++j) sv[j] = *(const f32x2v*)(sp + (size_t)j * 2048);
#pragma unroll
        for (int j = 0; j < 16; ++j) { const bool ok = (sgi * 16 + j) < lc; const float aj = ok ? sv[j][0] : 1.0f, hj = ok ? sv[j][1] : 0.f; cH = aj * cH + hj; cA *= aj; }
    }
    const float w0 = q.conv_w[ch], w1 = q.conv_w[1024 + ch], w2 = q.conv_w[2048 + ch], w3 = q.conv_w[3072 + ch], cb = q.conv_b[ch];
    const int c2 = wave * 16 + fr, ch2 = n * 128 + c2; const float brv = q.b_r[ch2], biv = q.b_i[ch2]; const float L = -8.0f * log1pf(expf(-q.lam[ch2]));
#pragma unroll
    for (int t = 0; t < 16; ++t) { const float y = w0 * bf_f(xr[t]) + w1 * bf_f(xr[t + 1]) + w2 * bf_f(xr[t + 2]) + w3 * bf_f(xr[t + 3]) + cb;
        xcf[(sgi * 16 + t) * 129 + c] = y; *(LAS bf16_t*)(xcb + (sgi * 16 + t) * 272 + c * 2) = to_bf16(y); }
    if (pass == 2) { sg[1024 + sgi * 128 + c] = cA; sg[1536 + sgi * 128 + c] = cH; }
    __syncthreads();
    f32x4 ar[4], ai[4];
#pragma unroll
    for (int m = 0; m < 4; ++m) { ar[m] = (f32x4){0.f, 0.f, 0.f, 0.f}; ai[m] = (f32x4){0.f, 0.f, 0.f, 0.f}; }
#pragma unroll
    for (int ks = 0; ks < 4; ++ks)
#pragma unroll
        for (int m = 0; m < 4; ++m) { const bf16x8 av = *(const LAS bf16x8*)(xcb + (m * 16 + fr) * 272 + (ks * 32 + fq * 8) * 2);
            ar[m] = __builtin_amdgcn_mfma_f32_16x16x32_bf16(av, wbr[ks], ar[m], 0, 0, 0); ai[m] = __builtin_amdgcn_mfma_f32_16x16x32_bf16(av, wbi[ks], ai[m], 0, 0, 0); }
#pragma unroll
    for (int m = 0; m < 4; ++m)
#pragma unroll
        for (int j = 0; j < 4; ++j) { const int t = m * 16 + fq * 4 + j; const float r = sigmoidf_(ar[m][j] + brv), ig = sigmoidf_(ai[m][j] + biv);
            const float lga = r * L; const float av = fast_exp2(lga * LOG2E); const float x = 2.0f * lga;
            const float om = -x * (1.0f + x * 0.5f * (1.0f + x * (1.0f / 3.0f) * (1.0f + x * 0.25f * (1.0f + x * 0.2f * (1.0f + x * (1.0f / 6.0f))))));
            la[t * 129 + c2] = av; lu[t * 129 + c2] = sqrtf(om) * ig * xcf[t * 129 + c2]; }
    __syncthreads();
    float av_[16], uv_[16];
#pragma unroll
    for (int t = 0; t < 16; ++t) { av_[t] = la[(sgi * 16 + t) * 129 + c]; uv_[t] = lu[(sgi * 16 + t) * 129 + c]; }
    { float A = 1.0f, H = 0.f;
#pragma unroll
      for (int t = 0; t < 16; ++t) { H = av_[t] * H + uv_[t]; A *= av_[t]; }
      sg[sgi * 128 + c] = A; sg[512 + sgi * 128 + c] = H; }
    __syncthreads();
    if (pass == 1) {
        if (tid < 128) { float A2 = sg[c], H2 = sg[512 + c];
#pragma unroll
            for (int s2 = 1; s2 < 4; ++s2) { const float as = sg[s2 * 128 + c], hs = sg[512 + s2 * 128 + c]; H2 = as * H2 + hs; A2 *= as; }
            *(f32x2v*)(q.lsum + ((size_t)ck * 1024 + ch) * 2) = (f32x2v){A2, H2}; }
    } else {
        float hc = 0.f;
#pragma unroll
        for (int s2 = 0; s2 < 4; ++s2) hc = sg[1024 + s2 * 128 + c] * hc + sg[1536 + s2 * 128 + c];
#pragma unroll
        for (int s2 = 0; s2 < 3; ++s2) { if (s2 < sgi) hc = sg[s2 * 128 + c] * hc + sg[512 + s2 * 128 + c]; }
        bf16_t* yp = q.YM + (tok0 + sgi * 16) * D + 1024 + ch;
#pragma unroll
        for (int t = 0; t < 16; ++t) { hc = av_[t] * hc + uv_[t];
            const float g = bf_f(grv[t]); const float ge = g * sigmoidf_(1.5957691216057308f * (g + 0.044715f * g * g * g));
            yp[(size_t)t * D] = to_bf16(hc * ge); }
    }
    __syncthreads();
}

constexpr int NPH = 14;
__global__ void __launch_bounds__(512, 2) fwd(Args a) {
    extern __shared__ __attribute__((aligned(16))) unsigned char lds_raw[];
    LAS unsigned char* lds = (LAS unsigned char*)lds_raw;
    cg::grid_group grid = cg::this_grid();
    const int lo = a.ph_lo, hi = a.ph_hi, G = gridDim.x, bx = blockIdx.x;
    unsigned char* ws = a.ws;
    float* mod = (float*)(ws + WS_MOD); float* lsum = (float*)(ws + WS_LSUM);
    bf16_t* W1IN = (bf16_t*)(ws + WS_W1IN); bf16_t* W1OUT = (bf16_t*)(ws + WS_W1OUT); bf16_t* W2IN = (bf16_t*)(ws + WS_W2IN); bf16_t* W2OUT = (bf16_t*)(ws + WS_W2OUT);
    bf16_t* WINM = (bf16_t*)(ws + WS_WINM); bf16_t* WV = (bf16_t*)(ws + WS_WV); bf16_t* WBR = (bf16_t*)(ws + WS_WBR); bf16_t* WO = (bf16_t*)(ws + WS_WO); bf16_t* WG = (bf16_t*)(ws + WS_WG);
    bf16_t* Y = (bf16_t*)(ws + WS_Y); bf16_t* P = (bf16_t*)(ws + WS_P); bf16_t* Hb = P; bf16_t* VT = (bf16_t*)(ws + WS_VT); bf16_t* YM = (bf16_t*)(ws + WS_YM); bf16_t* MG = Y;
    float* out = a.out;
#ifndef PHASE_MASK
#define PHASE_MASK 0x3fff
#endif
#define IN(k) (((PHASE_MASK >> (k)) & 1) && lo <= (k) && (k) < hi)
#ifndef DUPMASK
#define DUPMASK 0
#endif
#ifndef DUPCNT
#define DUPCNT 1
#endif
#define REP(k) for (int rep_ = 0; rep_ < 1 + DUPCNT * ((DUPMASK >> (k)) & 1); ++rep_)
#define SEAM(k) do { if (IN(k) && IN((k) + 1)) grid.sync(); } while (0)
    using namespace pg8;
    if (IN(0)) REP(0) {
        mod_items((LAS float*)lds, a.in[I_C], a.in[I_WADA], a.in[I_BADA], mod);
        LAS float* buf = (LAS float*)lds; int rot = 0;
        conv_job(buf, rot, a.in[I_W1IN], 2 * DFF, D, 2 * DFF, W1IN, D, 0, 1);
        conv_job(buf, rot, a.in[I_W1OUT], D, DFF, D, W1OUT, DFF, 0, 0);
        conv_job(buf, rot, a.in[I_WIN], 9216, D, 8192, WINM, D, 0, 2);
        conv_job(buf, rot, a.in[I_WIN], 9216, D, 1024, WV, D, 0, 3);
        conv_job(buf, rot, a.in[I_WBA], D, 1024, D, WBR, D, 0, 0);
        conv_job(buf, rot, a.in[I_WBL], D, 1024, D, WBR, D, 1024, 0);
        conv_job(buf, rot, a.in[I_WOUT], D, D, D, WO, D, 0, 0);
        conv_job(buf, rot, a.in[I_WRG], 128, 128, 1024, WG, 128, 0, 4);
        conv_job(buf, rot, a.in[I_WIG], 128, 128, 1024, WG + 8 * 128 * 128, 128, 0, 4);
        conv_job(buf, rot, a.in[I_W2IN], 2 * DFF, D, 2 * DFF, W2IN, D, 0, 1);
        conv_job(buf, rot, a.in[I_W2OUT], D, DFF, D, W2OUT, DFF, 0, 0);
    }
    SEAM(0);
    if (IN(1)) REP(1) norm_phase<false>(a.in[I_X], a.in[I_N1], mod, 0, Y, nullptr);
    SEAM(1);
    if (IN(2) && ((DUPMASK >> 2) & 1)) { Gemm g{Y, W1IN, T, 2 * DFF, D}; StaticOrder S; S.init(T, 2 * DFF, G, bx); EpiSwiGLU E{Hb}; gemm_phase<EpiSwiGLU, StaticOrder, true, true>(lds, g, S, E); }
    if (IN(2)) { Gemm g{Y, W1IN, T, 2 * DFF, D}; StaticOrder S; S.init(T, 2 * DFF, G, bx); EpiSwiGLU E{Hb}; gemm_phase<EpiSwiGLU, StaticOrder, true, true>(lds, g, S, E); }
    SEAM(2);
    if (IN(3) && ((DUPMASK >> 3) & 1)) { Gemm g{Hb, W1OUT, T, D, DFF}; StaticOrder S; S.init(T, D, G, bx, 4); EpiResid E{a.in[I_X], out, mod + 2 * D, 0.5f}; gemm_phase<EpiResid, StaticOrder, true, true>(lds, g, S, E); }
    if (IN(3)) { Gemm g{Hb, W1OUT, T, D, DFF}; StaticOrder S; S.init(T, D, G, bx, 4); EpiResid E{a.in[I_X], out, mod + 2 * D, 0.5f}; gemm_phase<EpiResid, StaticOrder, true, true>(lds, g, S, E); }
    SEAM(3);
    if (IN(4)) norm_phase<false>(out, a.in[I_NMIX], mod, 3, Y, nullptr);
    SEAM(4);
    if (IN(5)) {
        { Gemm g{Y, WINM, T, 8192, D}; StaticOrder S; S.init(T, 8192, G, bx); EpiP E{P, PW, 4, QSCALE}; gemm_phase<EpiP, StaticOrder, true, true>(lds, g, S, E); }
        { Gemm g{WV, Y, 1024, T, D}; StaticOrder S; S.init(1024, T, G, bx); EpiP E{VT, T, 0, 1.0f}; gemm_phase<EpiP, StaticOrder, true, true>(lds, g, S, E); }
    }
    SEAM(5);
    LruP lq{P, WG, a.in[I_CONVW], a.in[I_CONVB], a.in[I_BRG], a.in[I_BIG], a.in[I_LAM], lsum, YM};
    if (IN(6)) {
        REP(6) for (int p0 = bx; p0 < 256; p0 += G) { const int p = (G == 256) ? ((p0 & 7) * 32 + (p0 >> 3)) : p0;
            const int bh = p >> 3, jp = p & 7; attn_item(lds, P, VT, YM, bh >> 3, bh & 7, 15 - jp); attn_item(lds, P, VT, YM, bh >> 3, bh & 7, jp); }
        REP(14) for (int it = bx; it < 2048; it += G) lru_item(lds, lq, it >> 3, it & 7, 1);
    }
    SEAM(6);
    if (IN(7)) REP(7) { for (int it = bx; it < 2048; it += G) lru_item(lds, lq, it >> 3, it & 7, 2); }
    SEAM(7);
    if (IN(8)) { Gemm g{YM, WBR, T, D, D}; StaticOrder S; S.init(T, D, G, bx, 4); EpiBranch E{P, MG}; gemm_phase<EpiBranch, StaticOrder, true, true>(lds, g, S, E); }
    SEAM(8);
    if (IN(9)) { Gemm g{MG, WO, T, D, D}; StaticOrder S; S.init(T, D, G, bx, 4); EpiResid E{out, out, mod + 5 * D, 1.0f}; gemm_phase<EpiResid, StaticOrder, true, true>(lds, g, S, E); }
    SEAM(9);
    if (IN(10)) norm_phase<false>(out, a.in[I_N2], mod, 6, Y, nullptr);
    SEAM(10);
    if (IN(11)) { Gemm g{Y, W2IN, T, 2 * DFF, D}; StaticOrder S; S.init(T, 2 * DFF, G, bx); EpiSwiGLU E{Hb}; gemm_phase<EpiSwiGLU, StaticOrder, true, true>(lds, g, S, E); }
    SEAM(11);
    if (IN(12)) { Gemm g{Hb, W2OUT, T, D, DFF}; StaticOrder S; S.init(T, D, G, bx, 4); EpiResid E{out, out, mod + 8 * D, 0.5f}; gemm_phase<EpiResid, StaticOrder, true, true>(lds, g, S, E); }
    SEAM(12);
    if (IN(13)) norm_phase<true>(out, a.in[I_NF], mod, 0, nullptr, out);
}

#ifndef ONE_LAUNCH
#define ONE_LAUNCH 1
#endif
extern "C" void kernel_launch(void* const* d_in, const int* in_sizes, int n_in, void* d_out, int out_size, void* d_ws, size_t ws_size, hipStream_t stream) {
    static int grid = 0;
    if (grid == 0) {
        if (n_in != 23 || out_size != T * D || ws_size < WS_END) { fprintf(stderr, "kernel_launch: unexpected shapes (n_in %d out %d ws %zu need %zu)\n", n_in, out_size, ws_size, (size_t)WS_END); grid = -1; return; }
        int dev = 0, cus = 0, per_cu = 0;
        hipGetDevice(&dev); hipDeviceGetAttribute(&cus, hipDeviceAttributeMultiprocessorCount, dev);
        if (hipFuncSetAttribute((const void*)fwd, hipFuncAttributeMaxDynamicSharedMemorySize, LDS_BYTES) != hipSuccess) { fprintf(stderr, "kernel_launch: hipFuncSetAttribute failed\n"); grid = -1; return; }
        if (hipOccupancyMaxActiveBlocksPerMultiprocessor(&per_cu, (const void*)fwd, 512, LDS_BYTES) != hipSuccess || per_cu < 1) { fprintf(stderr, "kernel_launch: occupancy query says %d\n", per_cu); per_cu = 1; }
        (void)hipGetLastError();
        grid = cus * per_cu;
        if (grid > 256) grid = 256;
    }
    if (grid < 0) return;
    Args a{};
    for (int i = 0; i < 23; ++i) a.in[i] = (const float*)d_in[i];
    a.out = (float*)d_out; a.ws = (unsigned char*)d_ws;
#if ONE_LAUNCH
    a.ph_lo = 0; a.ph_hi = NPH;
    void* args[] = {&a};
    hipError_t e = hipLaunchCooperativeKernel((const void*)fwd, dim3(grid), dim3(512), args, LDS_BYTES, stream);
    if (e != hipSuccess) fprintf(stderr, "cooperative launch failed: %s (grid %d)\n", hipGetErrorString(e), grid);
#else
    for (int ph = 0; ph < NPH; ++ph) { a.ph_lo = ph; a.ph_hi = ph + 1; hipLaunchKernelGGL(fwd, dim3(grid), dim3(512), LDS_BYTES, stream, a); }
#endif
}
```

```cpp
#include <hip/hip_runtime.h>
#include <hip/hip_cooperative_groups.h>
#include <cstdio>
#include <cstdint>
namespace cg = cooperative_groups;

#define DI __device__ __forceinline__
#define LAS __attribute__((address_space(3)))

constexpr int T = 16384, D = 2048, DFF = 5632, SEQ = 4096;
constexpr int NMOD = 9 * D;
constexpr int PW = 8192;
constexpr float EPS = 1e-6f;
constexpr float LOG2E = 1.4426950408889634f;
constexpr float QSCALE = 0.08838834764831845f * 1.4426950408889634f;
constexpr int LDS_MAIN = 131072;
constexpr int LDS_BYTES = LDS_MAIN + 16;

constexpr size_t WS_BAR   = 0;
constexpr size_t WS_MOD   = 16384;
constexpr size_t WS_LSUM  = WS_MOD + (size_t)4 * NMOD * 4;
constexpr size_t WS_W1IN  = WS_LSUM + (size_t)256 * 1024 * 8;
constexpr size_t WS_W1OUT = WS_W1IN + (size_t)2 * DFF * D * 2;
constexpr size_t WS_W2IN  = WS_W1OUT + (size_t)D * DFF * 2;
constexpr size_t WS_W2OUT = WS_W2IN + (size_t)2 * DFF * D * 2;
constexpr size_t WS_WINM  = WS_W2OUT + (size_t)D * DFF * 2;
constexpr size_t WS_WV    = WS_WINM + (size_t)8192 * D * 2;
constexpr size_t WS_WBR   = WS_WV + (size_t)1024 * D * 2;
constexpr size_t WS_WO    = WS_WBR + (size_t)D * D * 2;
constexpr size_t WS_WG    = WS_WO + (size_t)D * D * 2;
constexpr size_t WS_Y     = WS_WG + (size_t)2 * 8 * 128 * 128 * 2;
constexpr size_t WS_P     = WS_Y + (size_t)T * D * 2;
constexpr size_t WS_VT    = WS_P + (size_t)T * PW * 2;
constexpr size_t WS_YM    = WS_VT + (size_t)1024 * T * 2;
constexpr size_t WS_END   = WS_YM + (size_t)T * D * 2;

typedef unsigned short bf16_t;
typedef short bf16x8 __attribute__((ext_vector_type(8)));
typedef float f32x4 __attribute__((ext_vector_type(4)));
typedef float f32x16 __attribute__((ext_vector_type(16)));
typedef float f32x2v __attribute__((ext_vector_type(2)));
typedef __bf16 bf16x2v __attribute__((ext_vector_type(2)));
typedef unsigned u32x4 __attribute__((ext_vector_type(4)));
typedef unsigned u32x2 __attribute__((ext_vector_type(2)));

DI unsigned pk_bf16(float lo, float hi) { f32x2v f = {lo, hi}; bf16x2v b = __builtin_convertvector(f, bf16x2v); return __builtin_bit_cast(unsigned, b); }
DI bf16_t to_bf16(float x) { return (bf16_t)(pk_bf16(x, 0.f) & 0xffffu); }
DI float bf_lo(unsigned u) { return __uint_as_float(u << 16); }
DI float bf_hi(unsigned u) { return __uint_as_float(u & 0xffff0000u); }
DI float bf_f(bf16_t h) { return __uint_as_float(((unsigned)h) << 16); }
DI float fast_exp2(float x) { return __builtin_amdgcn_exp2f(x); }
DI float fast_rcp(float x) { return __builtin_amdgcn_rcpf(x); }
DI float sigmoidf_(float x) { return fast_rcp(1.0f + fast_exp2(-x * LOG2E)); }

namespace pg8 {
#define PG8_LAS __attribute__((address_space(3)))
constexpr int BM = 256, BK = 64, HALF = 128, HTB = HALF * BK * 2, STAGE_BYTES = 8 * HTB, NXCD = 8, WGM = 8;
__host__ __device__ __forceinline__ int lds_byte(int r, int c) { const int st = (r >> 4) * 2 + (c >> 5), rr = r & 15, cc = c & 31, ob = rr * 64 + cc * 2; return st * 1024 + (ob ^ (((ob >> 9) & 1) << 5)); }
__host__ __device__ __forceinline__ void stage_rc(int b, int& R, int& C) { const int st = b / 1024, sb = b % 1024, swz = sb ^ (((sb >> 9) & 1) << 5); R = (st >> 1) * 16 + swz / 64; C = (st & 1) * 32 + (swz % 64) / 2; }
__host__ __device__ __forceinline__ int perm32(int rho) { const int n = rho >> 4, i = rho & 15; return 8 * (i >> 2) + 4 * n + (i & 3); }
struct Unit { int pm, pn; };
struct Gemm { const bf16_t* A; const bf16_t* Bt; int M, N, K; };
struct StaticOrder {
    int nM, nN, nwg, G, c, wgm;
    __host__ __device__ void init(int M, int N, int G_, int c_, int wgm_ = WGM) { nM = M / BM; nN = N / BM; nwg = nM * nN; G = G_; c = c_; wgm = wgm_; }
    __host__ __device__ bool next(int i, Unit& u) const {
        const long L = (long)i * G + c; if (L >= nwg) return false;
        int wgid = (int)L; { const int q = nwg / NXCD, r = nwg % NXCD, xcd = wgid % NXCD, off = wgid / NXCD; wgid = (xcd < r ? xcd * (q + 1) : r * (q + 1) + (xcd - r) * q) + off; }
        const int nig = wgm * nN, gid = wgid / nig, fm = gid * wgm, gsz = (nM - fm) < wgm ? (nM - fm) : wgm;
        u.pm = fm + ((wgid % nig) % gsz); u.pn = (wgid % nig) / gsz; return true;
    }
    __device__ __forceinline__ void a_ready(const Unit&) const {}
    __device__ __forceinline__ void done(const Unit&) const {}
};

struct EpiSwiGLU {
    static constexpr bool PERM = true, AFTER_DRAIN = false, MID = false;
    bf16_t* H;
    DI void mid(f32x4 (&)[2][2][4][2], const Unit&, int, int, int, int) const {}
    DI void operator()(const f32x4 (&acc)[2][2][4][2], const Unit& u, int wr, int wc, int fr, int fq) const {
        const int row0 = u.pm * BM + wr * 64 + fr, col0 = u.pn * HALF + wc * 32 + 8 * fq;
#pragma unroll
        for (int ai = 0; ai < 2; ++ai)
#pragma unroll
            for (int m = 0; m < 4; ++m) {
                float o[8];
#pragma unroll
                for (int n = 0; n < 2; ++n)
#pragma unroll
                    for (int j = 0; j < 4; ++j) { const float g = acc[ai][0][m][n][j], up = acc[ai][1][m][n][j]; o[n * 4 + j] = g * sigmoidf_(g) * up; }
                u32x4 w; w.x = pk_bf16(o[0], o[1]); w.y = pk_bf16(o[2], o[3]); w.z = pk_bf16(o[4], o[5]); w.w = pk_bf16(o[6], o[7]);
                *(u32x4*)(H + (size_t)(row0 + ai * HALF + m * 16) * DFF + col0) = w;
            }
    }
};
struct EpiResid {
    static constexpr bool PERM = false, AFTER_DRAIN = false, MID = false;
    const float* resid; float* out; const float* gmod; float coef;
    DI void mid(f32x4 (&)[2][2][4][2], const Unit&, int, int, int, int) const {}
    DI void operator()(const f32x4 (&acc)[2][2][4][2], const Unit& u, int wr, int wc, int fr, int fq) const {
        const int row0 = u.pm * BM + wr * 64 + fr, col0 = u.pn * BM + wc * 32 + 4 * fq;
        const float* gv = gmod + (size_t)(u.pm >> 4) * NMOD + col0;
        f32x4 g[2][2];
#pragma unroll
        for (int bj = 0; bj < 2; ++bj)
#pragma unroll
            for (int n = 0; n < 2; ++n) g[bj][n] = *(const f32x4*)(gv + bj * HALF + n * 16) * coef;
#pragma unroll
        for (int ai = 0; ai < 2; ++ai)
#pragma unroll
            for (int m = 0; m < 4; ++m) { const size_t off = (size_t)(row0 + ai * HALF + m * 16) * D + col0;
#pragma unroll
                for (int bj = 0; bj < 2; ++bj)
#pragma unroll
                    for (int n = 0; n < 2; ++n) { const f32x4 r = *(const f32x4*)(resid + off + bj * HALF + n * 16); *(f32x4*)(out + off + bj * HALF + n * 16) = r + g[bj][n] * acc[ai][bj][m][n]; }
                asm volatile("" ::: "memory"); }
    }
};
struct EpiP {
    static constexpr bool PERM = true, AFTER_DRAIN = false, MID = false;
    bf16_t* O; int ldc; int nscale; float scale;
    DI void mid(f32x4 (&)[2][2][4][2], const Unit&, int, int, int, int) const {}
    DI void operator()(const f32x4 (&acc)[2][2][4][2], const Unit& u, int wr, int wc, int fr, int fq) const {
        const int row0 = u.pm * BM + wr * 64 + fr, col0 = u.pn * BM + wc * 32 + 8 * fq;
        const float s = (u.pn < nscale) ? scale : 1.0f;
#pragma unroll
        for (int ai = 0; ai < 2; ++ai)
#pragma unroll
            for (int m = 0; m < 4; ++m) { bf16_t* p = O + (size_t)(row0 + ai * HALF + m * 16) * ldc + col0;
#pragma unroll
                for (int bj = 0; bj < 2; ++bj) { const f32x4 v0 = acc[ai][bj][m][0] * s, v1 = acc[ai][bj][m][1] * s;
                    u32x4 w; w.x = pk_bf16(v0[0], v0[1]); w.y = pk_bf16(v0[2], v0[3]); w.z = pk_bf16(v1[0], v1[1]); w.w = pk_bf16(v1[2], v1[3]);
                    *(u32x4*)(p + bj * HALF) = w; } }
    }
};
struct EpiBranch {
    #ifdef TEST_NOMID
    static constexpr bool PERM = true, AFTER_DRAIN = false, MID = false;
#else
    static constexpr bool PERM = true, AFTER_DRAIN = false, MID = true;
#endif
    const bf16_t* P; bf16_t* O;
    DI static float cl(float x) { return fminf(fmaxf(x, -60.f), 60.f); }
    DI void mid(f32x4 (&acc)[2][2][4][2], const Unit& u, int wr, int wc, int fr, int fq) const {
        int row0 = u.pm * BM + wr * 64 + fr, col0 = u.pn * BM + wc * 32 + 8 * fq;
        asm volatile("" : "+v"(row0), "+v"(col0));
#pragma unroll
        for (int ai = 0; ai < 2; ++ai)
#pragma unroll
            for (int m = 0; m < 4; ++m) { const bf16_t* gp = P + (size_t)(row0 + ai * HALF + m * 16) * PW + 4096 + col0;
#pragma unroll
                for (int bj = 0; bj < 2; ++bj) { const u32x4 ga = *(const u32x4*)(gp + bj * HALF), gl = *(const u32x4*)(gp + 2048 + bj * HALF);
#pragma unroll
                    for (int q = 0; q < 4; ++q) { const float a0 = cl(bf_lo(ga[q])), a1 = cl(bf_hi(ga[q])), l0 = cl(bf_lo(gl[q])), l1 = cl(bf_hi(gl[q]));
                        const float r0 = (1.0f + fast_exp2(-l0 * LOG2E)) * fast_rcp(1.0f + fast_exp2(-a0 * LOG2E));
                        const float r1 = (1.0f + fast_exp2(-l1 * LOG2E)) * fast_rcp(1.0f + fast_exp2(-a1 * LOG2E));
                        acc[ai][bj][m][q >> 1][(q & 1) * 2] *= r0; acc[ai][bj][m][q >> 1][(q & 1) * 2 + 1] *= r1; } }
                asm volatile("" ::: "memory"); }
    }
    DI void operator()(const f32x4 (&acc)[2][2][4][2], const Unit& u, int wr, int wc, int fr, int fq) const {
        const int row0 = u.pm * BM + wr * 64 + fr, col0 = u.pn * BM + wc * 32 + 8 * fq;
#pragma unroll
        for (int ai = 0; ai < 2; ++ai)
#pragma unroll
            for (int m = 0; m < 4; ++m) { const size_t r = (size_t)(row0 + ai * HALF + m * 16); const bf16_t* gp = P + r * PW + 6144 + col0;
#pragma unroll
                for (int bj = 0; bj < 2; ++bj) { const u32x4 gl = *(const u32x4*)(gp + bj * HALF); float o[8];
#pragma unroll
                    for (int q = 0; q < 4; ++q) { const float l0 = cl(bf_lo(gl[q])), l1 = cl(bf_hi(gl[q]));
                        o[q * 2] = acc[ai][bj][m][q >> 1][(q & 1) * 2] * fast_rcp(1.0f + fast_exp2(-l0 * LOG2E));
                        o[q * 2 + 1] = acc[ai][bj][m][q >> 1][(q & 1) * 2 + 1] * fast_rcp(1.0f + fast_exp2(-l1 * LOG2E)); }
                    u32x4 w; w.x = pk_bf16(o[0], o[1]); w.y = pk_bf16(o[2], o[3]); w.z = pk_bf16(o[4], o[5]); w.w = pk_bf16(o[6], o[7]);
                    *(u32x4*)(O + r * D + col0 + bj * HALF) = w; }
                asm volatile("" ::: "memory"); }
    }
};

template <class Epi, class Sched, bool ALIGN_EPI = false, bool SP2 = false>
__device__ __forceinline__ void gemm_phase(PG8_LAS unsigned char* lds, const Gemm g, const Sched& S, const Epi& E) {
    const int tid = threadIdx.x, wid = __builtin_amdgcn_readfirstlane(tid >> 6), lane = tid & 63, wr = wid >> 2, wc = wid & 3, fr = lane & 15, fq = lane >> 4;
    const int K = g.K, nt = K / BK;
    unsigned voffA[2], voffB[2];
#pragma unroll
    for (int i = 0; i < 2; ++i) { int R, C; stage_rc(tid * 16 + i * 8192, R, C); const int Rb = Epi::PERM ? ((R & ~31) + perm32(R & 31)) : R;
        voffA[i] = (unsigned)(R * K + C) * 2u; voffB[i] = (unsigned)(Rb * K + C) * 2u; }
    const size_t kstep = (size_t)(BK * 2);
    const size_t hstep = (size_t)HALF * K * 2;
    const size_t tstep = 2 * hstep;
    const unsigned ldsw = (unsigned)wid * 1024u;
    const int aoff = lds_byte(wr * 64 + fr, fq * 8), boff = lds_byte(wc * 32 + fr, fq * 8);
#define PG8_SA(b, h) (((b) * 2 + (h)) * HTB)
#define PG8_SB(b, h) ((4 + (b) * 2 + (h)) * HTB)
#define PG8_STAGE(bufoff, gbase, voff) do { _Pragma("unroll") for (int _i = 0; _i < 2; ++_i) \
        __builtin_amdgcn_global_load_lds((const unsigned*)((const char*)(gbase) + (voff)[_i]), (PG8_LAS unsigned*)(lds + (bufoff) + ldsw + _i * 8192), 16, 0, 0); } while (0)
#define PG8_LDA(dst, b, h) do { _Pragma("unroll") for (int m = 0; m < 4; ++m) _Pragma("unroll") for (int k = 0; k < 2; ++k) dst[m][k] = *(const PG8_LAS bf16x8*)(lds + PG8_SA(b, h) + aoff + m * 2048 + k * 1024); } while (0)
#define PG8_LDB(dst, b, h) do { _Pragma("unroll") for (int n = 0; n < 2; ++n) _Pragma("unroll") for (int k = 0; k < 2; ++k) dst[n][k] = *(const PG8_LAS bf16x8*)(lds + PG8_SB(b, h) + boff + n * 2048 + k * 1024); } while (0)
#define PG8_MMA(ai, bj, At, Bt) do { __builtin_amdgcn_s_setprio(1); _Pragma("unroll") for (int m = 0; m < 4; ++m) _Pragma("unroll") for (int n = 0; n < 2; ++n) _Pragma("unroll") for (int k = 0; k < 2; ++k) \
        acc[ai][bj][m][n] = __builtin_amdgcn_mfma_f32_16x16x32_bf16(Bt[n][k], At[m][k], acc[ai][bj][m][n], 0, 0, 0); __builtin_amdgcn_s_setprio(0); } while (0)
#define PG8_WAIT_V(n) asm volatile("s_waitcnt vmcnt(" #n ")" ::: "memory")
#define PG8_WAIT_L(n) asm volatile("s_waitcnt lgkmcnt(" #n ")" ::: "memory")
#define PG8_BAR __builtin_amdgcn_s_barrier()
#define PG8_SCHED __builtin_amdgcn_sched_barrier(0)
    Unit cur, nxt; int ui = 0;
    if (!S.next(0, cur)) return;
    f32x4 acc[2][2][4][2];
#pragma unroll
    for (int a = 0; a < 2; ++a)
#pragma unroll
        for (int b = 0; b < 2; ++b)
#pragma unroll
            for (int m = 0; m < 4; ++m)
#pragma unroll
                for (int n = 0; n < 2; ++n) acc[a][b][m][n] = (f32x4){0.f, 0.f, 0.f, 0.f};
    bf16x8 At[4][2], B0[2][2], B1[2][2];
    const char* cA = (const char*)g.A + (size_t)cur.pm * tstep; const char* cB = (const char*)g.Bt + (size_t)cur.pn * tstep;
    S.a_ready(cur);
    if constexpr (SP2) {
        PG8_STAGE(PG8_SB(0, 0), cB, voffB); PG8_STAGE(PG8_SB(0, 1), cB + hstep, voffB); PG8_STAGE(PG8_SA(0, 0), cA, voffA); PG8_STAGE(PG8_SA(0, 1), cA + hstep, voffA);
        if (wr == 1) PG8_BAR;
        PG8_WAIT_V(2); PG8_BAR;
        PG8_STAGE(PG8_SB(1, 0), cB + kstep, voffB); PG8_STAGE(PG8_SA(1, 0), cA + kstep, voffA); PG8_STAGE(PG8_SB(1, 1), cB + hstep + kstep, voffB);
        PG8_WAIT_V(6); PG8_BAR;
    } else {
        PG8_STAGE(PG8_SB(0, 0), cB, voffB); PG8_STAGE(PG8_SA(0, 0), cA, voffA); PG8_STAGE(PG8_SB(0, 1), cB + hstep, voffB); PG8_STAGE(PG8_SA(0, 1), cA + hstep, voffA);
        if (wr == 1) PG8_BAR;
        PG8_WAIT_V(4); PG8_BAR;
        PG8_STAGE(PG8_SB(1, 0), cB + kstep, voffB); PG8_STAGE(PG8_SA(1, 0), cA + kstep, voffA); PG8_STAGE(PG8_SB(1, 1), cB + hstep + kstep, voffB);
        PG8_WAIT_V(6); PG8_BAR;
    }
    for (;;) {
        const bool has_next = S.next(ui + 1, nxt);
        const char* nA = has_next ? (const char*)g.A + (size_t)nxt.pm * tstep : cA; const char* nB = has_next ? (const char*)g.Bt + (size_t)nxt.pn * tstep : cB;
        for (int t = 0; t < nt; t += 2) {
            const bool last = (t == nt - 2);
            const char* a1 = cA + (size_t)(t + 1) * kstep;
            const char* a2 = last ? nA : cA + (size_t)(t + 2) * kstep; const char* b2 = last ? nB : cB + (size_t)(t + 2) * kstep;
            const char* a3 = a2 + kstep; const char* b3 = b2 + kstep;
            if (last && has_next) S.a_ready(nxt);
            if constexpr (Epi::MID) { PG8_SCHED; if (t == nt / 2) E.mid(acc, cur, wr, wc, fr, fq); PG8_SCHED; }
            if constexpr (SP2) {
            PG8_LDB(B0, 0, 0); PG8_LDB(B1, 0, 1); PG8_SCHED; PG8_LDA(At, 0, 0); PG8_STAGE(PG8_SA(1, 1), a1 + hstep, voffA);
            PG8_WAIT_V(8); PG8_WAIT_L(0); PG8_BAR; PG8_MMA(0, 0, At, B0); PG8_MMA(0, 1, At, B1); PG8_BAR; PG8_SCHED;
            PG8_LDA(At, 0, 1); PG8_STAGE(PG8_SB(0, 0), b2, voffB); PG8_STAGE(PG8_SB(0, 1), b2 + hstep, voffB); PG8_STAGE(PG8_SA(0, 0), a2, voffA);
            PG8_WAIT_V(8); PG8_WAIT_L(0); PG8_BAR; PG8_MMA(1, 0, At, B0); PG8_MMA(1, 1, At, B1); PG8_BAR; PG8_SCHED;
            PG8_LDB(B0, 1, 0); PG8_LDB(B1, 1, 1); PG8_SCHED; PG8_LDA(At, 1, 0); PG8_STAGE(PG8_SA(0, 1), a2 + hstep, voffA);
            PG8_WAIT_V(8); PG8_WAIT_L(0); PG8_BAR; PG8_MMA(0, 0, At, B0); PG8_MMA(0, 1, At, B1); PG8_BAR; PG8_SCHED;
            PG8_LDA(At, 1, 1); PG8_STAGE(PG8_SB(1, 0), b3, voffB); PG8_STAGE(PG8_SB(1, 1), b3 + hstep, voffB); PG8_STAGE(PG8_SA(1, 0), a3, voffA);
            PG8_WAIT_V(8); PG8_WAIT_L(0); PG8_BAR; PG8_MMA(1, 0, At, B0); PG8_MMA(1, 1, At, B1); PG8_BAR; PG8_SCHED;
            } else {
            PG8_LDB(B0, 0, 0); PG8_SCHED; PG8_LDA(At, 0, 0); PG8_STAGE(PG8_SA(1, 1), a1 + hstep, voffA);
            PG8_WAIT_L(8); PG8_BAR; PG8_WAIT_L(0); PG8_MMA(0, 0, At, B0); PG8_BAR; PG8_SCHED;
            PG8_LDB(B1, 0, 1); PG8_STAGE(PG8_SB(0, 0), b2, voffB);
            PG8_BAR; PG8_WAIT_L(0); PG8_MMA(0, 1, At, B1); PG8_BAR;
            PG8_LDA(At, 0, 1); PG8_STAGE(PG8_SA(0, 0), a2, voffA);
            PG8_BAR; PG8_WAIT_L(0); PG8_MMA(1, 0, At, B0); PG8_BAR; PG8_SCHED;
            PG8_STAGE(PG8_SB(0, 1), b2 + hstep, voffB);
            PG8_WAIT_V(6); PG8_BAR; PG8_MMA(1, 1, At, B1); PG8_BAR;
            PG8_LDB(B0, 1, 0); PG8_SCHED; PG8_LDA(At, 1, 0); PG8_STAGE(PG8_SA(0, 1), a2 + hstep, voffA);
            PG8_WAIT_L(8); PG8_BAR; PG8_WAIT_L(0); PG8_MMA(0, 0, At, B0); PG8_BAR; PG8_SCHED;
            PG8_LDB(B1, 1, 1); PG8_STAGE(PG8_SB(1, 0), b3, voffB);
            PG8_BAR; PG8_WAIT_L(0); PG8_MMA(0, 1, At, B1); PG8_BAR;
            PG8_LDA(At, 1, 1); PG8_STAGE(PG8_SA(1, 0), a3, voffA);
            PG8_BAR; PG8_WAIT_L(0); PG8_MMA(1, 0, At, B0); PG8_BAR; PG8_SCHED;
            PG8_STAGE(PG8_SB(1, 1), b3 + hstep, voffB);
            PG8_WAIT_V(6); PG8_BAR; PG8_MMA(1, 1, At, B1); PG8_BAR;
            }
        }
        if constexpr (ALIGN_EPI) { if (wr == 0) PG8_BAR; }
        if constexpr (!Epi::AFTER_DRAIN) { E(acc, cur, wr, wc, fr, fq); S.done(cur); }
        if (!has_next) break;
#pragma unroll
        for (int a = 0; a < 2; ++a)
#pragma unroll
            for (int b = 0; b < 2; ++b)
#pragma unroll
                for (int m = 0; m < 4; ++m)
#pragma unroll
                    for (int n = 0; n < 2; ++n) acc[a][b][m][n] = (f32x4){0.f, 0.f, 0.f, 0.f};
        cur = nxt; cA = nA; cB = nB; ++ui;
        if constexpr (ALIGN_EPI) { if (wr == 1) PG8_BAR; }
    }
    PG8_WAIT_V(0);
    if constexpr (!ALIGN_EPI) { if (wr == 0) PG8_BAR; }
    PG8_BAR;
    if constexpr (Epi::AFTER_DRAIN) { E.fused(acc, cur, wr, wc, fr, fq, lds, wid, lane); S.done(cur); }
#undef PG8_SA
#undef PG8_SB
#undef PG8_STAGE
#undef PG8_LDA
#undef PG8_LDB
#undef PG8_MMA
#undef PG8_WAIT_V
#undef PG8_WAIT_L
#undef PG8_BAR
#undef PG8_SCHED
}
}

#define XB_TMO      128
#define XB_XCNT(j)  (256  + 64 * (j))
#define XB_XSUB(j)  (1280 + 64 * (j))
#define XB_XGEN(j)  (2304 + 64 * (j))
#define XB_TOP      3328
#define XB_TOPGEN   3392
#define XCD_BAR_WORDS 3456
#define XB_SPIN_CAP (1u << 18)

__device__ __forceinline__ unsigned xb_ld(unsigned* p)              { return __hip_atomic_load(p, __ATOMIC_RELAXED, __HIP_MEMORY_SCOPE_AGENT); }
__device__ __forceinline__ unsigned xb_add(unsigned* p, unsigned v) { return __hip_atomic_fetch_add(p, v, __ATOMIC_RELAXED, __HIP_MEMORY_SCOPE_AGENT); }
__device__ __forceinline__ unsigned xb_xcc_id() { return (unsigned)__builtin_amdgcn_s_getreg((3 << 11) | 20) & 0xFu; }
#define XB_SPIN(cond, bar) do { unsigned _sp = 0; while (cond) { __builtin_amdgcn_s_sleep(1); \
    if ((++_sp & 255u) == 0u) { if (xb_ld(&(bar)[XB_TMO])) break; if (_sp > XB_SPIN_CAP) { atomicAdd(&(bar)[XB_TMO], 1u); break; } } } } while (0)

struct XcdBarrier {
    unsigned* bar; unsigned x;
    volatile LAS unsigned* st;
};

__device__ __forceinline__ XcdBarrier xcd_barrier_post(unsigned* bar, volatile LAS unsigned* st) {
    XcdBarrier b; b.bar = bar; b.x = xb_xcc_id(); b.st = st;
    if (threadIdx.x == 0) (void)xb_add(&bar[XB_XCNT(b.x)], 1u);
    return b;
}
__device__ __forceinline__ void xcd_barrier_complete(unsigned* bar, unsigned x, unsigned& nloc, unsigned& nx) {
    const unsigned G = gridDim.x * gridDim.y * gridDim.z;
    unsigned sum, cnt, mine, sp = 0u;
    for (;;) {
        sum = 0u; cnt = 0u; mine = 0u;
#pragma unroll
        for (unsigned j = 0; j < 16; ++j) { const unsigned c = xb_ld(&bar[XB_XCNT(j)]); sum += c; cnt += (c > 0u) ? 1u : 0u; mine = (j == x) ? c : mine; }
        if (sum == G) break;
        __builtin_amdgcn_s_sleep(1);
        if ((++sp & 255u) == 0u) { if (xb_ld(&bar[XB_TMO])) break; if (sp > XB_SPIN_CAP) { atomicAdd(&bar[XB_TMO], 1u); break; } }
    }
    nloc = mine > 0u ? mine : 1u; nx = cnt > 0u ? cnt : 1u;
}

__device__ __forceinline__ void xcd_barrier(const XcdBarrier& b) {
    asm volatile("s_waitcnt vmcnt(0)" ::: "memory");
    __syncthreads();
    if (threadIdx.x == 0) {
        unsigned* bar = b.bar;
        __builtin_amdgcn_s_waitcnt(0);
        unsigned nloc = b.st[0], nx = b.st[1];
        if (nloc == 0u) { xcd_barrier_complete(bar, b.x, nloc, nx); b.st[0] = nloc; b.st[1] = nx; }
        const unsigned old = xb_add(&bar[XB_XSUB(b.x)], 1u);
        const unsigned gen = old / nloc;
        if (old + 1u == (gen + 1u) * nloc) {
            __builtin_amdgcn_fence(__ATOMIC_RELEASE, "agent");
            asm volatile("s_waitcnt vmcnt(0)" ::: "memory");
            const unsigned og = xb_add(&bar[XB_TOP], 1u);
            const unsigned tg = og / nx;
            if (og + 1u == (tg + 1u) * nx) xb_add(&bar[XB_TOPGEN], 1u);
            else XB_SPIN(xb_ld(&bar[XB_TOPGEN]) == tg, bar);
            __builtin_amdgcn_fence(__ATOMIC_ACQUIRE, "agent");
            xb_add(&bar[XB_XGEN(b.x)], 1u);
            asm volatile("s_waitcnt vmcnt(0)" ::: "memory");
        } else {
            XB_SPIN(xb_ld(&bar[XB_XGEN(b.x)]) == gen, bar);
            __builtin_amdgcn_fence(__ATOMIC_ACQUIRE, "agent");
            asm volatile("s_waitcnt vmcnt(0)" ::: "memory");
        }
    }
    __syncthreads();
}


struct Args { const float* in[23]; float* out; unsigned char* ws; int ph_lo, ph_hi; };
enum { I_X = 0, I_C, I_WADA, I_BADA, I_N1, I_W1IN, I_W1OUT, I_NMIX, I_WIN, I_CONVW, I_CONVB, I_WRG, I_BRG, I_WIG, I_BIG, I_LAM, I_WBA, I_WBL, I_WOUT, I_N2, I_W2IN, I_W2OUT, I_NF };

DI void conv_tile(LAS float* buf, const float* src, int lds_, bf16_t* dst, int ldd) {
    const int tid = threadIdx.x;
    float4 v[8];
#pragma unroll
    for (int i = 0; i < 8; ++i) { const int k = (tid >> 4) + 32 * i, cgp = tid & 15; v[i] = *(const float4*)(src + (size_t)k * lds_ + cgp * 4); }
#pragma unroll
    for (int i = 0; i < 8; ++i) { const int k = (tid >> 4) + 32 * i, cgp = tid & 15; LAS float* p = buf + k * 65 + cgp * 4; p[0] = v[i].x; p[1] = v[i].y; p[2] = v[i].z; p[3] = v[i].w; }
    __syncthreads();
#pragma unroll
    for (int i = 0; i < 4; ++i) { const int q = tid + 512 * i, g = q >> 6, kg = (g & 3) * 8 + (q & 7), n = (g >> 2) * 8 + ((q >> 3) & 7); float f[8];
#pragma unroll
        for (int j = 0; j < 8; ++j) f[j] = buf[(kg * 8 + j) * 65 + n];
        u32x4 o; o.x = pk_bf16(f[0], f[1]); o.y = pk_bf16(f[2], f[3]); o.z = pk_bf16(f[4], f[5]); o.w = pk_bf16(f[6], f[7]);
        *(u32x4*)(dst + (size_t)n * ldd + kg * 8) = o; }
    __syncthreads();
}
DI void conv_tile64(LAS float* buf, const float* src, int lds_, bf16_t* dst, int ldd) {
    const int tid = threadIdx.x;
#pragma unroll
    for (int i = 0; i < 2; ++i) { const int k = (tid >> 4) + 32 * i, cgp = tid & 15; const float4 v = *(const float4*)(src + (size_t)k * lds_ + cgp * 4);
        LAS float* p = buf + k * 65 + cgp * 4; p[0] = v.x; p[1] = v.y; p[2] = v.z; p[3] = v.w; }
    __syncthreads();
    { const int kg = tid & 7, n = tid >> 3; float f[8];
#pragma unroll
        for (int j = 0; j < 8; ++j) f[j] = buf[(kg * 8 + j) * 65 + n];
        u32x4 o; o.x = pk_bf16(f[0], f[1]); o.y = pk_bf16(f[2], f[3]); o.z = pk_bf16(f[4], f[5]); o.w = pk_bf16(f[6], f[7]);
        *(u32x4*)(dst + (size_t)n * ldd + kg * 8) = o; }
    __syncthreads();
}
DI void conv_job(LAS float* buf, int& rot, const float* src, int ldsrc, int K, int Nd, bf16_t* dst, int lddst, int koff, int map) {
    const int G = gridDim.x, KT = (map == 4) ? 64 : 256, tn_n = Nd >> 6, ntile = tn_n * (K / KT);
    for (int t = (int)((blockIdx.x + rot) % G); t < ntile; t += G) {
        const int tn = t % tn_n, tk = t / tn_n, n0 = tn * 64, k0 = tk * KT;
        if (map == 4) { conv_tile64(buf, src + (size_t)(n0 >> 7) * 16384 + (size_t)k0 * 128 + (n0 & 127), ldsrc, dst + (size_t)n0 * lddst + koff + k0, lddst); continue; }
        int c0 = n0;
        if (map == 1) { const int pn = n0 >> 8, rr = n0 & 255; c0 = rr < 128 ? 128 * pn + rr : DFF + 128 * pn + rr - 128; }
        else if (map == 2) c0 = n0 < 2048 ? n0 : n0 + 1024;
        else if (map == 3) c0 = 2048 + n0;
        conv_tile(buf, src + (size_t)k0 * ldsrc + c0, ldsrc, dst + (size_t)n0 * lddst + koff + k0, lddst);
    }
    rot = (rot + G - ntile % G) % G;
}
DI void mod_items(LAS float* lf, const float* c, const float* w_ada, const float* b_ada, float* mod) {
    const int tid = threadIdx.x;
    if (blockIdx.x >= 288) return;
    for (int i = tid; i < 8192; i += 512) { const float v = c[i]; lf[i] = v * sigmoidf_(v); }
    __syncthreads();
    LAS float* part = lf + 8192;
    for (int it = blockIdx.x; it < 288; it += gridDim.x) {
        const int col0 = it * 64, cgp = tid & 15, ks = tid >> 4;
        float acc[4][4];
#pragma unroll
        for (int b = 0; b < 4; ++b)
#pragma unroll
            for (int j = 0; j < 4; ++j) acc[b][j] = 0.f;
        const float* wp = w_ada + (size_t)(ks * 64) * NMOD + col0 + cgp * 4;
#pragma unroll 16
        for (int k = 0; k < 64; ++k) { const float4 w = *(const float4*)(wp + (size_t)k * NMOD);
#pragma unroll
            for (int b = 0; b < 4; ++b) { const float cv = lf[b * 2048 + ks * 64 + k]; acc[b][0] += cv * w.x; acc[b][1] += cv * w.y; acc[b][2] += cv * w.z; acc[b][3] += cv * w.w; } }
#pragma unroll
        for (int b = 0; b < 4; ++b)
#pragma unroll
            for (int j = 0; j < 4; ++j) part[(ks * 16 + cgp) * 16 + b * 4 + j] = acc[b][j];
        __syncthreads();
        if (tid < 256) { const int b = tid >> 6, cc = tid & 63; float s = 0.f;
            for (int k2 = 0; k2 < 32; ++k2) s += part[(k2 * 16 + (cc >> 2)) * 16 + b * 4 + (cc & 3)];
            mod[b * NMOD + col0 + cc] = s + b_ada[col0 + cc]; }
        __syncthreads();
    }
}

template <bool FINAL>
DI void norm_phase(const float* src, const float* gain, const float* mod, int ish, bf16_t* dst, float* dstf) {
    const int lane = threadIdx.x & 63, wave = threadIdx.x >> 6;
    for (int r = blockIdx.x * 8 + wave; r < T; r += gridDim.x * 8) {
        const float* xp = src + (size_t)r * D; f32x4 v[8]; float ss = 0.f;
#pragma unroll
        for (int i = 0; i < 8; ++i) { v[i] = *(const f32x4*)(xp + (i * 64 + lane) * 4); ss += v[i][0] * v[i][0] + v[i][1] * v[i][1] + v[i][2] * v[i][2] + v[i][3] * v[i][3]; }
#pragma unroll
        for (int off = 32; off >= 1; off >>= 1) ss += __shfl_xor(ss, off);
        const float rstd = rsqrtf(ss * (1.0f / D) + EPS);
        const float* sh = mod + (size_t)(r >> 12) * NMOD + ish * D; const float* sc = sh + D;
#pragma unroll
        for (int i = 0; i < 8; ++i) { const int col = (i * 64 + lane) * 4; const f32x4 g = *(const f32x4*)(gain + col);
            f32x4 y = v[i] * rstd * g;
            if (FINAL) *(f32x4*)(dstf + (size_t)r * D + col) = y;
            else { const f32x4 s4 = *(const f32x4*)(sh + col), c4 = *(const f32x4*)(sc + col); y = y * (1.0f + c4) + s4;
                u32x2 w; w.x = pk_bf16(y[0], y[1]); w.y = pk_bf16(y[2], y[3]); *(u32x2*)(dst + (size_t)r * D + col) = w; } }
    }
}

constexpr int AT_KROW = 272, AT_VROW = 144, AT_KB = 64 * AT_KROW, AT_BUF = AT_KB + 128 * AT_VROW;
DI f32x16 attn_qk(const LAS unsigned char* kp, const bf16x8 (&qf)[8]) {
    f32x16 s;
#pragma unroll
    for (int i = 0; i < 16; ++i) s[i] = 0.f;
#pragma unroll
    for (int ks = 0; ks < 8; ++ks) { const bf16x8 a = *(const LAS bf16x8*)(kp + ks * 32); s = __builtin_amdgcn_mfma_f32_32x32x16_bf16(a, qf[ks], s, 0, 0, 0); }
    return s;
}
template <bool MASKED>
DI void attn_ew(const f32x16& s, float& C, int half, int ks0, int tq, bf16x8& pf0, bf16x8& pf1) {
    float kp_[16];
#pragma unroll
    for (int i = 0; i < 16; ++i) kp_[i] = fast_rcp(1.0f + fast_exp2(s[i]));
    if (MASKED) {
#pragma unroll
        for (int i = 0; i < 16; ++i) { const int key = ks0 + 16 * (i >> 3) + 8 * half + (i & 7); kp_[i] = key < tq ? kp_[i] : 1.0f; } }
    float d[16]; float PA = 1.0f, PB = 1.0f;
#pragma unroll
    for (int i = 15; i >= 8; --i) { const float nx = PB * kp_[i]; d[i] = PB - nx; PB = nx; }
#pragma unroll
    for (int i = 7; i >= 0; --i) { const float nx = PA * kp_[i]; d[i] = PA - nx; PA = nx; }
    const float PAo = __shfl_xor(PA, 32), PBo = __shfl_xor(PB, 32);
    const float t1 = C * PBo, t3 = C * (PB * PBo), t4 = t3 * PAo;
    const float stB = half ? C : t1;
    const float stA = half ? t3 : t4;
    C = C * ((PA * PAo) * (PB * PBo));
    u32x4 p0, p1;
    p0.x = pk_bf16(d[0] * stA, d[1] * stA); p0.y = pk_bf16(d[2] * stA, d[3] * stA); p0.z = pk_bf16(d[4] * stA, d[5] * stA); p0.w = pk_bf16(d[6] * stA, d[7] * stA);
    p1.x = pk_bf16(d[8] * stB, d[9] * stB); p1.y = pk_bf16(d[10] * stB, d[11] * stB); p1.z = pk_bf16(d[12] * stB, d[13] * stB); p1.w = pk_bf16(d[14] * stB, d[15] * stB);
    pf0 = __builtin_bit_cast(bf16x8, p0); pf1 = __builtin_bit_cast(bf16x8, p1);
}
DI void attn_pv(const LAS unsigned char* vp0, const bf16x8& pf0, const bf16x8& pf1, f32x16 (&o)[4]) {
#pragma unroll
    for (int d = 0; d < 4; ++d) { const LAS unsigned char* vp = vp0 + d * 32 * AT_VROW;
        const bf16x8 v0 = *(const LAS bf16x8*)(vp), v1 = *(const LAS bf16x8*)(vp + 32);
        o[d] = __builtin_amdgcn_mfma_f32_32x32x16_bf16(v0, pf0, o[d], 0, 0, 0);
        o[d] = __builtin_amdgcn_mfma_f32_32x32x16_bf16(v1, pf1, o[d], 0, 0, 0); }
}
DI void attn_item(LAS unsigned char* lds, const bf16_t* P, const bf16_t* VT, bf16_t* YM, int b, int h, int qb) {
    const int tid = threadIdx.x, lane = tid & 63, wave = __builtin_amdgcn_readfirstlane(tid >> 6), l32 = lane & 31, half = lane >> 5;
    const int t0 = qb * 256 + wave * 32, tq = t0 + l32;
    const size_t tokbase = (size_t)b * SEQ;
    bf16x8 qf[8];
    { const bf16_t* qp = P + (tokbase + tq) * PW + h * 128 + 8 * half;
#pragma unroll
      for (int ks = 0; ks < 8; ++ks) qf[ks] = *(const bf16x8*)(qp + 16 * ks); }
    f32x16 o[4];
#pragma unroll
    for (int d = 0; d < 4; ++d)
#pragma unroll
        for (int i = 0; i < 16; ++i) o[d][i] = 0.f;
    float C = 1.0f;
    const int ktmax = qb * 4 + 3;
    const bf16_t* Kg = P + tokbase * PW + 1024 + h * 128;
    const bf16_t* Vg = VT + (size_t)(h * 128) * T + tokbase;
    unsigned ko[2], vo[2]; int kl[2], vl[2];
#pragma unroll
    for (int i = 0; i < 2; ++i) { const int p = tid + 512 * i; const int key = p >> 4, part = p & 15; ko[i] = (unsigned)(key * PW + part * 8); kl[i] = key * AT_KROW + part * 16;
        const int d = p >> 3, pv = p & 7; vo[i] = (unsigned)(d * T + pv * 8); vl[i] = AT_KB + d * AT_VROW + pv * 16; }
    u32x4 rk[2], rv[2];
    { const bf16_t* kb = Kg + (size_t)ktmax * 64 * PW; const bf16_t* vb = Vg + ktmax * 64;
#pragma unroll
      for (int i = 0; i < 2; ++i) { rk[i] = *(const u32x4*)(kb + ko[i]); rv[i] = *(const u32x4*)(vb + vo[i]); } }
#pragma unroll
    for (int i = 0; i < 2; ++i) { *(LAS u32x4*)(lds + kl[i]) = rk[i]; *(LAS u32x4*)(lds + vl[i]) = rv[i]; }
#pragma unroll
    for (int ks = 0; ks < 8; ++ks) asm volatile("" : "+v"(qf[ks]));
    __syncthreads();
    const int pir = (l32 & 0x13) | ((l32 & 8) >> 1) | ((l32 & 4) << 1);
    const int koff = pir * AT_KROW + half * 16, voff = l32 * AT_VROW + half * 16;
    int cur = 0;
    for (int kt = ktmax; kt >= 0; --kt) {
        if (kt > 0) { const bf16_t* kb = Kg + (size_t)(kt - 1) * 64 * PW; const bf16_t* vb = Vg + (kt - 1) * 64;
#pragma unroll
            for (int i = 0; i < 2; ++i) { rk[i] = *(const u32x4*)(kb + ko[i]); rv[i] = *(const u32x4*)(vb + vo[i]); } }
        const LAS unsigned char* Kb = lds + cur * AT_BUF + koff; const LAS unsigned char* Vb = lds + cur * AT_BUF + AT_KB + voff;
        if (kt * 64 + 63 < t0) {
            bf16x8 pa0, pa1, pb0, pb1;
            const f32x16 s1 = attn_qk(Kb + 32 * AT_KROW, qf);
            const f32x16 s0 = attn_qk(Kb, qf);
            attn_ew<false>(s1, C, half, 0, 0, pa0, pa1);
            attn_pv(Vb + 64, pa0, pa1, o);
            attn_ew<false>(s0, C, half, 0, 0, pb0, pb1);
            attn_pv(Vb, pb0, pb1, o);
        } else {
#pragma unroll
            for (int sub = 1; sub >= 0; --sub) {
                const int ks0 = kt * 64 + 32 * sub;
                if (ks0 >= t0 + 31) continue;
                bf16x8 pa0, pa1;
                const f32x16 s = attn_qk(Kb + sub * 32 * AT_KROW, qf);
                attn_ew<true>(s, C, half, ks0, tq, pa0, pa1);
                attn_pv(Vb + 64 * sub, pa0, pa1, o);
            }
        }
        if (kt > 0) { LAS unsigned char* nb = lds + (cur ^ 1) * AT_BUF;
#pragma unroll
            for (int i = 0; i < 2; ++i) { *(LAS u32x4*)(nb + kl[i]) = rk[i]; *(LAS u32x4*)(nb + vl[i]) = rv[i]; } }
        __syncthreads();
        cur ^= 1;
    }
    bf16_t* yp = YM + (tokbase + tq) * D + h * 128 + 4 * half;
#pragma unroll
    for (int d = 0; d < 4; ++d)
#pragma unroll
        for (int q4 = 0; q4 < 4; ++q4) { u32x2 w; w.x = pk_bf16(o[d][q4 * 4], o[d][q4 * 4 + 1]); w.y = pk_bf16(o[d][q4 * 4 + 2], o[d][q4 * 4 + 3]); *(u32x2*)(yp + d * 32 + q4 * 8) = w; }
}

struct LruP { const bf16_t* P; const bf16_t* WG; const float* conv_w; const float* conv_b; const float* b_r; const float* b_i; const float* lam; float* lsum; bf16_t* YM; };
DI void lru_item(LAS unsigned char* lds, const LruP& q, int ck, int n, int pass) {
    const int tid = threadIdx.x, lane = tid & 63, wave = __builtin_amdgcn_readfirstlane(tid >> 6);
    const int bq = ck >> 6, lc = ck & 63; const size_t tok0 = (size_t)ck * 64;
    LAS float* xcf = (LAS float*)lds;
    LAS float* la = xcf + 64 * 129;
    LAS float* lu = la + 64 * 129;
    LAS float* sg = lu + 64 * 129;
    LAS unsigned char* xcb = (LAS unsigned char*)(sg + 2048);
    const int c = tid & 127, sgi = tid >> 7, ch = n * 128 + c;
    const int fr = lane & 15, fq = lane >> 4;
    const bf16_t* xp = q.P + (tok0 + sgi * 16) * PW + 2048 + ch;
    const bool has_prev = (lc * 64 + sgi * 16) > 0;
    bf16_t xr[19];
#pragma unroll
    for (int t = 0; t < 3; ++t) xr[t] = has_prev ? xp[(t - 3) * PW] : (bf16_t)0;
#pragma unroll
    for (int t = 0; t < 16; ++t) xr[3 + t] = xp[(size_t)t * PW];
    bf16x8 wbr[4], wbi[4];
    { const bf16_t* wrp = q.WG + (size_t)(n * 128 + wave * 16 + fr) * 128 + fq * 8; const bf16_t* wip = wrp + 8 * 128 * 128;
#pragma unroll
      for (int ks = 0; ks < 4; ++ks) { wbr[ks] = *(const bf16x8*)(wrp + ks * 32); wbi[ks] = *(const bf16x8*)(wip + ks * 32); } }
    bf16_t grv[16]; float cA = 1.0f, cH = 0.f;
    if (pass == 2) {
        const bf16_t* gp = q.P + (tok0 + sgi * 16) * PW + 3072 + ch;
#pragma unroll
        for (int t = 0; t < 16; ++t) grv[t] = gp[(size_t)t * PW];
        const float* sp = q.lsum + ((size_t)(bq * 64 + sgi * 16) * 1024 + ch) * 2;
        f32x2v sv[16];
#pragma unroll
        for (int j = 0; j < 16; ++j) sv[j] = *(const f32x2v*)(sp + (size_t)j * 2048);
#pragma unroll
        for (int j = 0; j < 16; ++j) { const bool ok = (sgi * 16 + j) < lc; const float aj = ok ? sv[j][0] : 1.0f, hj = ok ? sv[j][1] : 0.f; cH = aj * cH + hj; cA *= aj; }
    }
    const float w0 = q.conv_w[ch], w1 = q.conv_w[1024 + ch], w2 = q.conv_w[2048 + ch], w3 = q.conv_w[3072 + ch], cb = q.conv_b[ch];
    const int c2 = wave * 16 + fr, ch2 = n * 128 + c2; const float brv = q.b_r[ch2], biv = q.b_i[ch2]; const float L = -8.0f * log1pf(expf(-q.lam[ch2]));
#pragma unroll
    for (int t = 0; t < 16; ++t) { const float y = w0 * bf_f(xr[t]) + w1 * bf_f(xr[t + 1]) + w2 * bf_f(xr[t + 2]) + w3 * bf_f(xr[t + 3]) + cb;
        xcf[(sgi * 16 + t) * 129 + c] = y; *(LAS bf16_t*)(xcb + (sgi * 16 + t) * 272 + c * 2) = to_bf16(y); }
    if (pass == 2) { sg[1024 + sgi * 128 + c] = cA; sg[1536 + sgi * 128 + c] = cH; }
    __syncthreads();
    f32x4 ar[4], ai[4];
#pragma unroll
    for (int m = 0; m < 4; ++m) { ar[m] = (f32x4){0.f, 0.f, 0.f, 0.f}; ai[m] = (f32x4){0.f, 0.f, 0.f, 0.f}; }
#pragma unroll
    for (int ks = 0; ks < 4; ++ks)
#pragma unroll
        for (int m = 0; m < 4; ++m) { const bf16x8 av = *(const LAS bf16x8*)(xcb + (m * 16 + fr) * 272 + (ks * 32 + fq * 8) * 2);
            ar[m] = __builtin_amdgcn_mfma_f32_16x16x32_bf16(av, wbr[ks], ar[m], 0, 0, 0); ai[m] = __builtin_amdgcn_mfma_f32_16x16x32_bf16(av, wbi[ks], ai[m], 0, 0, 0); }
#pragma unroll
    for (int m = 0; m < 4; ++m)
#pragma unroll
        for (int j = 0; j < 4; ++j) { const int t = m * 16 + fq * 4 + j; const float r = sigmoidf_(ar[m][j] + brv), ig = sigmoidf_(ai[m][j] + biv);
            const float lga = r * L; const float av = fast_exp2(lga * LOG2E); const float x = 2.0f * lga;
            const float om = -x * (1.0f + x * 0.5f * (1.0f + x * (1.0f / 3.0f) * (1.0f + x * 0.25f * (1.0f + x * 0.2f * (1.0f + x * (1.0f / 6.0f))))));
            la[t * 129 + c2] = av; lu[t * 129 + c2] = sqrtf(om) * ig * xcf[t * 129 + c2]; }
    __syncthreads();
    float av_[16], uv_[16];
#pragma unroll
    for (int t = 0; t < 16; ++t) { av_[t] = la[(sgi * 16 + t) * 129 + c]; uv_[t] = lu[(sgi * 16 + t) * 129 + c]; }
    { float A = 1.0f, H = 0.f;
#pragma unroll
      for (int t = 0; t < 16; ++t) { H = av_[t] * H + uv_[t]; A *= av_[t]; }
      sg[sgi * 128 + c] = A; sg[512 + sgi * 128 + c] = H; }
    __syncthreads();
    if (pass == 1) {
        if (tid < 128) { float A2 = sg[c], H2 = sg[512 + c];
#pragma unroll
            for (int s2 = 1; s2 < 4; ++s2) { const float as = sg[s2 * 128 + c], hs = sg[512 + s2 * 128 + c]; H2 = as * H2 + hs; A2 *= as; }
            *(f32x2v*)(q.lsum + ((size_t)ck * 1024 + ch) * 2) = (f32x2v){A2, H2}; }
    } else {
        float hc = 0.f;
#pragma unroll
        for (int s2 = 0; s2 < 4; ++s2) hc = sg[1024 + s2 * 128 + c] * hc + sg[1536 + s2 * 128 + c];
#pragma unroll
        for (int s2 = 0; s2 < 3; ++s2) { if (s2 < sgi) hc = sg[s2 * 128 + c] * hc + sg[512 + s2 * 128 + c]; }
        bf16_t* yp = q.YM + (tok0 + sgi * 16) * D + 1024 + ch;
#pragma unroll
        for (int t = 0; t < 16; ++t) { hc = av_[t] * hc + uv_[t];
            const float g = bf_f(grv[t]); const float ge = g * sigmoidf_(1.5957691216057308f * (g + 0.044715f * g * g * g));
            yp[(size_t)t * D] = to_bf16(hc * ge); }
    }
    __syncthreads();
}

constexpr int NPH = 14;
__global__ void __launch_bounds__(512, 2) fwd(Args a) {
    extern __shared__ __attribute__((aligned(16))) unsigned char lds_raw[];
    LAS unsigned char* lds = (LAS unsigned char*)lds_raw;
    cg::grid_group grid = cg::this_grid();
    const int lo = a.ph_lo, hi = a.ph_hi, G = gridDim.x, bx = blockIdx.x;
    unsigned char* ws = a.ws;
    float* mod = (float*)(ws + WS_MOD); float* lsum = (float*)(ws + WS_LSUM);
    bf16_t* W1IN = (bf16_t*)(ws + WS_W1IN); bf16_t* W1OUT = (bf16_t*)(ws + WS_W1OUT); bf16_t* W2IN = (bf16_t*)(ws + WS_W2IN); bf16_t* W2OUT = (bf16_t*)(ws + WS_W2OUT);
    bf16_t* WINM = (bf16_t*)(ws + WS_WINM); bf16_t* WV = (bf16_t*)(ws + WS_WV); bf16_t* WBR = (bf16_t*)(ws + WS_WBR); bf16_t* WO = (bf16_t*)(ws + WS_WO); bf16_t* WG = (bf16_t*)(ws + WS_WG);
    bf16_t* Y = (bf16_t*)(ws + WS_Y); bf16_t* P = (bf16_t*)(ws + WS_P); bf16_t* Hb = P; bf16_t* VT = (bf16_t*)(ws + WS_VT); bf16_t* YM = (bf16_t*)(ws + WS_YM); bf16_t* MG = Y;
    float* out = a.out;
#ifndef PHASE_MASK
#define PHASE_MASK 0x3fff
#endif
#define IN(k) (((PHASE_MASK >> (k)) & 1) && lo <= (k) && (k) < hi)
#ifndef DUPMASK
#define DUPMASK 0
#endif
#ifndef DUPCNT
#define DUPCNT 1
#endif
#define REP(k) for (int rep_ = 0; rep_ < 1 + DUPCNT * ((DUPMASK >> (k)) & 1); ++rep_)
#define SEAM(k) do { if (IN(k) && IN((k) + 1)) xcd_barrier(xbar); } while (0)
    if (threadIdx.x < 4) ((LAS unsigned*)(lds + LDS_MAIN))[threadIdx.x] = 0u;
    __syncthreads();
    XcdBarrier xbar; xbar.bar = (unsigned*)(ws + WS_BAR); xbar.x = 0; xbar.st = (volatile LAS unsigned*)(lds + LDS_MAIN);
    if (hi - lo > 1) xbar = xcd_barrier_post((unsigned*)(ws + WS_BAR), (volatile LAS unsigned*)(lds + LDS_MAIN));
    if (hi > 1000) grid.sync();
    using namespace pg8;
    if (IN(0)) REP(0) {
        mod_items((LAS float*)lds, a.in[I_C], a.in[I_WADA], a.in[I_BADA], mod);
        LAS float* buf = (LAS float*)lds; int rot = 0;
        conv_job(buf, rot, a.in[I_W1IN], 2 * DFF, D, 2 * DFF, W1IN, D, 0, 1);
        conv_job(buf, rot, a.in[I_W1OUT], D, DFF, D, W1OUT, DFF, 0, 0);
        conv_job(buf, rot, a.in[I_WIN], 9216, D, 8192, WINM, D, 0, 2);
        conv_job(buf, rot, a.in[I_WIN], 9216, D, 1024, WV, D, 0, 3);
        conv_job(buf, rot, a.in[I_WBA], D, 1024, D, WBR, D, 0, 0);
        conv_job(buf, rot, a.in[I_WBL], D, 1024, D, WBR, D, 1024, 0);
        conv_job(buf, rot, a.in[I_WOUT], D, D, D, WO, D, 0, 0);
        conv_job(buf, rot, a.in[I_WRG], 128, 128, 1024, WG, 128, 0, 4);
        conv_job(buf, rot, a.in[I_WIG], 128, 128, 1024, WG + 8 * 128 * 128, 128, 0, 4);
        conv_job(buf, rot, a.in[I_W2IN], 2 * DFF, D, 2 * DFF, W2IN, D, 0, 1);
        conv_job(buf, rot, a.in[I_W2OUT], D, DFF, D, W2OUT, DFF, 0, 0);
    }
    SEAM(0);
#ifdef EXTRA_SYNCS
    for (int es = 0; es < EXTRA_SYNCS; ++es) xcd_barrier(xbar);
#endif
    if (IN(1)) REP(1) norm_phase<false>(a.in[I_X], a.in[I_N1], mod, 0, Y, nullptr);
    SEAM(1);
    if (IN(2) && ((DUPMASK >> 2) & 1)) { Gemm g{Y, W1IN, T, 2 * DFF, D}; StaticOrder S; S.init(T, 2 * DFF, G, bx); EpiSwiGLU E{Hb}; gemm_phase<EpiSwiGLU, StaticOrder, true, true>(lds, g, S, E); }
    if (IN(2)) { Gemm g{Y, W1IN, T, 2 * DFF, D}; StaticOrder S; S.init(T, 2 * DFF, G, bx); EpiSwiGLU E{Hb}; gemm_phase<EpiSwiGLU, StaticOrder, true, true>(lds, g, S, E); }
    SEAM(2);
    if (IN(3) && ((DUPMASK >> 3) & 1)) { Gemm g{Hb, W1OUT, T, D, DFF}; StaticOrder S; S.init(T, D, G, bx, 4); EpiResid E{a.in[I_X], out, mod + 2 * D, 0.5f}; gemm_phase<EpiResid, StaticOrder, true, true>(lds, g, S, E); }
    if (IN(3)) { Gemm g{Hb, W1OUT, T, D, DFF}; StaticOrder S; S.init(T, D, G, bx, 4); EpiResid E{a.in[I_X], out, mod + 2 * D, 0.5f}; gemm_phase<EpiResid, StaticOrder, true, true>(lds, g, S, E); }
    SEAM(3);
    if (IN(4)) norm_phase<false>(out, a.in[I_NMIX], mod, 3, Y, nullptr);
    SEAM(4);
    if (IN(5)) {
        { Gemm g{Y, WINM, T, 8192, D}; StaticOrder S; S.init(T, 8192, G, bx); EpiP E{P, PW, 4, QSCALE}; gemm_phase<EpiP, StaticOrder, true, true>(lds, g, S, E); }
        { Gemm g{WV, Y, 1024, T, D}; StaticOrder S; S.init(1024, T, G, bx); EpiP E{VT, T, 0, 1.0f}; gemm_phase<EpiP, StaticOrder, true, true>(lds, g, S, E); }
    }
    SEAM(5);
    LruP lq{P, WG, a.in[I_CONVW], a.in[I_CONVB], a.in[I_BRG], a.in[I_BIG], a.in[I_LAM], lsum, YM};
    if (IN(6)) {
        REP(6) for (int p0 = bx; p0 < 256; p0 += G) { const int p = (G == 256) ? ((p0 & 7) * 32 + (p0 >> 3)) : p0;
            const int bh = p >> 3, jp = p & 7; attn_item(lds, P, VT, YM, bh >> 3, bh & 7, 15 - jp); attn_item(lds, P, VT, YM, bh >> 3, bh & 7, jp); }
        REP(14) for (int it = bx; it < 2048; it += G) lru_item(lds, lq, it >> 3, it & 7, 1);
    }
    SEAM(6);
    if (IN(7)) REP(7) { for (int it = bx; it < 2048; it += G) lru_item(lds, lq, it >> 3, it & 7, 2); }
    SEAM(7);
    if (IN(8)) { Gemm g{YM, WBR, T, D, D}; StaticOrder S; S.init(T, D, G, bx, 4); EpiBranch E{P, MG}; gemm_phase<EpiBranch, StaticOrder, true, true>(lds, g, S, E); }
    SEAM(8);
    if (IN(9)) { Gemm g{MG, WO, T, D, D}; StaticOrder S; S.init(T, D, G, bx, 4); EpiResid E{out, out, mod + 5 * D, 1.0f}; gemm_phase<EpiResid, StaticOrder, true, true>(lds, g, S, E); }
    SEAM(9);
    if (IN(10)) norm_phase<false>(out, a.in[I_N2], mod, 6, Y, nullptr);
    SEAM(10);
    if (IN(11)) { Gemm g{Y, W2IN, T, 2 * DFF, D}; StaticOrder S; S.init(T, 2 * DFF, G, bx); EpiSwiGLU E{Hb}; gemm_phase<EpiSwiGLU, StaticOrder, true, true>(lds, g, S, E); }
    SEAM(11);
    if (IN(12)) { Gemm g{Hb, W2OUT, T, D, DFF}; StaticOrder S; S.init(T, D, G, bx, 4); EpiResid E{out, out, mod + 8 * D, 0.5f}; gemm_phase<EpiResid, StaticOrder, true, true>(lds, g, S, E); }
    SEAM(12);
    if (IN(13)) norm_phase<true>(out, a.in[I_NF], mod, 0, nullptr, out);
}

#ifndef ONE_LAUNCH
#define ONE_LAUNCH 1
#endif
extern "C" void kernel_launch(void* const* d_in, const int* in_sizes, int n_in, void* d_out, int out_size, void* d_ws, size_t ws_size, hipStream_t stream) {
    static int grid = 0;
    if (grid == 0) {
        if (n_in != 23 || out_size != T * D || ws_size < WS_END) { fprintf(stderr, "kernel_launch: unexpected shapes (n_in %d out %d ws %zu need %zu)\n", n_in, out_size, ws_size, (size_t)WS_END); grid = -1; return; }
        int dev = 0, cus = 0, per_cu = 0;
        hipGetDevice(&dev); hipDeviceGetAttribute(&cus, hipDeviceAttributeMultiprocessorCount, dev);
        if (hipFuncSetAttribute((const void*)fwd, hipFuncAttributeMaxDynamicSharedMemorySize, LDS_BYTES) != hipSuccess) { fprintf(stderr, "kernel_launch: hipFuncSetAttribute failed\n"); grid = -1; return; }
        if (hipOccupancyMaxActiveBlocksPerMultiprocessor(&per_cu, (const void*)fwd, 512, LDS_BYTES) != hipSuccess || per_cu < 1) { fprintf(stderr, "kernel_launch: occupancy query says %d\n", per_cu); per_cu = 1; }
        (void)hipGetLastError();
        grid = cus * per_cu;
        if (grid > 256) grid = 256;
    }
    if (grid < 0) return;
    Args a{};
    for (int i = 0; i < 23; ++i) a.in[i] = (const float*)d_in[i];
    a.out = (float*)d_out; a.ws = (unsigned char*)d_ws;
#if ONE_LAUNCH
    if (hipMemsetAsync((char*)d_ws + WS_BAR, 0, 16384, stream) != hipSuccess) { fprintf(stderr, "kernel_launch: memset of the barrier words failed\n"); return; }
    a.ph_lo = 0; a.ph_hi = NPH;
    void* args[] = {&a};
    hipError_t e = hipLaunchCooperativeKernel((const void*)fwd, dim3(grid), dim3(512), args, LDS_BYTES, stream);
    if (e != hipSuccess) fprintf(stderr, "cooperative launch failed: %s (grid %d)\n", hipGetErrorString(e), grid);
#else
    for (int ph = 0; ph < NPH; ++ph) { a.ph_lo = ph; a.ph_hi = ph + 1; hipLaunchKernelGGL(fwd, dim3(grid), dim3(512), LDS_BYTES, stream, a); }
#endif
}
```

```cpp
#include <hip/hip_runtime.h>
#include <hip/hip_cooperative_groups.h>
#include <cstdio>
#include <cstdint>
namespace cg = cooperative_groups;

#define DI __device__ __forceinline__
#define LAS __attribute__((address_space(3)))

constexpr int T = 16384, D = 2048, DFF = 5632, SEQ = 4096;
constexpr int NMOD = 9 * D;
constexpr int PW = 8192;
constexpr float EPS = 1e-6f;
constexpr float LOG2E = 1.4426950408889634f;
constexpr float QSCALE = 0.08838834764831845f * 1.4426950408889634f;
constexpr int LDS_MAIN = 131072;
constexpr int LDS_BYTES = LDS_MAIN + 16;

constexpr size_t WS_BAR   = 0;
constexpr size_t WS_MOD   = 16384;
constexpr size_t WS_LSUM  = WS_MOD + (size_t)4 * NMOD * 4;
constexpr size_t WS_W1IN  = WS_LSUM + (size_t)256 * 1024 * 8;
constexpr size_t WS_W1OUT = WS_W1IN + (size_t)2 * DFF * D * 2;
constexpr size_t WS_W2IN  = WS_W1OUT + (size_t)D * DFF * 2;
constexpr size_t WS_W2OUT = WS_W2IN + (size_t)2 * DFF * D * 2;
constexpr size_t WS_WINM  = WS_W2OUT + (size_t)D * DFF * 2;
constexpr size_t WS_WV    = WS_WINM + (size_t)8192 * D * 2;
constexpr size_t WS_WBR   = WS_WV + (size_t)1024 * D * 2;
constexpr size_t WS_WO    = WS_WBR + (size_t)D * D * 2;
constexpr size_t WS_WG    = WS_WO + (size_t)D * D * 2;
constexpr size_t WS_Y     = WS_WG + (size_t)2 * 8 * 128 * 128 * 2;
constexpr size_t WS_P     = WS_Y + (size_t)T * D * 2;
constexpr size_t WS_VT    = WS_P + (size_t)T * PW * 2;
constexpr size_t WS_YM    = WS_VT + (size_t)1024 * T * 2;
constexpr size_t WS_END   = WS_YM + (size_t)T * D * 2;

typedef unsigned short bf16_t;
typedef short bf16x8 __attribute__((ext_vector_type(8)));
typedef float f32x4 __attribute__((ext_vector_type(4)));
typedef float f32x16 __attribute__((ext_vector_type(16)));
typedef float f32x2v __attribute__((ext_vector_type(2)));
typedef __bf16 bf16x2v __attribute__((ext_vector_type(2)));
typedef unsigned u32x4 __attribute__((ext_vector_type(4)));
typedef unsigned u32x2 __attribute__((ext_vector_type(2)));

DI unsigned pk_bf16(float lo, float hi) { f32x2v f = {lo, hi}; bf16x2v b = __builtin_convertvector(f, bf16x2v); return __builtin_bit_cast(unsigned, b); }
DI bf16_t to_bf16(float x) { return (bf16_t)(pk_bf16(x, 0.f) & 0xffffu); }
DI float bf_lo(unsigned u) { return __uint_as_float(u << 16); }
DI float bf_hi(unsigned u) { return __uint_as_float(u & 0xffff0000u); }
DI float bf_f(bf16_t h) { return __uint_as_float(((unsigned)h) << 16); }
DI float fast_exp2(float x) { return __builtin_amdgcn_exp2f(x); }
DI float fast_rcp(float x) { return __builtin_amdgcn_rcpf(x); }
DI float sigmoidf_(float x) { return fast_rcp(1.0f + fast_exp2(-x * LOG2E)); }

namespace pg8 {
#define PG8_LAS __attribute__((address_space(3)))
constexpr int BM = 256, BK = 64, HALF = 128, HTB = HALF * BK * 2, STAGE_BYTES = 8 * HTB, NXCD = 8, WGM = 8;
__host__ __device__ __forceinline__ int lds_byte(int r, int c) { const int st = (r >> 4) * 2 + (c >> 5), rr = r & 15, cc = c & 31, ob = rr * 64 + cc * 2; return st * 1024 + (ob ^ (((ob >> 9) & 1) << 5)); }
__host__ __device__ __forceinline__ void stage_rc(int b, int& R, int& C) { const int st = b / 1024, sb = b % 1024, swz = sb ^ (((sb >> 9) & 1) << 5); R = (st >> 1) * 16 + swz / 64; C = (st & 1) * 32 + (swz % 64) / 2; }
__host__ __device__ __forceinline__ int perm32(int rho) { const int n = rho >> 4, i = rho & 15; return 8 * (i >> 2) + 4 * n + (i & 3); }
struct Unit { int pm, pn; };
struct Gemm { const bf16_t* A; const bf16_t* Bt; int M, N, K; };
struct StaticOrder {
    int nM, nN, nwg, G, c, wgm;
    __host__ __device__ void init(int M, int N, int G_, int c_, int wgm_ = WGM) { nM = M / BM; nN = N / BM; nwg = nM * nN; G = G_; c = c_; wgm = wgm_; }
    __host__ __device__ bool next(int i, Unit& u) const {
        const long L = (long)i * G + c; if (L >= nwg) return false;
        int wgid = (int)L; { const int q = nwg / NXCD, r = nwg % NXCD, xcd = wgid % NXCD, off = wgid / NXCD; wgid = (xcd < r ? xcd * (q + 1) : r * (q + 1) + (xcd - r) * q) + off; }
        const int nig = wgm * nN, gid = wgid / nig, fm = gid * wgm, gsz = (nM - fm) < wgm ? (nM - fm) : wgm;
        u.pm = fm + ((wgid % nig) % gsz); u.pn = (wgid % nig) / gsz; return true;
    }
    __device__ __forceinline__ void a_ready(const Unit&) const {}
    __device__ __forceinline__ void done(const Unit&) const {}
};

struct EpiSwiGLU {
    static constexpr bool PERM = true, AFTER_DRAIN = false, MID = false;
    bf16_t* H;
    DI void mid(f32x4 (&)[2][2][4][2], const Unit&, int, int, int, int) const {}
    DI void operator()(const f32x4 (&acc)[2][2][4][2], const Unit& u, int wr, int wc, int fr, int fq) const {
        const int row0 = u.pm * BM + wr * 64 + fr, col0 = u.pn * HALF + wc * 32 + 8 * fq;
#pragma unroll
        for (int ai = 0; ai < 2; ++ai)
#pragma unroll
            for (int m = 0; m < 4; ++m) {
                float o[8];
#pragma unroll
                for (int n = 0; n < 2; ++n)
#pragma unroll
                    for (int j = 0; j < 4; ++j) { const float g = acc[ai][0][m][n][j], up = acc[ai][1][m][n][j]; o[n * 4 + j] = g * sigmoidf_(g) * up; }
                u32x4 w; w.x = pk_bf16(o[0], o[1]); w.y = pk_bf16(o[2], o[3]); w.z = pk_bf16(o[4], o[5]); w.w = pk_bf16(o[6], o[7]);
                *(u32x4*)(H + (size_t)(row0 + ai * HALF + m * 16) * DFF + col0) = w;
            }
    }
};
struct EpiResid {
    static constexpr bool PERM = false, AFTER_DRAIN = false, MID = false;
    const float* resid; float* out; const float* gmod; float coef;
    DI void mid(f32x4 (&)[2][2][4][2], const Unit&, int, int, int, int) const {}
    DI void operator()(const f32x4 (&acc)[2][2][4][2], const Unit& u, int wr, int wc, int fr, int fq) const {
        const int row0 = u.pm * BM + wr * 64 + fr, col0 = u.pn * BM + wc * 32 + 4 * fq;
        const float* gv = gmod + (size_t)(u.pm >> 4) * NMOD + col0;
        f32x4 g[2][2];
#pragma unroll
        for (int bj = 0; bj < 2; ++bj)
#pragma unroll
            for (int n = 0; n < 2; ++n) g[bj][n] = *(const f32x4*)(gv + bj * HALF + n * 16) * coef;
#pragma unroll
        for (int ai = 0; ai < 2; ++ai)
#pragma unroll
            for (int m = 0; m < 4; ++m) { const size_t off = (size_t)(row0 + ai * HALF + m * 16) * D + col0;
#pragma unroll
                for (int bj = 0; bj < 2; ++bj)
#pragma unroll
                    for (int n = 0; n < 2; ++n) { const f32x4 r = *(const f32x4*)(resid + off + bj * HALF + n * 16); *(f32x4*)(out + off + bj * HALF + n * 16) = r + g[bj][n] * acc[ai][bj][m][n]; }
                asm volatile("" ::: "memory"); }
    }
};
struct EpiP {
    static constexpr bool PERM = true, AFTER_DRAIN = false, MID = false;
    bf16_t* O; int ldc; int nscale; float scale;
    DI void mid(f32x4 (&)[2][2][4][2], const Unit&, int, int, int, int) const {}
    DI void operator()(const f32x4 (&acc)[2][2][4][2], const Unit& u, int wr, int wc, int fr, int fq) const {
        const int row0 = u.pm * BM + wr * 64 + fr, col0 = u.pn * BM + wc * 32 + 8 * fq;
        const float s = (u.pn < nscale) ? scale : 1.0f;
#pragma unroll
        for (int ai = 0; ai < 2; ++ai)
#pragma unroll
            for (int m = 0; m < 4; ++m) { bf16_t* p = O + (size_t)(row0 + ai * HALF + m * 16) * ldc + col0;
#pragma unroll
                for (int bj = 0; bj < 2; ++bj) { const f32x4 v0 = acc[ai][bj][m][0] * s, v1 = acc[ai][bj][m][1] * s;
                    u32x4 w; w.x = pk_bf16(v0[0], v0[1]); w.y = pk_bf16(v0[2], v0[3]); w.z = pk_bf16(v1[0], v1[1]); w.w = pk_bf16(v1[2], v1[3]);
                    *(u32x4*)(p + bj * HALF) = w; } }
    }
};
struct EpiBranch {
    #ifdef TEST_NOMID
    static constexpr bool PERM = true, AFTER_DRAIN = false, MID = false;
#else
    static constexpr bool PERM = true, AFTER_DRAIN = false, MID = true;
#endif
    const bf16_t* P; bf16_t* O;
    DI static float cl(float x) { return fminf(fmaxf(x, -60.f), 60.f); }
    DI void mid(f32x4 (&acc)[2][2][4][2], const Unit& u, int wr, int wc, int fr, int fq) const {
        int row0 = u.pm * BM + wr * 64 + fr, col0 = u.pn * BM + wc * 32 + 8 * fq;
        asm volatile("" : "+v"(row0), "+v"(col0));
#pragma unroll
        for (int ai = 0; ai < 2; ++ai)
#pragma unroll
            for (int m = 0; m < 4; ++m) { const bf16_t* gp = P + (size_t)(row0 + ai * HALF + m * 16) * PW + 4096 + col0;
#pragma unroll
                for (int bj = 0; bj < 2; ++bj) { const u32x4 ga = *(const u32x4*)(gp + bj * HALF), gl = *(const u32x4*)(gp + 2048 + bj * HALF);
#pragma unroll
                    for (int q = 0; q < 4; ++q) { const float a0 = cl(bf_lo(ga[q])), a1 = cl(bf_hi(ga[q])), l0 = cl(bf_lo(gl[q])), l1 = cl(bf_hi(gl[q]));
                        const float r0 = (1.0f + fast_exp2(-l0 * LOG2E)) * fast_rcp(1.0f + fast_exp2(-a0 * LOG2E));
                        const float r1 = (1.0f + fast_exp2(-l1 * LOG2E)) * fast_rcp(1.0f + fast_exp2(-a1 * LOG2E));
                        acc[ai][bj][m][q >> 1][(q & 1) * 2] *= r0; acc[ai][bj][m][q >> 1][(q & 1) * 2 + 1] *= r1; } }
                asm volatile("" ::: "memory"); }
    }
    DI void operator()(const f32x4 (&acc)[2][2][4][2], const Unit& u, int wr, int wc, int fr, int fq) const {
        const int row0 = u.pm * BM + wr * 64 + fr, col0 = u.pn * BM + wc * 32 + 8 * fq;
#pragma unroll
        for (int ai = 0; ai < 2; ++ai)
#pragma unroll
            for (int m = 0; m < 4; ++m) { const size_t r = (size_t)(row0 + ai * HALF + m * 16); const bf16_t* gp = P + r * PW + 6144 + col0;
#pragma unroll
                for (int bj = 0; bj < 2; ++bj) { const u32x4 gl = *(const u32x4*)(gp + bj * HALF); float o[8];
#pragma unroll
                    for (int q = 0; q < 4; ++q) { const float l0 = cl(bf_lo(gl[q])), l1 = cl(bf_hi(gl[q]));
                        o[q * 2] = acc[ai][bj][m][q >> 1][(q & 1) * 2] * fast_rcp(1.0f + fast_exp2(-l0 * LOG2E));
                        o[q * 2 + 1] = acc[ai][bj][m][q >> 1][(q & 1) * 2 + 1] * fast_rcp(1.0f + fast_exp2(-l1 * LOG2E)); }
                    u32x4 w; w.x = pk_bf16(o[0], o[1]); w.y = pk_bf16(o[2], o[3]); w.z = pk_bf16(o[4], o[5]); w.w = pk_bf16(o[6], o[7]);
                    *(u32x4*)(O + r * D + col0 + bj * HALF) = w; }
                asm volatile("" ::: "memory"); }
    }
};

template <class Epi, class Sched, bool ALIGN_EPI = false, bool SP2 = false>
__device__ __forceinline__ void gemm_phase(PG8_LAS unsigned char* lds, const Gemm g, const Sched& S, const Epi& E) {
    const int tid = threadIdx.x, wid = __builtin_amdgcn_readfirstlane(tid >> 6), lane = tid & 63, wr = wid >> 2, wc = wid & 3, fr = lane & 15, fq = lane >> 4;
    const int K = g.K, nt = K / BK;
    unsigned voffA[2], voffB[2];
#pragma unroll
    for (int i = 0; i < 2; ++i) { int R, C; stage_rc(tid * 16 + i * 8192, R, C); const int Rb = Epi::PERM ? ((R & ~31) + perm32(R & 31)) : R;
        voffA[i] = (unsigned)(R * K + C) * 2u; voffB[i] = (unsigned)(Rb * K + C) * 2u; }
    const size_t kstep = (size_t)(BK * 2);
    const size_t hstep = (size_t)HALF * K * 2;
    const size_t tstep = 2 * hstep;
    const unsigned ldsw = (unsigned)wid * 1024u;
    const int aoff = lds_byte(wr * 64 + fr, fq * 8), boff = lds_byte(wc * 32 + fr, fq * 8);
#define PG8_SA(b, h) (((b) * 2 + (h)) * HTB)
#define PG8_SB(b, h) ((4 + (b) * 2 + (h)) * HTB)
#define PG8_STAGE(bufoff, gbase, voff) do { _Pragma("unroll") for (int _i = 0; _i < 2; ++_i) \
        __builtin_amdgcn_global_load_lds((const unsigned*)((const char*)(gbase) + (voff)[_i]), (PG8_LAS unsigned*)(lds + (bufoff) + ldsw + _i * 8192), 16, 0, 0); } while (0)
#define PG8_LDA(dst, b, h) do { _Pragma("unroll") for (int m = 0; m < 4; ++m) _Pragma("unroll") for (int k = 0; k < 2; ++k) dst[m][k] = *(const PG8_LAS bf16x8*)(lds + PG8_SA(b, h) + aoff + m * 2048 + k * 1024); } while (0)
#define PG8_LDB(dst, b, h) do { _Pragma("unroll") for (int n = 0; n < 2; ++n) _Pragma("unroll") for (int k = 0; k < 2; ++k) dst[n][k] = *(const PG8_LAS bf16x8*)(lds + PG8_SB(b, h) + boff + n * 2048 + k * 1024); } while (0)
#define PG8_MMA(ai, bj, At, Bt) do { __builtin_amdgcn_s_setprio(1); _Pragma("unroll") for (int m = 0; m < 4; ++m) _Pragma("unroll") for (int n = 0; n < 2; ++n) _Pragma("unroll") for (int k = 0; k < 2; ++k) \
        acc[ai][bj][m][n] = __builtin_amdgcn_mfma_f32_16x16x32_bf16(Bt[n][k], At[m][k], acc[ai][bj][m][n], 0, 0, 0); __builtin_amdgcn_s_setprio(0); } while (0)
#define PG8_WAIT_V(n) asm volatile("s_waitcnt vmcnt(" #n ")" ::: "memory")
#define PG8_WAIT_L(n) asm volatile("s_waitcnt lgkmcnt(" #n ")" ::: "memory")
#define PG8_BAR __builtin_amdgcn_s_barrier()
#define PG8_SCHED __builtin_amdgcn_sched_barrier(0)
    Unit cur, nxt; int ui = 0;
    if (!S.next(0, cur)) return;
    f32x4 acc[2][2][4][2];
#pragma unroll
    for (int a = 0; a < 2; ++a)
#pragma unroll
        for (int b = 0; b < 2; ++b)
#pragma unroll
            for (int m = 0; m < 4; ++m)
#pragma unroll
                for (int n = 0; n < 2; ++n) acc[a][b][m][n] = (f32x4){0.f, 0.f, 0.f, 0.f};
    bf16x8 At[4][2], B0[2][2], B1[2][2];
    const char* cA = (const char*)g.A + (size_t)cur.pm * tstep; const char* cB = (const char*)g.Bt + (size_t)cur.pn * tstep;
    S.a_ready(cur);
    if constexpr (SP2) {
        PG8_STAGE(PG8_SB(0, 0), cB, voffB); PG8_STAGE(PG8_SB(0, 1), cB + hstep, voffB); PG8_STAGE(PG8_SA(0, 0), cA, voffA); PG8_STAGE(PG8_SA(0, 1), cA + hstep, voffA);
        if (wr == 1) PG8_BAR;
        PG8_WAIT_V(2); PG8_BAR;
        PG8_STAGE(PG8_SB(1, 0), cB + kstep, voffB); PG8_STAGE(PG8_SA(1, 0), cA + kstep, voffA); PG8_STAGE(PG8_SB(1, 1), cB + hstep + kstep, voffB);
        PG8_WAIT_V(6); PG8_BAR;
    } else {
        PG8_STAGE(PG8_SB(0, 0), cB, voffB); PG8_STAGE(PG8_SA(0, 0), cA, voffA); PG8_STAGE(PG8_SB(0, 1), cB + hstep, voffB); PG8_STAGE(PG8_SA(0, 1), cA + hstep, voffA);
        if (wr == 1) PG8_BAR;
        PG8_WAIT_V(4); PG8_BAR;
        PG8_STAGE(PG8_SB(1, 0), cB + kstep, voffB); PG8_STAGE(PG8_SA(1, 0), cA + kstep, voffA); PG8_STAGE(PG8_SB(1, 1), cB + hstep + kstep, voffB);
        PG8_WAIT_V(6); PG8_BAR;
    }
    for (;;) {
        const bool has_next = S.next(ui + 1, nxt);
        const char* nA = has_next ? (const char*)g.A + (size_t)nxt.pm * tstep : cA; const char* nB = has_next ? (const char*)g.Bt + (size_t)nxt.pn * tstep : cB;
        for (int t = 0; t < nt; t += 2) {
            const bool last = (t == nt - 2);
            const char* a1 = cA + (size_t)(t + 1) * kstep;
            const char* a2 = last ? nA : cA + (size_t)(t + 2) * kstep; const char* b2 = last ? nB : cB + (size_t)(t + 2) * kstep;
            const char* a3 = a2 + kstep; const char* b3 = b2 + kstep;
            if (last && has_next) S.a_ready(nxt);
            if constexpr (Epi::MID) { PG8_SCHED; if (t == nt / 2) E.mid(acc, cur, wr, wc, fr, fq); PG8_SCHED; }
            if constexpr (SP2) {
            PG8_LDB(B0, 0, 0); PG8_LDB(B1, 0, 1); PG8_SCHED; PG8_LDA(At, 0, 0); PG8_STAGE(PG8_SA(1, 1), a1 + hstep, voffA);
            PG8_WAIT_V(8); PG8_WAIT_L(0); PG8_BAR; PG8_MMA(0, 0, At, B0); PG8_MMA(0, 1, At, B1); PG8_BAR; PG8_SCHED;
            PG8_LDA(At, 0, 1); PG8_STAGE(PG8_SB(0, 0), b2, voffB); PG8_STAGE(PG8_SB(0, 1), b2 + hstep, voffB); PG8_STAGE(PG8_SA(0, 0), a2, voffA);
            PG8_WAIT_V(8); PG8_WAIT_L(0); PG8_BAR; PG8_MMA(1, 0, At, B0); PG8_MMA(1, 1, At, B1); PG8_BAR; PG8_SCHED;
            PG8_LDB(B0, 1, 0); PG8_LDB(B1, 1, 1); PG8_SCHED; PG8_LDA(At, 1, 0); PG8_STAGE(PG8_SA(0, 1), a2 + hstep, voffA);
            PG8_WAIT_V(8); PG8_WAIT_L(0); PG8_BAR; PG8_MMA(0, 0, At, B0); PG8_MMA(0, 1, At, B1); PG8_BAR; PG8_SCHED;
            PG8_LDA(At, 1, 1); PG8_STAGE(PG8_SB(1, 0), b3, voffB); PG8_STAGE(PG8_SB(1, 1), b3 + hstep, voffB); PG8_STAGE(PG8_SA(1, 0), a3, voffA);
            PG8_WAIT_V(8); PG8_WAIT_L(0); PG8_BAR; PG8_MMA(1, 0, At, B0); PG8_MMA(1, 1, At, B1); PG8_BAR; PG8_SCHED;
            } else {
            PG8_LDB(B0, 0, 0); PG8_SCHED; PG8_LDA(At, 0, 0); PG8_STAGE(PG8_SA(1, 1), a1 + hstep, voffA);
            PG8_WAIT_L(8); PG8_BAR; PG8_WAIT_L(0); PG8_MMA(0, 0, At, B0); PG8_BAR; PG8_SCHED;
            PG8_LDB(B1, 0, 1); PG8_STAGE(PG8_SB(0, 0), b2, voffB);
            PG8_BAR; PG8_WAIT_L(0); PG8_MMA(0, 1, At, B1); PG8_BAR;
            PG8_LDA(At, 0, 1); PG8_STAGE(PG8_SA(0, 0), a2, voffA);
            PG8_BAR; PG8_WAIT_L(0); PG8_MMA(1, 0, At, B0); PG8_BAR; PG8_SCHED;
            PG8_STAGE(PG8_SB(0, 1), b2 + hstep, voffB);
            PG8_WAIT_V(6); PG8_BAR; PG8_MMA(1, 1, At, B1); PG8_BAR;
            PG8_LDB(B0, 1, 0); PG8_SCHED; PG8_LDA(At, 1, 0); PG8_STAGE(PG8_SA(0, 1), a2 + hstep, voffA);
            PG8_WAIT_L(8); PG8_BAR; PG8_WAIT_L(0); PG8_MMA(0, 0, At, B0); PG8_BAR; PG8_SCHED;
            PG8_LDB(B1, 1, 1); PG8_STAGE(PG8_SB(1, 0), b3, voffB);
            PG8_BAR; PG8_WAIT_L(0); PG8_MMA(0, 1, At, B1); PG8_BAR;
            PG8_LDA(At, 1, 1); PG8_STAGE(PG8_SA(1, 0), a3, voffA);
            PG8_BAR; PG8_WAIT_L(0); PG8_MMA(1, 0, At, B0); PG8_BAR; PG8_SCHED;
            PG8_STAGE(PG8_SB(1, 1), b3 + hstep, voffB);
            PG8_WAIT_V(6); PG8_BAR; PG8_MMA(1, 1, At, B1); PG8_BAR;
            }
        }
        if constexpr (ALIGN_EPI) { if (wr == 0) PG8_BAR; }
        if constexpr (!Epi::AFTER_DRAIN) { E(acc, cur, wr, wc, fr, fq); S.done(cur); }
        if (!has_next) break;
#pragma unroll
        for (int a = 0; a < 2; ++a)
#pragma unroll
            for (int b = 0; b < 2; ++b)
#pragma unroll
                for (int m = 0; m < 4; ++m)
#pragma unroll
                    for (int n = 0; n < 2; ++n) acc[a][b][m][n] = (f32x4){0.f, 0.f, 0.f, 0.f};
        cur = nxt; cA = nA; cB = nB; ++ui;
        if constexpr (ALIGN_EPI) { if (wr == 1) PG8_BAR; }
    }
    PG8_WAIT_V(0);
    if constexpr (!ALIGN_EPI) { if (wr == 0) PG8_BAR; }
    PG8_BAR;
    if constexpr (Epi::AFTER_DRAIN) { E.fused(acc, cur, wr, wc, fr, fq, lds, wid, lane); S.done(cur); }
#undef PG8_SA
#undef PG8_SB
#undef PG8_STAGE
#undef PG8_LDA
#undef PG8_LDB
#undef PG8_MMA
#undef PG8_WAIT_V
#undef PG8_WAIT_L
#undef PG8_BAR
#undef PG8_SCHED
}
}

#define XB_TMO      128
#define XB_XCNT(j)  (256  + 64 * (j))
#define XB_XSUB(j)  (1280 + 64 * (j))
#define XB_XGEN(j)  (2304 + 64 * (j))
#define XB_TOP      3328
#define XB_TOPGEN   3392
#define XCD_BAR_WORDS 3456
#define XB_SPIN_CAP (1u << 18)

__device__ __forceinline__ unsigned xb_ld(unsigned* p)              { return __hip_atomic_load(p, __ATOMIC_RELAXED, __HIP_MEMORY_SCOPE_AGENT); }
__device__ __forceinline__ unsigned xb_add(unsigned* p, unsigned v) { return __hip_atomic_fetch_add(p, v, __ATOMIC_RELAXED, __HIP_MEMORY_SCOPE_AGENT); }
__device__ __forceinline__ unsigned xb_xcc_id() { return (unsigned)__builtin_amdgcn_s_getreg((3 << 11) | 20) & 0xFu; }
#define XB_SPIN(cond, bar) do { unsigned _sp = 0; while (cond) { __builtin_amdgcn_s_sleep(1); \
    if ((++_sp & 255u) == 0u) { if (xb_ld(&(bar)[XB_TMO])) break; if (_sp > XB_SPIN_CAP) { atomicAdd(&(bar)[XB_TMO], 1u); break; } } } } while (0)

struct XcdBarrier {
    unsigned* bar; unsigned x;
    volatile LAS unsigned* st;
};

__device__ __forceinline__ XcdBarrier xcd_barrier_post(unsigned* bar, volatile LAS unsigned* st) {
    XcdBarrier b; b.bar = bar; b.x = xb_xcc_id(); b.st = st;
    if (threadIdx.x == 0) (void)xb_add(&bar[XB_XCNT(b.x)], 1u);
    return b;
}
__device__ __forceinline__ void xcd_barrier_complete(unsigned* bar, unsigned x, unsigned& nloc, unsigned& nx) {
    const unsigned G = gridDim.x * gridDim.y * gridDim.z;
    unsigned sum, cnt, mine, sp = 0u;
    for (;;) {
        sum = 0u; cnt = 0u; mine = 0u;
#pragma unroll
        for (unsigned j = 0; j < 16; ++j) { const unsigned c = xb_ld(&bar[XB_XCNT(j)]); sum += c; cnt += (c > 0u) ? 1u : 0u; mine = (j == x) ? c : mine; }
        if (sum == G) break;
        __builtin_amdgcn_s_sleep(1);
        if ((++sp & 255u) == 0u) { if (xb_ld(&bar[XB_TMO])) break; if (sp > XB_SPIN_CAP) { atomicAdd(&bar[XB_TMO], 1u); break; } }
    }
    nloc = mine > 0u ? mine : 1u; nx = cnt > 0u ? cnt : 1u;
}

__device__ __forceinline__ void xcd_barrier(const XcdBarrier& b) {
    asm volatile("s_waitcnt vmcnt(0)" ::: "memory");
    __syncthreads();
    if (threadIdx.x == 0) {
        unsigned* bar = b.bar;
        __builtin_amdgcn_s_waitcnt(0);
        unsigned nloc = b.st[0], nx = b.st[1];
        if (nloc == 0u) { xcd_barrier_complete(bar, b.x, nloc, nx); b.st[0] = nloc; b.st[1] = nx; }
        const unsigned old = xb_add(&bar[XB_XSUB(b.x)], 1u);
        const unsigned gen = old / nloc;
        if (old + 1u == (gen + 1u) * nloc) {
            __builtin_amdgcn_fence(__ATOMIC_RELEASE, "agent");
            asm volatile("s_waitcnt vmcnt(0)" ::: "memory");
            const unsigned og = xb_add(&bar[XB_TOP], 1u);
            const unsigned tg = og / nx;
            if (og + 1u == (tg + 1u) * nx) xb_add(&bar[XB_TOPGEN], 1u);
            else XB_SPIN(xb_ld(&bar[XB_TOPGEN]) == tg, bar);
            __builtin_amdgcn_fence(__ATOMIC_ACQUIRE, "agent");
            xb_add(&bar[XB_XGEN(b.x)], 1u);
            asm volatile("s_waitcnt vmcnt(0)" ::: "memory");
        } else {
            XB_SPIN(xb_ld(&bar[XB_XGEN(b.x)]) == gen, bar);
            __builtin_amdgcn_fence(__ATOMIC_ACQUIRE, "agent");
            asm volatile("s_waitcnt vmcnt(0)" ::: "memory");
        }
    }
    __syncthreads();
}


struct Args { const float* in[23]; float* out; unsigned char* ws; int ph_lo, ph_hi; };
enum { I_X = 0, I_C, I_WADA, I_BADA, I_N1, I_W1IN, I_W1OUT, I_NMIX, I_WIN, I_CONVW, I_CONVB, I_WRG, I_BRG, I_WIG, I_BIG, I_LAM, I_WBA, I_WBL, I_WOUT, I_N2, I_W2IN, I_W2OUT, I_NF };

DI void conv_tile(LAS float* buf, const float* src, int lds_, bf16_t* dst, int ldd) {
    const int tid = threadIdx.x;
    float4 v[8];
#pragma unroll
    for (int i = 0; i < 8; ++i) { const int k = (tid >> 4) + 32 * i, cgp = tid & 15; v[i] = *(const float4*)(src + (size_t)k * lds_ + cgp * 4); }
#pragma unroll
    for (int i = 0; i < 8; ++i) { const int k = (tid >> 4) + 32 * i, cgp = tid & 15; LAS float* p = buf + k * 65 + cgp * 4; p[0] = v[i].x; p[1] = v[i].y; p[2] = v[i].z; p[3] = v[i].w; }
    __syncthreads();
#pragma unroll
    for (int i = 0; i < 4; ++i) { const int q = tid + 512 * i, g = q >> 6, kg = (g & 3) * 8 + (q & 7), n = (g >> 2) * 8 + ((q >> 3) & 7); float f[8];
#pragma unroll
        for (int j = 0; j < 8; ++j) f[j] = buf[(kg * 8 + j) * 65 + n];
        u32x4 o; o.x = pk_bf16(f[0], f[1]); o.y = pk_bf16(f[2], f[3]); o.z = pk_bf16(f[4], f[5]); o.w = pk_bf16(f[6], f[7]);
        *(u32x4*)(dst + (size_t)n * ldd + kg * 8) = o; }
    __syncthreads();
}
DI void conv_tile64(LAS float* buf, const float* src, int lds_, bf16_t* dst, int ldd) {
    const int tid = threadIdx.x;
#pragma unroll
    for (int i = 0; i < 2; ++i) { const int k = (tid >> 4) + 32 * i, cgp = tid & 15; const float4 v = *(const float4*)(src + (size_t)k * lds_ + cgp * 4);
        LAS float* p = buf + k * 65 + cgp * 4; p[0] = v.x; p[1] = v.y; p[2] = v.z; p[3] = v.w; }
    __syncthreads();
    { const int kg = tid & 7, n = tid >> 3; float f[8];
#pragma unroll
        for (int j = 0; j < 8; ++j) f[j] = buf[(kg * 8 + j) * 65 + n];
        u32x4 o; o.x = pk_bf16(f[0], f[1]); o.y = pk_bf16(f[2], f[3]); o.z = pk_bf16(f[4], f[5]); o.w = pk_bf16(f[6], f[7]);
        *(u32x4*)(dst + (size_t)n * ldd + kg * 8) = o; }
    __syncthreads();
}
DI void conv_job(LAS float* buf, int& rot, const float* src, int ldsrc, int K, int Nd, bf16_t* dst, int lddst, int koff, int map) {
    const int G = gridDim.x, KT = (map == 4) ? 64 : 256, tn_n = Nd >> 6, ntile = tn_n * (K / KT);
    for (int t = (int)((blockIdx.x + rot) % G); t < ntile; t += G) {
        const int tn = t % tn_n, tk = t / tn_n, n0 = tn * 64, k0 = tk * KT;
        if (map == 4) { conv_tile64(buf, src + (size_t)(n0 >> 7) * 16384 + (size_t)k0 * 128 + (n0 & 127), ldsrc, dst + (size_t)n0 * lddst + koff + k0, lddst); continue; }
        int c0 = n0;
        if (map == 1) { const int pn = n0 >> 8, rr = n0 & 255; c0 = rr < 128 ? 128 * pn + rr : DFF + 128 * pn + rr - 128; }
        else if (map == 2) c0 = n0 < 2048 ? n0 : n0 + 1024;
        else if (map == 3) c0 = 2048 + n0;
        conv_tile(buf, src + (size_t)k0 * ldsrc + c0, ldsrc, dst + (size_t)n0 * lddst + koff + k0, lddst);
    }
    rot = (rot + G - ntile % G) % G;
}
DI void mod_items(LAS float* lf, const float* c, const float* w_ada, const float* b_ada, float* mod) {
    const int tid = threadIdx.x;
    if (blockIdx.x >= 288) return;
    for (int i = tid; i < 8192; i += 512) { const float v = c[i]; lf[i] = v * sigmoidf_(v); }
    __syncthreads();
    LAS float* part = lf + 8192;
    for (int it = blockIdx.x; it < 288; it += gridDim.x) {
        const int col0 = it * 64, cgp = tid & 15, ks = tid >> 4;
        float acc[4][4];
#pragma unroll
        for (int b = 0; b < 4; ++b)
#pragma unroll
            for (int j = 0; j < 4; ++j) acc[b][j] = 0.f;
        const float* wp = w_ada + (size_t)(ks * 64) * NMOD + col0 + cgp * 4;
#pragma unroll 16
        for (int k = 0; k < 64; ++k) { const float4 w = *(const float4*)(wp + (size_t)k * NMOD);
#pragma unroll
            for (int b = 0; b < 4; ++b) { const float cv = lf[b * 2048 + ks * 64 + k]; acc[b][0] += cv * w.x; acc[b][1] += cv * w.y; acc[b][2] += cv * w.z; acc[b][3] += cv * w.w; } }
#pragma unroll
        for (int b = 0; b < 4; ++b)
#pragma unroll
            for (int j = 0; j < 4; ++j) part[(ks * 16 + cgp) * 16 + b * 4 + j] = acc[b][j];
        __syncthreads();
        if (tid < 256) { const int b = tid >> 6, cc = tid & 63; float s = 0.f;
            for (int k2 = 0; k2 < 32; ++k2) s += part[(k2 * 16 + (cc >> 2)) * 16 + b * 4 + (cc & 3)];
            mod[b * NMOD + col0 + cc] = s + b_ada[col0 + cc]; }
        __syncthreads();
    }
}

template <bool FINAL>
DI void norm_phase(const float* src, const float* gain, const float* mod, int ish, bf16_t* dst, float* dstf) {
    const int lane = threadIdx.x & 63, wave = threadIdx.x >> 6;
    for (int r = blockIdx.x * 8 + wave; r < T; r += gridDim.x * 8) {
        const float* xp = src + (size_t)r * D; f32x4 v[8]; float ss = 0.f;
#pragma unroll
        for (int i = 0; i < 8; ++i) { v[i] = *(const f32x4*)(xp + (i * 64 + lane) * 4); ss += v[i][0] * v[i][0] + v[i][1] * v[i][1] + v[i][2] * v[i][2] + v[i][3] * v[i][3]; }
#pragma unroll
        for (int off = 32; off >= 1; off >>= 1) ss += __shfl_xor(ss, off);
        const float rstd = rsqrtf(ss * (1.0f / D) + EPS);
        const float* sh = mod + (size_t)(r >> 12) * NMOD + ish * D; const float* sc = sh + D;
#pragma unroll
        for (int i = 0; i < 8; ++i) { const int col = (i * 64 + lane) * 4; const f32x4 g = *(const f32x4*)(gain + col);
            f32x4 y = v[i] * rstd * g;
            if (FINAL) *(f32x4*)(dstf + (size_t)r * D + col) = y;
            else { const f32x4 s4 = *(const f32x4*)(sh + col), c4 = *(const f32x4*)(sc + col); y = y * (1.0f + c4) + s4;
                u32x2 w; w.x = pk_bf16(y[0], y[1]); w.y = pk_bf16(y[2], y[3]); *(u32x2*)(dst + (size_t)r * D + col) = w; } }
    }
}

constexpr int AT_KROW = 272, AT_VROW = 144, AT_KB = 64 * AT_KROW, AT_BUF = AT_KB + 128 * AT_VROW;
DI f32x16 attn_qk(const LAS unsigned char* kp, const bf16x8 (&qf)[8]) {
    f32x16 s;
#pragma unroll
    for (int i = 0; i < 16; ++i) s[i] = 0.f;
#pragma unroll
    for (int ks = 0; ks < 8; ++ks) { const bf16x8 a = *(const LAS bf16x8*)(kp + ks * 32); s = __builtin_amdgcn_mfma_f32_32x32x16_bf16(a, qf[ks], s, 0, 0, 0); }
    return s;
}
template <bool MASKED>
DI void attn_ew(const f32x16& s, float& C, int half, int ks0, int tq, bf16x8& pf0, bf16x8& pf1) {
    float kp_[16];
#pragma unroll
    for (int i = 0; i < 16; ++i) kp_[i] = fast_rcp(1.0f + fast_exp2(s[i]));
    if (MASKED) {
#pragma unroll
        for (int i = 0; i < 16; ++i) { const int key = ks0 + 16 * (i >> 3) + 8 * half + (i & 7); kp_[i] = key < tq ? kp_[i] : 1.0f; } }
    float d[16]; float PA = 1.0f, PB = 1.0f;
#pragma unroll
    for (int i = 15; i >= 8; --i) { const float nx = PB * kp_[i]; d[i] = PB - nx; PB = nx; }
#pragma unroll
    for (int i = 7; i >= 0; --i) { const float nx = PA * kp_[i]; d[i] = PA - nx; PA = nx; }
    const float PAo = __shfl_xor(PA, 32), PBo = __shfl_xor(PB, 32);
    const float t1 = C * PBo, t3 = C * (PB * PBo), t4 = t3 * PAo;
    const float stB = half ? C : t1;
    const float stA = half ? t3 : t4;
    C = C * ((PA * PAo) * (PB * PBo));
    u32x4 p0, p1;
    p0.x = pk_bf16(d[0] * stA, d[1] * stA); p0.y = pk_bf16(d[2] * stA, d[3] * stA); p0.z = pk_bf16(d[4] * stA, d[5] * stA); p0.w = pk_bf16(d[6] * stA, d[7] * stA);
    p1.x = pk_bf16(d[8] * stB, d[9] * stB); p1.y = pk_bf16(d[10] * stB, d[11] * stB); p1.z = pk_bf16(d[12] * stB, d[13] * stB); p1.w = pk_bf16(d[14] * stB, d[15] * stB);
    pf0 = __builtin_bit_cast(bf16x8, p0); pf1 = __builtin_bit_cast(bf16x8, p1);
}
DI void attn_pv(const LAS unsigned char* vp0, const bf16x8& pf0, const bf16x8& pf1, f32x16 (&o)[4]) {
#pragma unroll
    for (int d = 0; d < 4; ++d) { const LAS unsigned char* vp = vp0 + d * 32 * AT_VROW;
        const bf16x8 v0 = *(const LAS bf16x8*)(vp), v1 = *(const LAS bf16x8*)(vp + 32);
        o[d] = __builtin_amdgcn_mfma_f32_32x32x16_bf16(v0, pf0, o[d], 0, 0, 0);
        o[d] = __builtin_amdgcn_mfma_f32_32x32x16_bf16(v1, pf1, o[d], 0, 0, 0); }
}
DI void attn_item(LAS unsigned char* lds, const bf16_t* P, const bf16_t* VT, bf16_t* YM, int b, int h, int qb) {
    const int tid = threadIdx.x, lane = tid & 63, wave = __builtin_amdgcn_readfirstlane(tid >> 6), l32 = lane & 31, half = lane >> 5;
    const int t0 = qb * 256 + wave * 32, tq = t0 + l32;
    const size_t tokbase = (size_t)b * SEQ;
    bf16x8 qf[8];
    { const bf16_t* qp = P + (tokbase + tq) * PW + h * 128 + 8 * half;
#pragma unroll
      for (int ks = 0; ks < 8; ++ks) qf[ks] = *(const bf16x8*)(qp + 16 * ks); }
    f32x16 o[4];
#pragma unroll
    for (int d = 0; d < 4; ++d)
#pragma unroll
        for (int i = 0; i < 16; ++i) o[d][i] = 0.f;
    float C = 1.0f;
    const int ktmax = qb * 4 + 3;
    const bf16_t* Kg = P + tokbase * PW + 1024 + h * 128;
    const bf16_t* Vg = VT + (size_t)(h * 128) * T + tokbase;
    unsigned ko[2], vo[2]; int kl[2], vl[2];
#pragma unroll
    for (int i = 0; i < 2; ++i) { const int p = tid + 512 * i; const int key = p >> 4, part = p & 15; ko[i] = (unsigned)(key * PW + part * 8); kl[i] = key * AT_KROW + part * 16;
        const int d = p >> 3, pv = p & 7; vo[i] = (unsigned)(d * T + pv * 8); vl[i] = AT_KB + d * AT_VROW + pv * 16; }
    u32x4 rk[2], rv[2];
    { const bf16_t* kb = Kg + (size_t)ktmax * 64 * PW; const bf16_t* vb = Vg + ktmax * 64;
#pragma unroll
      for (int i = 0; i < 2; ++i) { rk[i] = *(const u32x4*)(kb + ko[i]); rv[i] = *(const u32x4*)(vb + vo[i]); } }
#pragma unroll
    for (int i = 0; i < 2; ++i) { *(LAS u32x4*)(lds + kl[i]) = rk[i]; *(LAS u32x4*)(lds + vl[i]) = rv[i]; }
#pragma unroll
    for (int ks = 0; ks < 8; ++ks) asm volatile("" : "+v"(qf[ks]));
    __syncthreads();
    const int pir = (l32 & 0x13) | ((l32 & 8) >> 1) | ((l32 & 4) << 1);
    const int koff = pir * AT_KROW + half * 16, voff = l32 * AT_VROW + half * 16;
    int cur = 0;
    for (int kt = ktmax; kt >= 0; --kt) {
        if (kt > 0) { const bf16_t* kb = Kg + (size_t)(kt - 1) * 64 * PW; const bf16_t* vb = Vg + (kt - 1) * 64;
#pragma unroll
            for (int i = 0; i < 2; ++i) { rk[i] = *(const u32x4*)(kb + ko[i]); rv[i] = *(const u32x4*)(vb + vo[i]); } }
        const LAS unsigned char* Kb = lds + cur * AT_BUF + koff; const LAS unsigned char* Vb = lds + cur * AT_BUF + AT_KB + voff;
        if (kt * 64 + 63 < t0) {
            bf16x8 pa0, pa1, pb0, pb1;
            const f32x16 s1 = attn_qk(Kb + 32 * AT_KROW, qf);
            const f32x16 s0 = attn_qk(Kb, qf);
            attn_ew<false>(s1, C, half, 0, 0, pa0, pa1);
            attn_pv(Vb + 64, pa0, pa1, o);
            attn_ew<false>(s0, C, half, 0, 0, pb0, pb1);
            attn_pv(Vb, pb0, pb1, o);
        } else {
#pragma unroll
            for (int sub = 1; sub >= 0; --sub) {
                const int ks0 = kt * 64 + 32 * sub;
                if (ks0 >= t0 + 31) continue;
                bf16x8 pa0, pa1;
                const f32x16 s = attn_qk(Kb + sub * 32 * AT_KROW, qf);
                attn_ew<true>(s, C, half, ks0, tq, pa0, pa1);
                attn_pv(Vb + 64 * sub, pa0, pa1, o);
            }
        }
        if (kt > 0) { LAS unsigned char* nb = lds + (cur ^ 1) * AT_BUF;
#pragma unroll
            for (int i = 0; i < 2; ++i) { *(LAS u32x4*)(nb + kl[i]) = rk[i]; *(LAS u32x4*)(nb + vl[i]) = rv[i]; } }
        __syncthreads();
        cur ^= 1;
    }
    bf16_t* yp = YM + (tokbase + tq) * D + h * 128 + 4 * half;
#pragma unroll
    for (int d = 0; d < 4; ++d)
#pragma unroll
        for (int q4 = 0; q4 < 4; ++q4) { u32x2 w; w.x = pk_bf16(o[d][q4 * 4], o[d][q4 * 4 + 1]); w.y = pk_bf16(o[d][q4 * 4 + 2], o[d][q4 * 4 + 3]); *(u32x2*)(yp + d * 32 + q4 * 8) = w; }
}

struct LruP { const bf16_t* P; const bf16_t* WG; const float* conv_w; const float* conv_b; const float* b_r; const float* b_i; const float* lam; float* lsum; bf16_t* YM; bf16_t* YA; };
DI void lru_item(LAS unsigned char* lds, const LruP& q, int ck, int n) {
    const int tid = threadIdx.x, lane = tid & 63, wave = __builtin_amdgcn_readfirstlane(tid >> 6);
    const int lc = ck & 63; const size_t tok0 = (size_t)ck * 64;
    LAS float* xcf = (LAS float*)lds;
    LAS float* la = xcf + 64 * 129;
    LAS float* lu = la + 64 * 129;
    LAS float* sg = lu + 64 * 129;
    LAS unsigned char* xcb = (LAS unsigned char*)(sg + 2048);
    const int c = tid & 127, sgi = tid >> 7, ch = n * 128 + c;
    const int fr = lane & 15, fq = lane >> 4;
    const bf16_t* xp = q.P + (tok0 + sgi * 16) * PW + 2048 + ch;
    const bool has_prev = (lc * 64 + sgi * 16) > 0;
    bf16_t xr[19];
#pragma unroll
    for (int t = 0; t < 3; ++t) xr[t] = has_prev ? xp[(t - 3) * PW] : (bf16_t)0;
#pragma unroll
    for (int t = 0; t < 16; ++t) xr[3 + t] = xp[(size_t)t * PW];
    bf16x8 wbr[4], wbi[4];
    { const bf16_t* wrp = q.WG + (size_t)(n * 128 + wave * 16 + fr) * 128 + fq * 8; const bf16_t* wip = wrp + 8 * 128 * 128;
#pragma unroll
      for (int ks = 0; ks < 4; ++ks) { wbr[ks] = *(const bf16x8*)(wrp + ks * 32); wbi[ks] = *(const bf16x8*)(wip + ks * 32); } }
    bf16_t grv[16];
    { const bf16_t* gp = q.P + (tok0 + sgi * 16) * PW + 3072 + ch;
#pragma unroll
      for (int t = 0; t < 16; ++t) grv[t] = gp[(size_t)t * PW]; }
    const float w0 = q.conv_w[ch], w1 = q.conv_w[1024 + ch], w2 = q.conv_w[2048 + ch], w3 = q.conv_w[3072 + ch], cb = q.conv_b[ch];
    const int c2 = wave * 16 + fr, ch2 = n * 128 + c2; const float brv = q.b_r[ch2], biv = q.b_i[ch2]; const float L = -8.0f * log1pf(expf(-q.lam[ch2]));
#pragma unroll
    for (int t = 0; t < 16; ++t) { const float y = w0 * bf_f(xr[t]) + w1 * bf_f(xr[t + 1]) + w2 * bf_f(xr[t + 2]) + w3 * bf_f(xr[t + 3]) + cb;
        xcf[(sgi * 16 + t) * 129 + c] = y; *(LAS bf16_t*)(xcb + (sgi * 16 + t) * 272 + c * 2) = to_bf16(y); }
    __syncthreads();
    f32x4 ar[4], ai[4];
#pragma unroll
    for (int m = 0; m < 4; ++m) { ar[m] = (f32x4){0.f, 0.f, 0.f, 0.f}; ai[m] = (f32x4){0.f, 0.f, 0.f, 0.f}; }
#pragma unroll
    for (int ks = 0; ks < 4; ++ks)
#pragma unroll
        for (int m = 0; m < 4; ++m) { const bf16x8 av = *(const LAS bf16x8*)(xcb + (m * 16 + fr) * 272 + (ks * 32 + fq * 8) * 2);
            ar[m] = __builtin_amdgcn_mfma_f32_16x16x32_bf16(av, wbr[ks], ar[m], 0, 0, 0); ai[m] = __builtin_amdgcn_mfma_f32_16x16x32_bf16(av, wbi[ks], ai[m], 0, 0, 0); }
#pragma unroll
    for (int m = 0; m < 4; ++m)
#pragma unroll
        for (int j = 0; j < 4; ++j) { const int t = m * 16 + fq * 4 + j; const float r = sigmoidf_(ar[m][j] + brv), ig = sigmoidf_(ai[m][j] + biv);
            const float lga = r * L; const float av = fast_exp2(lga * LOG2E); const float x = 2.0f * lga;
            const float om = -x * (1.0f + x * 0.5f * (1.0f + x * (1.0f / 3.0f) * (1.0f + x * 0.25f * (1.0f + x * 0.2f * (1.0f + x * (1.0f / 6.0f))))));
            la[t * 129 + c2] = av; lu[t * 129 + c2] = sqrtf(om) * ig * xcf[t * 129 + c2]; }
    __syncthreads();
    float av_[16], uv_[16];
#pragma unroll
    for (int t = 0; t < 16; ++t) { av_[t] = la[(sgi * 16 + t) * 129 + c]; uv_[t] = lu[(sgi * 16 + t) * 129 + c]; }
    { float A = 1.0f, H = 0.f;
#pragma unroll
      for (int t = 0; t < 16; ++t) { H = av_[t] * H + uv_[t]; A *= av_[t]; }
      sg[sgi * 128 + c] = A; sg[512 + sgi * 128 + c] = H; }
    __syncthreads();
    float Ar = 1.0f, Hr = 0.f;
#pragma unroll
    for (int s2 = 0; s2 < 3; ++s2) { if (s2 < sgi) { const float as = sg[s2 * 128 + c], hs = sg[512 + s2 * 128 + c]; Hr = as * Hr + hs; Ar *= as; } }
    bf16_t* yl = q.YM + (tok0 + sgi * 16) * D + 1024 + ch;
    bf16_t* ya = q.YA + (tok0 + sgi * 16) * 1024 + ch;
#pragma unroll
    for (int t = 0; t < 16; ++t) { Hr = av_[t] * Hr + uv_[t]; Ar *= av_[t];
        const float g = bf_f(grv[t]); const float ge = g * sigmoidf_(1.5957691216057308f * (g + 0.044715f * g * g * g));
        yl[(size_t)t * D] = to_bf16(Hr * ge); ya[(size_t)t * 1024] = to_bf16(Ar * ge); }
    if (sgi == 3) *(f32x2v*)(q.lsum + ((size_t)ck * 1024 + ch) * 2) = (f32x2v){Ar, Hr};
    __syncthreads();
}
DI void lru_fix(LAS unsigned char* lds, const LruP& q, int ck, int n) {
    const int tid = threadIdx.x; const int bq = ck >> 6, lc = ck & 63; const size_t tok0 = (size_t)ck * 64;
    LAS float* sg = (LAS float*)lds;
    const int c = tid & 127, sgi = tid >> 7, ch = n * 128 + c;
    if (lc == 0) return;
    bf16_t* yl = q.YM + (tok0 + sgi * 16) * D + 1024 + ch;
    const bf16_t* ya = q.YA + (tok0 + sgi * 16) * 1024 + ch;
    bf16_t l[16], a[16];
#pragma unroll
    for (int t = 0; t < 16; ++t) { l[t] = yl[(size_t)t * D]; a[t] = ya[(size_t)t * 1024]; }
    const float* sp = q.lsum + ((size_t)(bq * 64 + sgi * 16) * 1024 + ch) * 2;
    f32x2v sv[16];
#pragma unroll
    for (int j = 0; j < 16; ++j) sv[j] = *(const f32x2v*)(sp + (size_t)j * 2048);
    float cA = 1.0f, cH = 0.f;
#pragma unroll
    for (int j = 0; j < 16; ++j) { const bool ok = (sgi * 16 + j) < lc; const float aj = ok ? sv[j][0] : 1.0f, hj = ok ? sv[j][1] : 0.f; cH = aj * cH + hj; cA *= aj; }
    sg[sgi * 128 + c] = cA; sg[512 + sgi * 128 + c] = cH;
    __syncthreads();
    float hc = 0.f;
#pragma unroll
    for (int s2 = 0; s2 < 4; ++s2) hc = sg[s2 * 128 + c] * hc + sg[512 + s2 * 128 + c];
#pragma unroll
    for (int t = 0; t < 16; ++t) yl[(size_t)t * D] = to_bf16(bf_f(l[t]) + bf_f(a[t]) * hc);
    __syncthreads();
}

constexpr int NPH = 14;
__global__ void __launch_bounds__(512, 2) fwd(Args a) {
    extern __shared__ __attribute__((aligned(16))) unsigned char lds_raw[];
    LAS unsigned char* lds = (LAS unsigned char*)lds_raw;
    cg::grid_group grid = cg::this_grid();
    const int lo = a.ph_lo, hi = a.ph_hi, G = gridDim.x, bx = blockIdx.x;
    unsigned char* ws = a.ws;
    float* mod = (float*)(ws + WS_MOD); float* lsum = (float*)(ws + WS_LSUM);
    bf16_t* W1IN = (bf16_t*)(ws + WS_W1IN); bf16_t* W1OUT = (bf16_t*)(ws + WS_W1OUT); bf16_t* W2IN = (bf16_t*)(ws + WS_W2IN); bf16_t* W2OUT = (bf16_t*)(ws + WS_W2OUT);
    bf16_t* WINM = (bf16_t*)(ws + WS_WINM); bf16_t* WV = (bf16_t*)(ws + WS_WV); bf16_t* WBR = (bf16_t*)(ws + WS_WBR); bf16_t* WO = (bf16_t*)(ws + WS_WO); bf16_t* WG = (bf16_t*)(ws + WS_WG);
    bf16_t* Y = (bf16_t*)(ws + WS_Y); bf16_t* P = (bf16_t*)(ws + WS_P); bf16_t* Hb = P; bf16_t* VT = (bf16_t*)(ws + WS_VT); bf16_t* YM = (bf16_t*)(ws + WS_YM); bf16_t* MG = Y;
    float* out = a.out;
#ifndef PHASE_MASK
#define PHASE_MASK 0x3fff
#endif
#define IN(k) (((PHASE_MASK >> (k)) & 1) && lo <= (k) && (k) < hi)
#ifndef DUPMASK
#define DUPMASK 0
#endif
#ifndef DUPCNT
#define DUPCNT 1
#endif
#define REP(k) for (int rep_ = 0; rep_ < 1 + DUPCNT * ((DUPMASK >> (k)) & 1); ++rep_)
#define SEAM(k) do { if (IN(k) && IN((k) + 1)) xcd_barrier(xbar); } while (0)
    if (threadIdx.x < 4) ((LAS unsigned*)(lds + LDS_MAIN))[threadIdx.x] = 0u;
    __syncthreads();
    XcdBarrier xbar; xbar.bar = (unsigned*)(ws + WS_BAR); xbar.x = 0; xbar.st = (volatile LAS unsigned*)(lds + LDS_MAIN);
    if (hi - lo > 1) xbar = xcd_barrier_post((unsigned*)(ws + WS_BAR), (volatile LAS unsigned*)(lds + LDS_MAIN));
    if (hi > 1000) grid.sync();
    using namespace pg8;
    if (IN(0)) REP(0) {
        mod_items((LAS float*)lds, a.in[I_C], a.in[I_WADA], a.in[I_BADA], mod);
        LAS float* buf = (LAS float*)lds; int rot = 0;
        conv_job(buf, rot, a.in[I_W1IN], 2 * DFF, D, 2 * DFF, W1IN, D, 0, 1);
        conv_job(buf, rot, a.in[I_W1OUT], D, DFF, D, W1OUT, DFF, 0, 0);
        conv_job(buf, rot, a.in[I_WIN], 9216, D, 8192, WINM, D, 0, 2);
        conv_job(buf, rot, a.in[I_WIN], 9216, D, 1024, WV, D, 0, 3);
        conv_job(buf, rot, a.in[I_WBA], D, 1024, D, WBR, D, 0, 0);
        conv_job(buf, rot, a.in[I_WBL], D, 1024, D, WBR, D, 1024, 0);
        conv_job(buf, rot, a.in[I_WOUT], D, D, D, WO, D, 0, 0);
        conv_job(buf, rot, a.in[I_WRG], 128, 128, 1024, WG, 128, 0, 4);
        conv_job(buf, rot, a.in[I_WIG], 128, 128, 1024, WG + 8 * 128 * 128, 128, 0, 4);
        conv_job(buf, rot, a.in[I_W2IN], 2 * DFF, D, 2 * DFF, W2IN, D, 0, 1);
        conv_job(buf, rot, a.in[I_W2OUT], D, DFF, D, W2OUT, DFF, 0, 0);
    }
    SEAM(0);
#ifdef EXTRA_SYNCS
    for (int es = 0; es < EXTRA_SYNCS; ++es) xcd_barrier(xbar);
#endif
    if (IN(1)) REP(1) norm_phase<false>(a.in[I_X], a.in[I_N1], mod, 0, Y, nullptr);
    SEAM(1);
    if (IN(2) && ((DUPMASK >> 2) & 1)) { Gemm g{Y, W1IN, T, 2 * DFF, D}; StaticOrder S; S.init(T, 2 * DFF, G, bx); EpiSwiGLU E{Hb}; gemm_phase<EpiSwiGLU, StaticOrder, true, true>(lds, g, S, E); }
    if (IN(2)) { Gemm g{Y, W1IN, T, 2 * DFF, D}; StaticOrder S; S.init(T, 2 * DFF, G, bx); EpiSwiGLU E{Hb}; gemm_phase<EpiSwiGLU, StaticOrder, true, true>(lds, g, S, E); }
    SEAM(2);
    if (IN(3) && ((DUPMASK >> 3) & 1)) { Gemm g{Hb, W1OUT, T, D, DFF}; StaticOrder S; S.init(T, D, G, bx, 4); EpiResid E{a.in[I_X], out, mod + 2 * D, 0.5f}; gemm_phase<EpiResid, StaticOrder, true, true>(lds, g, S, E); }
    if (IN(3)) { Gemm g{Hb, W1OUT, T, D, DFF}; StaticOrder S; S.init(T, D, G, bx, 4); EpiResid E{a.in[I_X], out, mod + 2 * D, 0.5f}; gemm_phase<EpiResid, StaticOrder, true, true>(lds, g, S, E); }
    SEAM(3);
    if (IN(4)) norm_phase<false>(out, a.in[I_NMIX], mod, 3, Y, nullptr);
    SEAM(4);
    if (IN(5)) {
        { Gemm g{Y, WINM, T, 8192, D}; StaticOrder S; S.init(T, 8192, G, bx); EpiP E{P, PW, 4, QSCALE}; gemm_phase<EpiP, StaticOrder, true, true>(lds, g, S, E); }
        { Gemm g{WV, Y, 1024, T, D}; StaticOrder S; S.init(1024, T, G, bx); EpiP E{VT, T, 0, 1.0f}; gemm_phase<EpiP, StaticOrder, true, true>(lds, g, S, E); }
    }
    SEAM(5);
    LruP lq{P, WG, a.in[I_CONVW], a.in[I_CONVB], a.in[I_BRG], a.in[I_BIG], a.in[I_LAM], lsum, YM, Y};
    if (IN(6)) {
        REP(6) for (int p0 = bx; p0 < 256; p0 += G) { const int p = (G == 256) ? ((p0 & 7) * 32 + (p0 >> 3)) : p0;
            const int bh = p >> 3, jp = p & 7; attn_item(lds, P, VT, YM, bh >> 3, bh & 7, 15 - jp); attn_item(lds, P, VT, YM, bh >> 3, bh & 7, jp); }
        REP(14) for (int it = bx; it < 2048; it += G) lru_item(lds, lq, it >> 3, it & 7);
    }
    SEAM(6);
    if (IN(7)) { for (int it = bx; it < 2048; it += G) lru_fix(lds, lq, it >> 3, it & 7); }
    SEAM(7);
    if (IN(8)) { Gemm g{YM, WBR, T, D, D}; StaticOrder S; S.init(T, D, G, bx, 4); EpiBranch E{P, MG}; gemm_phase<EpiBranch, StaticOrder, true, true>(lds, g, S, E); }
    SEAM(8);
    if (IN(9)) { Gemm g{MG, WO, T, D, D}; StaticOrder S; S.init(T, D, G, bx, 4); EpiResid E{out, out, mod + 5 * D, 1.0f}; gemm_phase<EpiResid, StaticOrder, true, true>(lds, g, S, E); }
    SEAM(9);
    if (IN(10)) norm_phase<false>(out, a.in[I_N2], mod, 6, Y, nullptr);
    SEAM(10);
    if (IN(11)) { Gemm g{Y, W2IN, T, 2 * DFF, D}; StaticOrder S; S.init(T, 2 * DFF, G, bx); EpiSwiGLU E{Hb}; gemm_phase<EpiSwiGLU, StaticOrder, true, true>(lds, g, S, E); }
    SEAM(11);
    if (IN(12)) { Gemm g{Hb, W2OUT, T, D, DFF}; StaticOrder S; S.init(T, D, G, bx, 4); EpiResid E{out, out, mod + 8 * D, 0.5f}; gemm_phase<EpiResid, StaticOrder, true, true>(lds, g, S, E); }
    SEAM(12);
    if (IN(13)) norm_phase<true>(out, a.in[I_NF], mod, 0, nullptr, out);
}

#ifndef ONE_LAUNCH
#define ONE_LAUNCH 1
#endif
extern "C" void kernel_launch(void* const* d_in, const int* in_sizes, int n_in, void* d_out, int out_size, void* d_ws, size_t ws_size, hipStream_t stream) {
    static int grid = 0;
    if (grid == 0) {
        if (n_in != 23 || out_size != T * D || ws_size < WS_END) { fprintf(stderr, "kernel_launch: unexpected shapes (n_in %d out %d ws %zu need %zu)\n", n_in, out_size, ws_size, (size_t)WS_END); grid = -1; return; }
        int dev = 0, cus = 0, per_cu = 0;
        hipGetDevice(&dev); hipDeviceGetAttribute(&cus, hipDeviceAttributeMultiprocessorCount, dev);
        if (hipFuncSetAttribute((const void*)fwd, hipFuncAttributeMaxDynamicSharedMemorySize, LDS_BYTES) != hipSuccess) { fprintf(stderr, "kernel_launch: hipFuncSetAttribute failed\n"); grid = -1; return; }
        if (hipOccupancyMaxActiveBlocksPerMultiprocessor(&per_cu, (const void*)fwd, 512, LDS_BYTES) != hipSuccess || per_cu < 1) { fprintf(stderr, "kernel_launch: occupancy query says %d\n", per_cu); per_cu = 1; }
        (void)hipGetLastError();
        grid = cus * per_cu;
        if (grid > 256) grid = 256;
    }
    if (grid < 0) return;
    Args a{};
    for (int i = 0; i < 23; ++i) a.in[i] = (const float*)d_in[i];
    a.out = (float*)d_out; a.ws = (unsigned char*)d_ws;
#if ONE_LAUNCH
    if (hipMemsetAsync((char*)d_ws + WS_BAR, 0, 16384, stream) != hipSuccess) { fprintf(stderr, "kernel_launch: memset of the barrier words failed\n"); return; }
    a.ph_lo = 0; a.ph_hi = NPH;
    void* args[] = {&a};
    hipError_t e = hipLaunchCooperativeKernel((const void*)fwd, dim3(grid), dim3(512), args, LDS_BYTES, stream);
    if (e != hipSuccess) fprintf(stderr, "cooperative launch failed: %s (grid %d)\n", hipGetErrorString(e), grid);
#else
    for (int ph = 0; ph < NPH; ++ph) { a.ph_lo = ph; a.ph_hi = ph + 1; hipLaunchKernelGGL(fwd, dim3(grid), dim3(512), LDS_BYTES, stream, a); }
#endif
}
```

```cpp
#include <hip/hip_runtime.h>
#include <hip/hip_cooperative_groups.h>
#include <cstdio>
#include <cstdint>
namespace cg = cooperative_groups;

#define DI __device__ __forceinline__
#define LAS __attribute__((address_space(3)))

constexpr int T = 16384, D = 2048, DFF = 5632, SEQ = 4096;
constexpr int NMOD = 9 * D;
constexpr int PW = 8192;
constexpr float EPS = 1e-6f;
constexpr float LOG2E = 1.4426950408889634f;
constexpr float QSCALE = 0.08838834764831845f * 1.4426950408889634f;
constexpr int LDS_MAIN = 131072;
constexpr int LDS_BYTES = LDS_MAIN + 16;

constexpr size_t WS_BAR   = 0;
constexpr size_t WS_MOD   = 16384;
constexpr size_t WS_LSUM  = WS_MOD + (size_t)4 * NMOD * 4;
constexpr size_t WS_W1IN  = WS_LSUM + (size_t)256 * 1024 * 8;
constexpr size_t WS_W1OUT = WS_W1IN + (size_t)2 * DFF * D * 2;
constexpr size_t WS_W2IN  = WS_W1OUT + (size_t)D * DFF * 2;
constexpr size_t WS_W2OUT = WS_W2IN + (size_t)2 * DFF * D * 2;
constexpr size_t WS_WINM  = WS_W2OUT + (size_t)D * DFF * 2;
constexpr size_t WS_WV    = WS_WINM + (size_t)8192 * D * 2;
constexpr size_t WS_WBR   = WS_WV + (size_t)1024 * D * 2;
constexpr size_t WS_WO    = WS_WBR + (size_t)D * D * 2;
constexpr size_t WS_WG    = WS_WO + (size_t)D * D * 2;
constexpr size_t WS_Y     = WS_WG + (size_t)2 * 8 * 128 * 128 * 2;
constexpr size_t WS_P     = WS_Y + (size_t)T * D * 2;
constexpr size_t WS_VT    = WS_P + (size_t)T * PW * 2;
constexpr size_t WS_YM    = WS_VT + (size_t)1024 * T * 2;
constexpr size_t WS_END   = WS_YM + (size_t)T * D * 2;

typedef unsigned short bf16_t;
typedef short bf16x8 __attribute__((ext_vector_type(8)));
typedef float f32x4 __attribute__((ext_vector_type(4)));
typedef float f32x16 __attribute__((ext_vector_type(16)));
typedef float f32x2v __attribute__((ext_vector_type(2)));
typedef __bf16 bf16x2v __attribute__((ext_vector_type(2)));
typedef unsigned u32x4 __attribute__((ext_vector_type(4)));
typedef unsigned u32x2 __attribute__((ext_vector_type(2)));

DI unsigned pk_bf16(float lo, float hi) { f32x2v f = {lo, hi}; bf16x2v b = __builtin_convertvector(f, bf16x2v); return __builtin_bit_cast(unsigned, b); }
DI bf16_t to_bf16(float x) { return (bf16_t)(pk_bf16(x, 0.f) & 0xffffu); }
DI float bf_lo(unsigned u) { return __uint_as_float(u << 16); }
DI float bf_hi(unsigned u) { return __uint_as_float(u & 0xffff0000u); }
DI float bf_f(bf16_t h) { return __uint_as_float(((unsigned)h) << 16); }
DI float fast_exp2(float x) { return __builtin_amdgcn_exp2f(x); }
DI float fast_rcp(float x) { return __builtin_amdgcn_rcpf(x); }
DI float sigmoidf_(float x) { return fast_rcp(1.0f + fast_exp2(-x * LOG2E)); }

namespace pg8 {
#define PG8_LAS __attribute__((address_space(3)))
constexpr int BM = 256, BK = 64, HALF = 128, HTB = HALF * BK * 2, STAGE_BYTES = 8 * HTB, NXCD = 8, WGM = 8;
__host__ __device__ __forceinline__ int lds_byte(int r, int c) { const int st = (r >> 4) * 2 + (c >> 5), rr = r & 15, cc = c & 31, ob = rr * 64 + cc * 2; return st * 1024 + (ob ^ (((ob >> 9) & 1) << 5)); }
__host__ __device__ __forceinline__ void stage_rc(int b, int& R, int& C) { const int st = b / 1024, sb = b % 1024, swz = sb ^ (((sb >> 9) & 1) << 5); R = (st >> 1) * 16 + swz / 64; C = (st & 1) * 32 + (swz % 64) / 2; }
__host__ __device__ __forceinline__ int perm32(int rho) { const int n = rho >> 4, i = rho & 15; return 8 * (i >> 2) + 4 * n + (i & 3); }
struct Unit { int pm, pn; };
struct Gemm { const bf16_t* A; const bf16_t* Bt; int M, N, K; };
struct StaticOrder {
    int nM, nN, nwg, G, c, wgm;
    __host__ __device__ void init(int M, int N, int G_, int c_, int wgm_ = WGM) { nM = M / BM; nN = N / BM; nwg = nM * nN; G = G_; c = c_; wgm = wgm_; }
    __host__ __device__ bool next(int i, Unit& u) const {
        const long L = (long)i * G + c; if (L >= nwg) return false;
        int wgid = (int)L; { const int q = nwg / NXCD, r = nwg % NXCD, xcd = wgid % NXCD, off = wgid / NXCD; wgid = (xcd < r ? xcd * (q + 1) : r * (q + 1) + (xcd - r) * q) + off; }
        const int nig = wgm * nN, gid = wgid / nig, fm = gid * wgm, gsz = (nM - fm) < wgm ? (nM - fm) : wgm;
        u.pm = fm + ((wgid % nig) % gsz); u.pn = (wgid % nig) / gsz; return true;
    }
    __device__ __forceinline__ void a_ready(const Unit&) const {}
    __device__ __forceinline__ void done(const Unit&) const {}
};

struct EpiSwiGLU {
    static constexpr bool PERM = true, AFTER_DRAIN = false, MID = false;
    bf16_t* H;
    DI void mid(f32x4 (&)[2][2][4][2], const Unit&, int, int, int, int) const {}
    DI void operator()(const f32x4 (&acc)[2][2][4][2], const Unit& u, int wr, int wc, int fr, int fq) const {
        const int row0 = u.pm * BM + wr * 64 + fr, col0 = u.pn * HALF + wc * 32 + 8 * fq;
#pragma unroll
        for (int ai = 0; ai < 2; ++ai)
#pragma unroll
            for (int m = 0; m < 4; ++m) {
                float o[8];
#pragma unroll
                for (int n = 0; n < 2; ++n)
#pragma unroll
                    for (int j = 0; j < 4; ++j) { const float g = acc[ai][0][m][n][j], up = acc[ai][1][m][n][j]; o[n * 4 + j] = g * sigmoidf_(g) * up; }
                u32x4 w; w.x = pk_bf16(o[0], o[1]); w.y = pk_bf16(o[2], o[3]); w.z = pk_bf16(o[4], o[5]); w.w = pk_bf16(o[6], o[7]);
                *(u32x4*)(H + (size_t)(row0 + ai * HALF + m * 16) * DFF + col0) = w;
            }
    }
};
struct EpiResid {
    static constexpr bool PERM = false, AFTER_DRAIN = false, MID = false;
    const float* resid; float* out; const float* gmod; float coef;
    DI void mid(f32x4 (&)[2][2][4][2], const Unit&, int, int, int, int) const {}
    DI void operator()(const f32x4 (&acc)[2][2][4][2], const Unit& u, int wr, int wc, int fr, int fq) const {
        const int row0 = u.pm * BM + wr * 64 + fr, col0 = u.pn * BM + wc * 32 + 4 * fq;
        const float* gv = gmod + (size_t)(u.pm >> 4) * NMOD + col0;
        f32x4 g[2][2];
#pragma unroll
        for (int bj = 0; bj < 2; ++bj)
#pragma unroll
            for (int n = 0; n < 2; ++n) g[bj][n] = *(const f32x4*)(gv + bj * HALF + n * 16) * coef;
#pragma unroll
        for (int ai = 0; ai < 2; ++ai)
#pragma unroll
            for (int m = 0; m < 4; ++m) { const size_t off = (size_t)(row0 + ai * HALF + m * 16) * D + col0;
#pragma unroll
                for (int bj = 0; bj < 2; ++bj)
#pragma unroll
                    for (int n = 0; n < 2; ++n) { const f32x4 r = *(const f32x4*)(resid + off + bj * HALF + n * 16); *(f32x4*)(out + off + bj * HALF + n * 16) = r + g[bj][n] * acc[ai][bj][m][n]; }
                asm volatile("" ::: "memory"); }
    }
};
struct EpiP {
    static constexpr bool PERM = true, AFTER_DRAIN = false, MID = false;
    bf16_t* O; int ldc; int nscale; float scale;
    DI void mid(f32x4 (&)[2][2][4][2], const Unit&, int, int, int, int) const {}
    DI void operator()(const f32x4 (&acc)[2][2][4][2], const Unit& u, int wr, int wc, int fr, int fq) const {
        const int row0 = u.pm * BM + wr * 64 + fr, col0 = u.pn * BM + wc * 32 + 8 * fq;
        const float s = (u.pn < nscale) ? scale : 1.0f;
#pragma unroll
        for (int ai = 0; ai < 2; ++ai)
#pragma unroll
            for (int m = 0; m < 4; ++m) { bf16_t* p = O + (size_t)(row0 + ai * HALF + m * 16) * ldc + col0;
#pragma unroll
                for (int bj = 0; bj < 2; ++bj) { const f32x4 v0 = acc[ai][bj][m][0] * s, v1 = acc[ai][bj][m][1] * s;
                    u32x4 w; w.x = pk_bf16(v0[0], v0[1]); w.y = pk_bf16(v0[2], v0[3]); w.z = pk_bf16(v1[0], v1[1]); w.w = pk_bf16(v1[2], v1[3]);
                    *(u32x4*)(p + bj * HALF) = w; } }
    }
};
struct EpiBranch {
    #ifdef TEST_NOMID
    static constexpr bool PERM = true, AFTER_DRAIN = false, MID = false;
#else
    static constexpr bool PERM = true, AFTER_DRAIN = false, MID = true;
#endif
    const bf16_t* P; bf16_t* O;
    DI static float cl(float x) { return fminf(fmaxf(x, -60.f), 60.f); }
    DI void mid(f32x4 (&acc)[2][2][4][2], const Unit& u, int wr, int wc, int fr, int fq) const {
        int row0 = u.pm * BM + wr * 64 + fr, col0 = u.pn * BM + wc * 32 + 8 * fq;
        asm volatile("" : "+v"(row0), "+v"(col0));
#pragma unroll
        for (int ai = 0; ai < 2; ++ai)
#pragma unroll
            for (int m = 0; m < 4; ++m) { const bf16_t* gp = P + (size_t)(row0 + ai * HALF + m * 16) * PW + 4096 + col0;
#pragma unroll
                for (int bj = 0; bj < 2; ++bj) { const u32x4 ga = *(const u32x4*)(gp + bj * HALF), gl = *(const u32x4*)(gp + 2048 + bj * HALF);
#pragma unroll
                    for (int q = 0; q < 4; ++q) { const float a0 = cl(bf_lo(ga[q])), a1 = cl(bf_hi(ga[q])), l0 = cl(bf_lo(gl[q])), l1 = cl(bf_hi(gl[q]));
                        const float r0 = (1.0f + fast_exp2(-l0 * LOG2E)) * fast_rcp(1.0f + fast_exp2(-a0 * LOG2E));
                        const float r1 = (1.0f + fast_exp2(-l1 * LOG2E)) * fast_rcp(1.0f + fast_exp2(-a1 * LOG2E));
                        acc[ai][bj][m][q >> 1][(q & 1) * 2] *= r0; acc[ai][bj][m][q >> 1][(q & 1) * 2 + 1] *= r1; } }
                asm volatile("" ::: "memory"); }
    }
    DI void operator()(const f32x4 (&acc)[2][2][4][2], const Unit& u, int wr, int wc, int fr, int fq) const {
        const int row0 = u.pm * BM + wr * 64 + fr, col0 = u.pn * BM + wc * 32 + 8 * fq;
#pragma unroll
        for (int ai = 0; ai < 2; ++ai)
#pragma unroll
            for (int m = 0; m < 4; ++m) { const size_t r = (size_t)(row0 + ai * HALF + m * 16); const bf16_t* gp = P + r * PW + 6144 + col0;
#pragma unroll
                for (int bj = 0; bj < 2; ++bj) { const u32x4 gl = *(const u32x4*)(gp + bj * HALF); float o[8];
#pragma unroll
                    for (int q = 0; q < 4; ++q) { const float l0 = cl(bf_lo(gl[q])), l1 = cl(bf_hi(gl[q]));
                        o[q * 2] = acc[ai][bj][m][q >> 1][(q & 1) * 2] * fast_rcp(1.0f + fast_exp2(-l0 * LOG2E));
                        o[q * 2 + 1] = acc[ai][bj][m][q >> 1][(q & 1) * 2 + 1] * fast_rcp(1.0f + fast_exp2(-l1 * LOG2E)); }
                    u32x4 w; w.x = pk_bf16(o[0], o[1]); w.y = pk_bf16(o[2], o[3]); w.z = pk_bf16(o[4], o[5]); w.w = pk_bf16(o[6], o[7]);
                    *(u32x4*)(O + r * D + col0 + bj * HALF) = w; }
                asm volatile("" ::: "memory"); }
    }
};

template <class Epi, class Sched, bool ALIGN_EPI = false, bool SP2 = false>
__device__ __forceinline__ void gemm_phase(PG8_LAS unsigned char* lds, const Gemm g, const Sched& S, const Epi& E) {
    const int tid = threadIdx.x, wid = __builtin_amdgcn_readfirstlane(tid >> 6), lane = tid & 63, wr = wid >> 2, wc = wid & 3, fr = lane & 15, fq = lane >> 4;
    const int K = g.K, nt = K / BK;
    unsigned voffA[2], voffB[2];
#pragma unroll
    for (int i = 0; i < 2; ++i) { int R, C; stage_rc(tid * 16 + i * 8192, R, C); const int Rb = Epi::PERM ? ((R & ~31) + perm32(R & 31)) : R;
        voffA[i] = (unsigned)(R * K + C) * 2u; voffB[i] = (unsigned)(Rb * K + C) * 2u; }
    const size_t kstep = (size_t)(BK * 2);
    const size_t hstep = (size_t)HALF * K * 2;
    const size_t tstep = 2 * hstep;
    const unsigned ldsw = (unsigned)wid * 1024u;
    const int aoff = lds_byte(wr * 64 + fr, fq * 8), boff = lds_byte(wc * 32 + fr, fq * 8);
#define PG8_SA(b, h) (((b) * 2 + (h)) * HTB)
#define PG8_SB(b, h) ((4 + (b) * 2 + (h)) * HTB)
#define PG8_STAGE(bufoff, gbase, voff) do { _Pragma("unroll") for (int _i = 0; _i < 2; ++_i) \
        __builtin_amdgcn_global_load_lds((const unsigned*)((const char*)(gbase) + (voff)[_i]), (PG8_LAS unsigned*)(lds + (bufoff) + ldsw + _i * 8192), 16, 0, 0); } while (0)
#define PG8_LDA(dst, b, h) do { _Pragma("unroll") for (int m = 0; m < 4; ++m) _Pragma("unroll") for (int k = 0; k < 2; ++k) dst[m][k] = *(const PG8_LAS bf16x8*)(lds + PG8_SA(b, h) + aoff + m * 2048 + k * 1024); } while (0)
#define PG8_LDB(dst, b, h) do { _Pragma("unroll") for (int n = 0; n < 2; ++n) _Pragma("unroll") for (int k = 0; k < 2; ++k) dst[n][k] = *(const PG8_LAS bf16x8*)(lds + PG8_SB(b, h) + boff + n * 2048 + k * 1024); } while (0)
#define PG8_MMA(ai, bj, At, Bt) do { __builtin_amdgcn_s_setprio(1); _Pragma("unroll") for (int m = 0; m < 4; ++m) _Pragma("unroll") for (int n = 0; n < 2; ++n) _Pragma("unroll") for (int k = 0; k < 2; ++k) \
        acc[ai][bj][m][n] = __builtin_amdgcn_mfma_f32_16x16x32_bf16(Bt[n][k], At[m][k], acc[ai][bj][m][n], 0, 0, 0); __builtin_amdgcn_s_setprio(0); } while (0)
#define PG8_WAIT_V(n) asm volatile("s_waitcnt vmcnt(" #n ")" ::: "memory")
#define PG8_WAIT_L(n) asm volatile("s_waitcnt lgkmcnt(" #n ")" ::: "memory")
#define PG8_BAR __builtin_amdgcn_s_barrier()
#define PG8_SCHED __builtin_amdgcn_sched_barrier(0)
    Unit cur, nxt; int ui = 0;
    if (!S.next(0, cur)) return;
    f32x4 acc[2][2][4][2];
#pragma unroll
    for (int a = 0; a < 2; ++a)
#pragma unroll
        for (int b = 0; b < 2; ++b)
#pragma unroll
            for (int m = 0; m < 4; ++m)
#pragma unroll
                for (int n = 0; n < 2; ++n) acc[a][b][m][n] = (f32x4){0.f, 0.f, 0.f, 0.f};
    bf16x8 At[4][2], B0[2][2], B1[2][2];
    const char* cA = (const char*)g.A + (size_t)cur.pm * tstep; const char* cB = (const char*)g.Bt + (size_t)cur.pn * tstep;
    S.a_ready(cur);
    if constexpr (SP2) {
        PG8_STAGE(PG8_SB(0, 0), cB, voffB); PG8_STAGE(PG8_SB(0, 1), cB + hstep, voffB); PG8_STAGE(PG8_SA(0, 0), cA, voffA); PG8_STAGE(PG8_SA(0, 1), cA + hstep, voffA);
        if (wr == 1) PG8_BAR;
        PG8_WAIT_V(2); PG8_BAR;
        PG8_STAGE(PG8_SB(1, 0), cB + kstep, voffB); PG8_STAGE(PG8_SA(1, 0), cA + kstep, voffA); PG8_STAGE(PG8_SB(1, 1), cB + hstep + kstep, voffB);
        PG8_WAIT_V(6); PG8_BAR;
    } else {
        PG8_STAGE(PG8_SB(0, 0), cB, voffB); PG8_STAGE(PG8_SA(0, 0), cA, voffA); PG8_STAGE(PG8_SB(0, 1), cB + hstep, voffB); PG8_STAGE(PG8_SA(0, 1), cA + hstep, voffA);
        if (wr == 1) PG8_BAR;
        PG8_WAIT_V(4); PG8_BAR;
        PG8_STAGE(PG8_SB(1, 0), cB + kstep, voffB); PG8_STAGE(PG8_SA(1, 0), cA + kstep, voffA); PG8_STAGE(PG8_SB(1, 1), cB + hstep + kstep, voffB);
        PG8_WAIT_V(6); PG8_BAR;
    }
    for (;;) {
        const bool has_next = S.next(ui + 1, nxt);
        const char* nA = has_next ? (const char*)g.A + (size_t)nxt.pm * tstep : cA; const char* nB = has_next ? (const char*)g.Bt + (size_t)nxt.pn * tstep : cB;
        for (int t = 0; t < nt; t += 2) {
            const bool last = (t == nt - 2);
            const char* a1 = cA + (size_t)(t + 1) * kstep;
            const char* a2 = last ? nA : cA + (size_t)(t + 2) * kstep; const char* b2 = last ? nB : cB + (size_t)(t + 2) * kstep;
            const char* a3 = a2 + kstep; const char* b3 = b2 + kstep;
            if (last && has_next) S.a_ready(nxt);
            if constexpr (Epi::MID) { PG8_SCHED; if (t == nt / 2) E.mid(acc, cur, wr, wc, fr, fq); PG8_SCHED; }
            if constexpr (SP2) {
            PG8_LDB(B0, 0, 0); PG8_LDB(B1, 0, 1); PG8_SCHED; PG8_LDA(At, 0, 0); PG8_STAGE(PG8_SA(1, 1), a1 + hstep, voffA);
            PG8_WAIT_V(8); PG8_WAIT_L(0); PG8_BAR; PG8_MMA(0, 0, At, B0); PG8_MMA(0, 1, At, B1); PG8_BAR; PG8_SCHED;
            PG8_LDA(At, 0, 1); PG8_STAGE(PG8_SB(0, 0), b2, voffB); PG8_STAGE(PG8_SB(0, 1), b2 + hstep, voffB); PG8_STAGE(PG8_SA(0, 0), a2, voffA);
            PG8_WAIT_V(8); PG8_WAIT_L(0); PG8_BAR; PG8_MMA(1, 0, At, B0); PG8_MMA(1, 1, At, B1); PG8_BAR; PG8_SCHED;
            PG8_LDB(B0, 1, 0); PG8_LDB(B1, 1, 1); PG8_SCHED; PG8_LDA(At, 1, 0); PG8_STAGE(PG8_SA(0, 1), a2 + hstep, voffA);
            PG8_WAIT_V(8); PG8_WAIT_L(0); PG8_BAR; PG8_MMA(0, 0, At, B0); PG8_MMA(0, 1, At, B1); PG8_BAR; PG8_SCHED;
            PG8_LDA(At, 1, 1); PG8_STAGE(PG8_SB(1, 0), b3, voffB); PG8_STAGE(PG8_SB(1, 1), b3 + hstep, voffB); PG8_STAGE(PG8_SA(1, 0), a3, voffA);
            PG8_WAIT_V(8); PG8_WAIT_L(0); PG8_BAR; PG8_MMA(1, 0, At, B0); PG8_MMA(1, 1, At, B1); PG8_BAR; PG8_SCHED;
            } else {
            PG8_LDB(B0, 0, 0); PG8_SCHED; PG8_LDA(At, 0, 0); PG8_STAGE(PG8_SA(1, 1), a1 + hstep, voffA);
            PG8_WAIT_L(8); PG8_BAR; PG8_WAIT_L(0); PG8_MMA(0, 0, At, B0); PG8_BAR; PG8_SCHED;
            PG8_LDB(B1, 0, 1); PG8_STAGE(PG8_SB(0, 0), b2, voffB);
            PG8_BAR; PG8_WAIT_L(0); PG8_MMA(0, 1, At, B1); PG8_BAR;
            PG8_LDA(At, 0, 1); PG8_STAGE(PG8_SA(0, 0), a2, voffA);
            PG8_BAR; PG8_WAIT_L(0); PG8_MMA(1, 0, At, B0); PG8_BAR; PG8_SCHED;
            PG8_STAGE(PG8_SB(0, 1), b2 + hstep, voffB);
            PG8_WAIT_V(6); PG8_BAR; PG8_MMA(1, 1, At, B1); PG8_BAR;
            PG8_LDB(B0, 1, 0); PG8_SCHED; PG8_LDA(At, 1, 0); PG8_STAGE(PG8_SA(0, 1), a2 + hstep, voffA);
            PG8_WAIT_L(8); PG8_BAR; PG8_WAIT_L(0); PG8_MMA(0, 0, At, B0); PG8_BAR; PG8_SCHED;
            PG8_LDB(B1, 1, 1); PG8_STAGE(PG8_SB(1, 0), b3, voffB);
            PG8_BAR; PG8_WAIT_L(0); PG8_MMA(0, 1, At, B1); PG8_BAR;
            PG8_LDA(At, 1, 1); PG8_STAGE(PG8_SA(1, 0), a3, voffA);
            PG8_BAR; PG8_WAIT_L(0); PG8_MMA(1, 0, At, B0); PG8_BAR; PG8_SCHED;
            PG8_STAGE(PG8_SB(1, 1), b3 + hstep, voffB);
            PG8_WAIT_V(6); PG8_BAR; PG8_MMA(1, 1, At, B1); PG8_BAR;
            }
        }
        if constexpr (ALIGN_EPI) { if (wr == 0) PG8_BAR; }
        if constexpr (!Epi::AFTER_DRAIN) { E(acc, cur, wr, wc, fr, fq); S.done(cur); }
        if (!has_next) break;
#pragma unroll
        for (int a = 0; a < 2; ++a)
#pragma unroll
            for (int b = 0; b < 2; ++b)
#pragma unroll
                for (int m = 0; m < 4; ++m)
#pragma unroll
                    for (int n = 0; n < 2; ++n) acc[a][b][m][n] = (f32x4){0.f, 0.f, 0.f, 0.f};
        cur = nxt; cA = nA; cB = nB; ++ui;
        if constexpr (ALIGN_EPI) { if (wr == 1) PG8_BAR; }
    }
    PG8_WAIT_V(0);
    if constexpr (!ALIGN_EPI) { if (wr == 0) PG8_BAR; }
    PG8_BAR;
    if constexpr (Epi::AFTER_DRAIN) { E.fused(acc, cur, wr, wc, fr, fq, lds, wid, lane); S.done(cur); }
#undef PG8_SA
#undef PG8_SB
#undef PG8_STAGE
#undef PG8_LDA
#undef PG8_LDB
#undef PG8_MMA
#undef PG8_WAIT_V
#undef PG8_WAIT_L
#undef PG8_BAR
#undef PG8_SCHED
}
}

#define XB_TMO      128
#define XB_XCNT(j)  (256  + 64 * (j))
#define XB_XSUB(j)  (1280 + 64 * (j))
#define XB_XGEN(j)  (2304 + 64 * (j))
#define XB_TOP      3328
#define XB_TOPGEN   3392
#define XCD_BAR_WORDS 3456
#define XB_SPIN_CAP (1u << 18)

__device__ __forceinline__ unsigned xb_ld(unsigned* p)              { return __hip_atomic_load(p, __ATOMIC_RELAXED, __HIP_MEMORY_SCOPE_AGENT); }
__device__ __forceinline__ unsigned xb_add(unsigned* p, unsigned v) { return __hip_atomic_fetch_add(p, v, __ATOMIC_RELAXED, __HIP_MEMORY_SCOPE_AGENT); }
__device__ __forceinline__ unsigned xb_xcc_id() { return (unsigned)__builtin_amdgcn_s_getreg((3 << 11) | 20) & 0xFu; }
#define XB_SPIN(cond, bar) do { unsigned _sp = 0; while (cond) { __builtin_amdgcn_s_sleep(1); \
    if ((++_sp & 255u) == 0u) { if (xb_ld(&(bar)[XB_TMO])) break; if (_sp > XB_SPIN_CAP) { atomicAdd(&(bar)[XB_TMO], 1u); break; } } } } while (0)

struct XcdBarrier {
    unsigned* bar; unsigned x;
    volatile LAS unsigned* st;
};

__device__ __forceinline__ XcdBarrier xcd_barrier_post(unsigned* bar, volatile LAS unsigned* st) {
    XcdBarrier b; b.bar = bar; b.x = xb_xcc_id(); b.st = st;
    if (threadIdx.x == 0) (void)xb_add(&bar[XB_XCNT(b.x)], 1u);
    return b;
}
__device__ __forceinline__ void xcd_barrier_complete(unsigned* bar, unsigned x, unsigned& nloc, unsigned& nx) {
    const unsigned G = gridDim.x * gridDim.y * gridDim.z;
    unsigned sum, cnt, mine, sp = 0u;
    for (;;) {
        sum = 0u; cnt = 0u; mine = 0u;
#pragma unroll
        for (unsigned j = 0; j < 16; ++j) { const unsigned c = xb_ld(&bar[XB_XCNT(j)]); sum += c; cnt += (c > 0u) ? 1u : 0u; mine = (j == x) ? c : mine; }
        if (sum == G) break;
        __builtin_amdgcn_s_sleep(1);
        if ((++sp & 255u) == 0u) { if (xb_ld(&bar[XB_TMO])) break; if (sp > XB_SPIN_CAP) { atomicAdd(&bar[XB_TMO], 1u); break; } }
    }
    nloc = mine > 0u ? mine : 1u; nx = cnt > 0u ? cnt : 1u;
}

__device__ __forceinline__ void xcd_barrier(const XcdBarrier& b) {
    asm volatile("s_waitcnt vmcnt(0)" ::: "memory");
    __syncthreads();
    if (threadIdx.x == 0) {
        unsigned* bar = b.bar;
        __builtin_amdgcn_s_waitcnt(0);
        unsigned nloc = b.st[0], nx = b.st[1];
        if (nloc == 0u) { xcd_barrier_complete(bar, b.x, nloc, nx); b.st[0] = nloc; b.st[1] = nx; }
        const unsigned old = xb_add(&bar[XB_XSUB(b.x)], 1u);
        const unsigned gen = old / nloc;
        if (old + 1u == (gen + 1u) * nloc) {
            __builtin_amdgcn_fence(__ATOMIC_RELEASE, "agent");
            asm volatile("s_waitcnt vmcnt(0)" ::: "memory");
            const unsigned og = xb_add(&bar[XB_TOP], 1u);
            const unsigned tg = og / nx;
            if (og + 1u == (tg + 1u) * nx) xb_add(&bar[XB_TOPGEN], 1u);
            else XB_SPIN(xb_ld(&bar[XB_TOPGEN]) == tg, bar);
            __builtin_amdgcn_fence(__ATOMIC_ACQUIRE, "agent");
            xb_add(&bar[XB_XGEN(b.x)], 1u);
            asm volatile("s_waitcnt vmcnt(0)" ::: "memory");
        } else {
            XB_SPIN(xb_ld(&bar[XB_XGEN(b.x)]) == gen, bar);
            __builtin_amdgcn_fence(__ATOMIC_ACQUIRE, "agent");
            asm volatile("s_waitcnt vmcnt(0)" ::: "memory");
        }
    }
    __syncthreads();
}


struct Args { const float* in[23]; float* out; unsigned char* ws; int ph_lo, ph_hi; };
enum { I_X = 0, I_C, I_WADA, I_BADA, I_N1, I_W1IN, I_W1OUT, I_NMIX, I_WIN, I_CONVW, I_CONVB, I_WRG, I_BRG, I_WIG, I_BIG, I_LAM, I_WBA, I_WBL, I_WOUT, I_N2, I_W2IN, I_W2OUT, I_NF };

DI void conv_tile(LAS float* buf, const float* src, int lds_, bf16_t* dst, int ldd) {
    const int tid = threadIdx.x;
    float4 v[8];
#pragma unroll
    for (int i = 0; i < 8; ++i) { const int k = (tid >> 4) + 32 * i, cgp = tid & 15; v[i] = *(const float4*)(src + (size_t)k * lds_ + cgp * 4); }
#pragma unroll
    for (int i = 0; i < 8; ++i) { const int k = (tid >> 4) + 32 * i, cgp = tid & 15; LAS float* p = buf + k * 65 + cgp * 4; p[0] = v[i].x; p[1] = v[i].y; p[2] = v[i].z; p[3] = v[i].w; }
    __syncthreads();
#pragma unroll
    for (int i = 0; i < 4; ++i) { const int q = tid + 512 * i, g = q >> 6, kg = (g & 3) * 8 + (q & 7), n = (g >> 2) * 8 + ((q >> 3) & 7); float f[8];
#pragma unroll
        for (int j = 0; j < 8; ++j) f[j] = buf[(kg * 8 + j) * 65 + n];
        u32x4 o; o.x = pk_bf16(f[0], f[1]); o.y = pk_bf16(f[2], f[3]); o.z = pk_bf16(f[4], f[5]); o.w = pk_bf16(f[6], f[7]);
        *(u32x4*)(dst + (size_t)n * ldd + kg * 8) = o; }
    __syncthreads();
}
DI void conv_tile64(LAS float* buf, const float* src, int lds_, bf16_t* dst, int ldd) {
    const int tid = threadIdx.x;
#pragma unroll
    for (int i = 0; i < 2; ++i) { const int k = (tid >> 4) + 32 * i, cgp = tid & 15; const float4 v = *(const float4*)(src + (size_t)k * lds_ + cgp * 4);
        LAS float* p = buf + k * 65 + cgp * 4; p[0] = v.x; p[1] = v.y; p[2] = v.z; p[3] = v.w; }
    __syncthreads();
    { const int kg = tid & 7, n = tid >> 3; float f[8];
#pragma unroll
        for (int j = 0; j < 8; ++j) f[j] = buf[(kg * 8 + j) * 65 + n];
        u32x4 o; o.x = pk_bf16(f[0], f[1]); o.y = pk_bf16(f[2], f[3]); o.z = pk_bf16(f[4], f[5]); o.w = pk_bf16(f[6], f[7]);
        *(u32x4*)(dst + (size_t)n * ldd + kg * 8) = o; }
    __syncthreads();
}
DI void conv_job(LAS float* buf, int& rot, const float* src, int ldsrc, int K, int Nd, bf16_t* dst, int lddst, int koff, int map) {
    const int G = gridDim.x, KT = (map == 4) ? 64 : 256, tn_n = Nd >> 6, ntile = tn_n * (K / KT);
    for (int t = (int)((blockIdx.x + rot) % G); t < ntile; t += G) {
        const int tn = t % tn_n, tk = t / tn_n, n0 = tn * 64, k0 = tk * KT;
        if (map == 4) { conv_tile64(buf, src + (size_t)(n0 >> 7) * 16384 + (size_t)k0 * 128 + (n0 & 127), ldsrc, dst + (size_t)n0 * lddst + koff + k0, lddst); continue; }
        int c0 = n0;
        if (map == 1) { const int pn = n0 >> 8, rr = n0 & 255; c0 = rr < 128 ? 128 * pn + rr : DFF + 128 * pn + rr - 128; }
        else if (map == 2) c0 = n0 < 2048 ? n0 : n0 + 1024;
        else if (map == 3) c0 = 2048 + n0;
        conv_tile(buf, src + (size_t)k0 * ldsrc + c0, ldsrc, dst + (size_t)n0 * lddst + koff + k0, lddst);
    }
    rot = (rot + G - ntile % G) % G;
}
DI void mod_items(LAS float* lf, const float* c, const float* w_ada, const float* b_ada, float* mod) {
    const int tid = threadIdx.x;
    if (blockIdx.x >= 288) return;
    for (int i = tid; i < 8192; i += 512) { const float v = c[i]; lf[i] = v * sigmoidf_(v); }
    __syncthreads();
    LAS float* part = lf + 8192;
    for (int it = blockIdx.x; it < 288; it += gridDim.x) {
        const int col0 = it * 64, cgp = tid & 15, ks = tid >> 4;
        float acc[4][4];
#pragma unroll
        for (int b = 0; b < 4; ++b)
#pragma unroll
            for (int j = 0; j < 4; ++j) acc[b][j] = 0.f;
        const float* wp = w_ada + (size_t)(ks * 64) * NMOD + col0 + cgp * 4;
#pragma unroll 16
        for (int k = 0; k < 64; ++k) { const float4 w = *(const float4*)(wp + (size_t)k * NMOD);
#pragma unroll
            for (int b = 0; b < 4; ++b) { const float cv = lf[b * 2048 + ks * 64 + k]; acc[b][0] += cv * w.x; acc[b][1] += cv * w.y; acc[b][2] += cv * w.z; acc[b][3] += cv * w.w; } }
#pragma unroll
        for (int b = 0; b < 4; ++b)
#pragma unroll
            for (int j = 0; j < 4; ++j) part[(ks * 16 + cgp) * 16 + b * 4 + j] = acc[b][j];
        __syncthreads();
        if (tid < 256) { const int b = tid >> 6, cc = tid & 63; float s = 0.f;
            for (int k2 = 0; k2 < 32; ++k2) s += part[(k2 * 16 + (cc >> 2)) * 16 + b * 4 + (cc & 3)];
            mod[b * NMOD + col0 + cc] = s + b_ada[col0 + cc]; }
        __syncthreads();
    }
}

template <bool FINAL>
DI void norm_phase(const float* src, const float* gain, const float* mod, int ish, bf16_t* dst, float* dstf) {
    const int lane = threadIdx.x & 63, wave = threadIdx.x >> 6;
    for (int r = blockIdx.x * 8 + wave; r < T; r += gridDim.x * 8) {
        const float* xp = src + (size_t)r * D; f32x4 v[8]; float ss = 0.f;
#pragma unroll
        for (int i = 0; i < 8; ++i) { v[i] = *(const f32x4*)(xp + (i * 64 + lane) * 4); ss += v[i][0] * v[i][0] + v[i][1] * v[i][1] + v[i][2] * v[i][2] + v[i][3] * v[i][3]; }
#pragma unroll
        for (int off = 32; off >= 1; off >>= 1) ss += __shfl_xor(ss, off);
        const float rstd = rsqrtf(ss * (1.0f / D) + EPS);
        const float* sh = mod + (size_t)(r >> 12) * NMOD + ish * D; const float* sc = sh + D;
#pragma unroll
        for (int i = 0; i < 8; ++i) { const int col = (i * 64 + lane) * 4; const f32x4 g = *(const f32x4*)(gain + col);
            f32x4 y = v[i] * rstd * g;
            if (FINAL) *(f32x4*)(dstf + (size_t)r * D + col) = y;
            else { const f32x4 s4 = *(const f32x4*)(sh + col), c4 = *(const f32x4*)(sc + col); y = y * (1.0f + c4) + s4;
                u32x2 w; w.x = pk_bf16(y[0], y[1]); w.y = pk_bf16(y[2], y[3]); *(u32x2*)(dst + (size_t)r * D + col) = w; } }
    }
}

constexpr int AT_KROW = 272, AT_VROW = 144, AT_KB = 64 * AT_KROW, AT_BUF = AT_KB + 128 * AT_VROW;
DI f32x16 attn_qk(const LAS unsigned char* kp, const bf16x8 (&qf)[8]) {
    f32x16 s;
#pragma unroll
    for (int i = 0; i < 16; ++i) s[i] = 0.f;
#pragma unroll
    for (int ks = 0; ks < 8; ++ks) { const bf16x8 a = *(const LAS bf16x8*)(kp + ks * 32); s = __builtin_amdgcn_mfma_f32_32x32x16_bf16(a, qf[ks], s, 0, 0, 0); }
    return s;
}
DI void attn_ew(const f32x16& s, float& C, int half, int ks0, int tq, bool MASKED, bf16x8& pf0, bf16x8& pf1) {
    float kp_[16];
#pragma unroll
    for (int i = 0; i < 16; ++i) kp_[i] = fast_rcp(1.0f + fast_exp2(s[i]));
    if (MASKED) {
        asm volatile("" ::: "memory");
#pragma unroll
        for (int i = 0; i < 16; ++i) { const int key = ks0 + 16 * (i >> 3) + 8 * half + (i & 7); kp_[i] = key < tq ? kp_[i] : 1.0f; } }
    float d[16]; float PA = 1.0f, PB = 1.0f;
#pragma unroll
    for (int i = 15; i >= 8; --i) { const float nx = PB * kp_[i]; d[i] = PB - nx; PB = nx; }
#pragma unroll
    for (int i = 7; i >= 0; --i) { const float nx = PA * kp_[i]; d[i] = PA - nx; PA = nx; }
    const float PAo = __shfl_xor(PA, 32), PBo = __shfl_xor(PB, 32);
    const float t1 = C * PBo, t3 = C * (PB * PBo), t4 = t3 * PAo;
    const float stB = half ? C : t1;
    const float stA = half ? t3 : t4;
    C = C * ((PA * PAo) * (PB * PBo));
    float w[16];
#pragma unroll
    for (int i = 0; i < 8; ++i) { asm("v_mul_f32 %0, %1, %2" : "=v"(w[i]) : "v"(d[i]), "v"(stA)); asm("v_mul_f32 %0, %1, %2" : "=v"(w[8 + i]) : "v"(d[8 + i]), "v"(stB)); }
    u32x4 p0, p1;
    p0.x = pk_bf16(w[0], w[1]); p0.y = pk_bf16(w[2], w[3]); p0.z = pk_bf16(w[4], w[5]); p0.w = pk_bf16(w[6], w[7]);
    p1.x = pk_bf16(w[8], w[9]); p1.y = pk_bf16(w[10], w[11]); p1.z = pk_bf16(w[12], w[13]); p1.w = pk_bf16(w[14], w[15]);
    pf0 = __builtin_bit_cast(bf16x8, p0); pf1 = __builtin_bit_cast(bf16x8, p1);
}
DI void attn_pv(const LAS unsigned char* vp0, const bf16x8& pf0, const bf16x8& pf1, f32x16 (&o)[4]) {
#pragma unroll
    for (int d = 0; d < 4; ++d) { const LAS unsigned char* vp = vp0 + d * 32 * AT_VROW;
        const bf16x8 v0 = *(const LAS bf16x8*)(vp), v1 = *(const LAS bf16x8*)(vp + 32);
        o[d] = __builtin_amdgcn_mfma_f32_32x32x16_bf16(v0, pf0, o[d], 0, 0, 0);
        o[d] = __builtin_amdgcn_mfma_f32_32x32x16_bf16(v1, pf1, o[d], 0, 0, 0); }
}
DI void attn_item(LAS unsigned char* lds, const bf16_t* P, const bf16_t* VT, bf16_t* YM, int b, int h, int qb) {
    const int tid = threadIdx.x, lane = tid & 63, wave = __builtin_amdgcn_readfirstlane(tid >> 6), l32 = lane & 31, half = lane >> 5;
    const int t0 = qb * 256 + wave * 32, tq = t0 + l32;
    const size_t tokbase = (size_t)b * SEQ;
    bf16x8 qf[8];
    { const bf16_t* qp = P + (tokbase + tq) * PW + h * 128 + 8 * half;
#pragma unroll
      for (int ks = 0; ks < 8; ++ks) qf[ks] = *(const bf16x8*)(qp + 16 * ks); }
    f32x16 o[4];
#pragma unroll
    for (int d = 0; d < 4; ++d)
#pragma unroll
        for (int i = 0; i < 16; ++i) o[d][i] = 0.f;
    float C = 1.0f;
    const int ktmax = qb * 4 + 3;
    const bf16_t* Kg = P + tokbase * PW + 1024 + h * 128;
    const bf16_t* Vg = VT + (size_t)(h * 128) * T + tokbase;
    unsigned ko[2], vo[2]; int kl[2], vl[2];
#pragma unroll
    for (int i = 0; i < 2; ++i) { const int p = tid + 512 * i; const int key = p >> 4, part = p & 15; ko[i] = (unsigned)(key * PW + part * 8); kl[i] = key * AT_KROW + part * 16;
        const int d = p >> 3, pv = p & 7; vo[i] = (unsigned)(d * T + pv * 8); vl[i] = AT_KB + d * AT_VROW + pv * 16; }
    u32x4 rk[2], rv[2];
    { const bf16_t* kb = Kg + (size_t)ktmax * 64 * PW; const bf16_t* vb = Vg + ktmax * 64;
#pragma unroll
      for (int i = 0; i < 2; ++i) { rk[i] = *(const u32x4*)(kb + ko[i]); rv[i] = *(const u32x4*)(vb + vo[i]); } }
#pragma unroll
    for (int i = 0; i < 2; ++i) { *(LAS u32x4*)(lds + kl[i]) = rk[i]; *(LAS u32x4*)(lds + vl[i]) = rv[i]; }
#pragma unroll
    for (int ks = 0; ks < 8; ++ks) asm volatile("" : "+v"(qf[ks]));
    __syncthreads();
    const int pir = (l32 & 0x13) | ((l32 & 8) >> 1) | ((l32 & 4) << 1);
    const int koff = pir * AT_KROW + half * 16, voff = l32 * AT_VROW + half * 16;
    int cur = 0;
    for (int kt = ktmax; kt >= 0; --kt) {
        if (kt > 0) { const bf16_t* kb = Kg + (size_t)(kt - 1) * 64 * PW; const bf16_t* vb = Vg + (kt - 1) * 64;
#pragma unroll
            for (int i = 0; i < 2; ++i) { rk[i] = *(const u32x4*)(kb + ko[i]); rv[i] = *(const u32x4*)(vb + vo[i]); } }
        const LAS unsigned char* Kb = lds + cur * AT_BUF + koff; const LAS unsigned char* Vb = lds + cur * AT_BUF + AT_KB + voff;
        if (kt * 64 < t0 + 31) {
            const bool need_mask = (kt * 64 + 63 >= t0);
            bf16x8 pa0, pa1, pb0, pb1;
            const f32x16 s1 = attn_qk(Kb + 32 * AT_KROW, qf);
            const f32x16 s0 = attn_qk(Kb, qf);
            attn_ew(s1, C, half, kt * 64 + 32, tq, need_mask, pa0, pa1);
            attn_pv(Vb + 64, pa0, pa1, o);
            attn_ew(s0, C, half, kt * 64, tq, need_mask, pb0, pb1);
            attn_pv(Vb, pb0, pb1, o);
        }
        if (kt > 0) { LAS unsigned char* nb = lds + (cur ^ 1) * AT_BUF;
#pragma unroll
            for (int i = 0; i < 2; ++i) { *(LAS u32x4*)(nb + kl[i]) = rk[i]; *(LAS u32x4*)(nb + vl[i]) = rv[i]; } }
        __syncthreads();
        cur ^= 1;
    }
    bf16_t* yp = YM + (tokbase + tq) * D + h * 128 + 4 * half;
#pragma unroll
    for (int d = 0; d < 4; ++d)
#pragma unroll
        for (int q4 = 0; q4 < 4; ++q4) { u32x2 w; w.x = pk_bf16(o[d][q4 * 4], o[d][q4 * 4 + 1]); w.y = pk_bf16(o[d][q4 * 4 + 2], o[d][q4 * 4 + 3]); *(u32x2*)(yp + d * 32 + q4 * 8) = w; }
}

struct LruP { const bf16_t* P; const bf16_t* WG; const float* conv_w; const float* conv_b; const float* b_r; const float* b_i; const float* lam; float* lsum; bf16_t* YM; bf16_t* YA; };
DI void lru_item(LAS unsigned char* lds, const LruP& q, int ck, int n) {
    const int tid = threadIdx.x, lane = tid & 63, wave = __builtin_amdgcn_readfirstlane(tid >> 6);
    const int lc = ck & 63; const size_t tok0 = (size_t)ck * 64;
    LAS float* xcf = (LAS float*)lds;
    LAS float* la = xcf + 64 * 129;
    LAS float* lu = la + 64 * 129;
    LAS float* sg = lu + 64 * 129;
    LAS unsigned char* xcb = (LAS unsigned char*)(sg + 2048);
    const int c = tid & 127, sgi = tid >> 7, ch = n * 128 + c;
    const int fr = lane & 15, fq = lane >> 4;
    const bf16_t* xp = q.P + (tok0 + sgi * 16) * PW + 2048 + ch;
    const bool has_prev = (lc * 64 + sgi * 16) > 0;
    bf16_t xr[19];
#pragma unroll
    for (int t = 0; t < 3; ++t) xr[t] = has_prev ? xp[(t - 3) * PW] : (bf16_t)0;
#pragma unroll
    for (int t = 0; t < 16; ++t) xr[3 + t] = xp[(size_t)t * PW];
    bf16x8 wbr[4], wbi[4];
    { const bf16_t* wrp = q.WG + (size_t)(n * 128 + wave * 16 + fr) * 128 + fq * 8; const bf16_t* wip = wrp + 8 * 128 * 128;
#pragma unroll
      for (int ks = 0; ks < 4; ++ks) { wbr[ks] = *(const bf16x8*)(wrp + ks * 32); wbi[ks] = *(const bf16x8*)(wip + ks * 32); } }
    bf16_t grv[16];
    { const bf16_t* gp = q.P + (tok0 + sgi * 16) * PW + 3072 + ch;
#pragma unroll
      for (int t = 0; t < 16; ++t) grv[t] = gp[(size_t)t * PW]; }
    const float w0 = q.conv_w[ch], w1 = q.conv_w[1024 + ch], w2 = q.conv_w[2048 + ch], w3 = q.conv_w[3072 + ch], cb = q.conv_b[ch];
    const int c2 = wave * 16 + fr, ch2 = n * 128 + c2; const float brv = q.b_r[ch2], biv = q.b_i[ch2]; const float L = -8.0f * log1pf(expf(-q.lam[ch2]));
#pragma unroll
    for (int t = 0; t < 16; ++t) { const float y = w0 * bf_f(xr[t]) + w1 * bf_f(xr[t + 1]) + w2 * bf_f(xr[t + 2]) + w3 * bf_f(xr[t + 3]) + cb;
        xcf[(sgi * 16 + t) * 129 + c] = y; *(LAS bf16_t*)(xcb + (sgi * 16 + t) * 272 + c * 2) = to_bf16(y); }
    __syncthreads();
    f32x4 ar[4], ai[4];
#pragma unroll
    for (int m = 0; m < 4; ++m) { ar[m] = (f32x4){0.f, 0.f, 0.f, 0.f}; ai[m] = (f32x4){0.f, 0.f, 0.f, 0.f}; }
#pragma unroll
    for (int ks = 0; ks < 4; ++ks)
#pragma unroll
        for (int m = 0; m < 4; ++m) { const bf16x8 av = *(const LAS bf16x8*)(xcb + (m * 16 + fr) * 272 + (ks * 32 + fq * 8) * 2);
            ar[m] = __builtin_amdgcn_mfma_f32_16x16x32_bf16(av, wbr[ks], ar[m], 0, 0, 0); ai[m] = __builtin_amdgcn_mfma_f32_16x16x32_bf16(av, wbi[ks], ai[m], 0, 0, 0); }
#pragma unroll
    for (int m = 0; m < 4; ++m)
#pragma unroll
        for (int j = 0; j < 4; ++j) { const int t = m * 16 + fq * 4 + j; const float r = sigmoidf_(ar[m][j] + brv), ig = sigmoidf_(ai[m][j] + biv);
            const float lga = r * L; const float av = fast_exp2(lga * LOG2E); const float x = 2.0f * lga;
            const float om = -x * (1.0f + x * 0.5f * (1.0f + x * (1.0f / 3.0f) * (1.0f + x * 0.25f * (1.0f + x * 0.2f * (1.0f + x * (1.0f / 6.0f))))));
            la[t * 129 + c2] = av; lu[t * 129 + c2] = sqrtf(om) * ig * xcf[t * 129 + c2]; }
    __syncthreads();
    float av_[16], uv_[16];
#pragma unroll
    for (int t = 0; t < 16; ++t) { av_[t] = la[(sgi * 16 + t) * 129 + c]; uv_[t] = lu[(sgi * 16 + t) * 129 + c]; }
    { float A = 1.0f, H = 0.f;
#pragma unroll
      for (int t = 0; t < 16; ++t) { H = av_[t] * H + uv_[t]; A *= av_[t]; }
      sg[sgi * 128 + c] = A; sg[512 + sgi * 128 + c] = H; }
    __syncthreads();
    float Ar = 1.0f, Hr = 0.f;
#pragma unroll
    for (int s2 = 0; s2 < 3; ++s2) { if (s2 < sgi) { const float as = sg[s2 * 128 + c], hs = sg[512 + s2 * 128 + c]; Hr = as * Hr + hs; Ar *= as; } }
    bf16_t* yl = q.YM + (tok0 + sgi * 16) * D + 1024 + ch;
    bf16_t* ya = q.YA + (tok0 + sgi * 16) * 1024 + ch;
#pragma unroll
    for (int t = 0; t < 16; ++t) { Hr = av_[t] * Hr + uv_[t]; Ar *= av_[t];
        const float g = bf_f(grv[t]); const float ge = g * sigmoidf_(1.5957691216057308f * (g + 0.044715f * g * g * g));
        yl[(size_t)t * D] = to_bf16(Hr * ge); ya[(size_t)t * 1024] = to_bf16(Ar * ge); }
    if (sgi == 3) *(f32x2v*)(q.lsum + ((size_t)ck * 1024 + ch) * 2) = (f32x2v){Ar, Hr};
    __syncthreads();
}
DI void lru_fix(LAS unsigned char* lds, const LruP& q, int ck, int n) {
    const int tid = threadIdx.x; const int bq = ck >> 6, lc = ck & 63; const size_t tok0 = (size_t)ck * 64;
    LAS float* sg = (LAS float*)lds;
    const int c = tid & 127, sgi = tid >> 7, ch = n * 128 + c;
    if (lc == 0) return;
    bf16_t* yl = q.YM + (tok0 + sgi * 16) * D + 1024 + ch;
    const bf16_t* ya = q.YA + (tok0 + sgi * 16) * 1024 + ch;
    bf16_t l[16], a[16];
#pragma unroll
    for (int t = 0; t < 16; ++t) { l[t] = yl[(size_t)t * D]; a[t] = ya[(size_t)t * 1024]; }
    const float* sp = q.lsum + ((size_t)(bq * 64 + sgi * 16) * 1024 + ch) * 2;
    f32x2v sv[16];
#pragma unroll
    for (int j = 0; j < 16; ++j) sv[j] = *(const f32x2v*)(sp + (size_t)j * 2048);
    float cA = 1.0f, cH = 0.f;
#pragma unroll
    for (int j = 0; j < 16; ++j) { const bool ok = (sgi * 16 + j) < lc; const float aj = ok ? sv[j][0] : 1.0f, hj = ok ? sv[j][1] : 0.f; cH = aj * cH + hj; cA *= aj; }
    sg[sgi * 128 + c] = cA; sg[512 + sgi * 128 + c] = cH;
    __syncthreads();
    float hc = 0.f;
#pragma unroll
    for (int s2 = 0; s2 < 4; ++s2) hc = sg[s2 * 128 + c] * hc + sg[512 + s2 * 128 + c];
#pragma unroll
    for (int t = 0; t < 16; ++t) yl[(size_t)t * D] = to_bf16(bf_f(l[t]) + bf_f(a[t]) * hc);
    __syncthreads();
}

constexpr int NPH = 14;
__global__ void __launch_bounds__(512, 2) fwd(Args a) {
    extern __shared__ __attribute__((aligned(16))) unsigned char lds_raw[];
    LAS unsigned char* lds = (LAS unsigned char*)lds_raw;
    cg::grid_group grid = cg::this_grid();
    const int lo = a.ph_lo, hi = a.ph_hi, G = gridDim.x, bx = blockIdx.x;
    unsigned char* ws = a.ws;
    float* mod = (float*)(ws + WS_MOD); float* lsum = (float*)(ws + WS_LSUM);
    bf16_t* W1IN = (bf16_t*)(ws + WS_W1IN); bf16_t* W1OUT = (bf16_t*)(ws + WS_W1OUT); bf16_t* W2IN = (bf16_t*)(ws + WS_W2IN); bf16_t* W2OUT = (bf16_t*)(ws + WS_W2OUT);
    bf16_t* WINM = (bf16_t*)(ws + WS_WINM); bf16_t* WV = (bf16_t*)(ws + WS_WV); bf16_t* WBR = (bf16_t*)(ws + WS_WBR); bf16_t* WO = (bf16_t*)(ws + WS_WO); bf16_t* WG = (bf16_t*)(ws + WS_WG);
    bf16_t* Y = (bf16_t*)(ws + WS_Y); bf16_t* P = (bf16_t*)(ws + WS_P); bf16_t* Hb = P; bf16_t* VT = (bf16_t*)(ws + WS_VT); bf16_t* YM = (bf16_t*)(ws + WS_YM); bf16_t* MG = Y;
    float* out = a.out;
#ifndef PHASE_MASK
#define PHASE_MASK 0x3fff
#endif
#define IN(k) (((PHASE_MASK >> (k)) & 1) && lo <= (k) && (k) < hi)
#ifndef DUPMASK
#define DUPMASK 0
#endif
#ifndef DUPCNT
#define DUPCNT 1
#endif
#define REP(k) for (int rep_ = 0; rep_ < 1 + DUPCNT * ((DUPMASK >> (k)) & 1); ++rep_)
#define SEAM(k) do { if (IN(k) && IN((k) + 1)) xcd_barrier(xbar); } while (0)
    if (threadIdx.x < 4) ((LAS unsigned*)(lds + LDS_MAIN))[threadIdx.x] = 0u;
    __syncthreads();
    XcdBarrier xbar; xbar.bar = (unsigned*)(ws + WS_BAR); xbar.x = 0; xbar.st = (volatile LAS unsigned*)(lds + LDS_MAIN);
    if (hi - lo > 1) xbar = xcd_barrier_post((unsigned*)(ws + WS_BAR), (volatile LAS unsigned*)(lds + LDS_MAIN));
    if (hi > 1000) grid.sync();
    using namespace pg8;
    if (IN(0)) REP(0) {
        mod_items((LAS float*)lds, a.in[I_C], a.in[I_WADA], a.in[I_BADA], mod);
        LAS float* buf = (LAS float*)lds; int rot = 0;
        conv_job(buf, rot, a.in[I_W1IN], 2 * DFF, D, 2 * DFF, W1IN, D, 0, 1);
        conv_job(buf, rot, a.in[I_W1OUT], D, DFF, D, W1OUT, DFF, 0, 0);
        conv_job(buf, rot, a.in[I_WIN], 9216, D, 8192, WINM, D, 0, 2);
        conv_job(buf, rot, a.in[I_WIN], 9216, D, 1024, WV, D, 0, 3);
        conv_job(buf, rot, a.in[I_WBA], D, 1024, D, WBR, D, 0, 0);
        conv_job(buf, rot, a.in[I_WBL], D, 1024, D, WBR, D, 1024, 0);
        conv_job(buf, rot, a.in[I_WOUT], D, D, D, WO, D, 0, 0);
        conv_job(buf, rot, a.in[I_WRG], 128, 128, 1024, WG, 128, 0, 4);
        conv_job(buf, rot, a.in[I_WIG], 128, 128, 1024, WG + 8 * 128 * 128, 128, 0, 4);
        conv_job(buf, rot, a.in[I_W2IN], 2 * DFF, D, 2 * DFF, W2IN, D, 0, 1);
        conv_job(buf, rot, a.in[I_W2OUT], D, DFF, D, W2OUT, DFF, 0, 0);
    }
    SEAM(0);
#ifdef EXTRA_SYNCS
    for (int es = 0; es < EXTRA_SYNCS; ++es) xcd_barrier(xbar);
#endif
    if (IN(1)) REP(1) norm_phase<false>(a.in[I_X], a.in[I_N1], mod, 0, Y, nullptr);
    SEAM(1);
    if (IN(2) && ((DUPMASK >> 2) & 1)) { Gemm g{Y, W1IN, T, 2 * DFF, D}; StaticOrder S; S.init(T, 2 * DFF, G, bx); EpiSwiGLU E{Hb}; gemm_phase<EpiSwiGLU, StaticOrder, true, true>(lds, g, S, E); }
    if (IN(2)) { Gemm g{Y, W1IN, T, 2 * DFF, D}; StaticOrder S; S.init(T, 2 * DFF, G, bx); EpiSwiGLU E{Hb}; gemm_phase<EpiSwiGLU, StaticOrder, true, true>(lds, g, S, E); }
    SEAM(2);
    if (IN(3) && ((DUPMASK >> 3) & 1)) { Gemm g{Hb, W1OUT, T, D, DFF}; StaticOrder S; S.init(T, D, G, bx, 4); EpiResid E{a.in[I_X], out, mod + 2 * D, 0.5f}; gemm_phase<EpiResid, StaticOrder, true, true>(lds, g, S, E); }
    if (IN(3)) { Gemm g{Hb, W1OUT, T, D, DFF}; StaticOrder S; S.init(T, D, G, bx, 4); EpiResid E{a.in[I_X], out, mod + 2 * D, 0.5f}; gemm_phase<EpiResid, StaticOrder, true, true>(lds, g, S, E); }
    SEAM(3);
    if (IN(4)) norm_phase<false>(out, a.in[I_NMIX], mod, 3, Y, nullptr);
    SEAM(4);
    if (IN(5)) {
        { Gemm g{Y, WINM, T, 8192, D}; StaticOrder S; S.init(T, 8192, G, bx); EpiP E{P, PW, 4, QSCALE}; gemm_phase<EpiP, StaticOrder, true, true>(lds, g, S, E); }
        { Gemm g{WV, Y, 1024, T, D}; StaticOrder S; S.init(1024, T, G, bx); EpiP E{VT, T, 0, 1.0f}; gemm_phase<EpiP, StaticOrder, true, true>(lds, g, S, E); }
    }
    SEAM(5);
    LruP lq{P, WG, a.in[I_CONVW], a.in[I_CONVB], a.in[I_BRG], a.in[I_BIG], a.in[I_LAM], lsum, YM, Y};
    if (IN(6)) {
        REP(6) for (int p0 = bx; p0 < 256; p0 += G) { const int p = (G == 256) ? ((p0 & 7) * 32 + (p0 >> 3)) : p0;
            const int bh = p >> 3, jp = p & 7; attn_item(lds, P, VT, YM, bh >> 3, bh & 7, 15 - jp); attn_item(lds, P, VT, YM, bh >> 3, bh & 7, jp); }
        REP(14) for (int it = bx; it < 2048; it += G) lru_item(lds, lq, it >> 3, it & 7);
    }
    SEAM(6);
    if (IN(7)) { for (int it = bx; it < 2048; it += G) lru_fix(lds, lq, it >> 3, it & 7); }
    SEAM(7);
    if (IN(8)) { Gemm g{YM, WBR, T, D, D}; StaticOrder S; S.init(T, D, G, bx, 4); EpiBranch E{P, MG}; gemm_phase<EpiBranch, StaticOrder, true, true>(lds, g, S, E); }
    SEAM(8);
    if (IN(9)) { Gemm g{MG, WO, T, D, D}; StaticOrder S; S.init(T, D, G, bx, 4); EpiResid E{out, out, mod + 5 * D, 1.0f}; gemm_phase<EpiResid, StaticOrder, true, true>(lds, g, S, E); }
    SEAM(9);
    if (IN(10)) norm_phase<false>(out, a.in[I_N2], mod, 6, Y, nullptr);
    SEAM(10);
    if (IN(11)) { Gemm g{Y, W2IN, T, 2 * DFF, D}; StaticOrder S; S.init(T, 2 * DFF, G, bx); EpiSwiGLU E{Hb}; gemm_phase<EpiSwiGLU, StaticOrder, true, true>(lds, g, S, E); }
    SEAM(11);
    if (IN(12)) { Gemm g{Hb, W2OUT, T, D, DFF}; StaticOrder S; S.init(T, D, G, bx, 4); EpiResid E{out, out, mod + 8 * D, 0.5f}; gemm_phase<EpiResid, StaticOrder, true, true>(lds, g, S, E); }
    SEAM(12);
    if (IN(13)) norm_phase<true>(out, a.in[I_NF], mod, 0, nullptr, out);
}

#ifndef ONE_LAUNCH
#define ONE_LAUNCH 1
#endif
extern "C" void kernel_launch(void* const* d_in, const int* in_sizes, int n_in, void* d_out, int out_size, void* d_ws, size_t ws_size, hipStream_t stream) {
    static int grid = 0;
    if (grid == 0) {
        if (n_in != 23 || out_size != T * D || ws_size < WS_END) { fprintf(stderr, "kernel_launch: unexpected shapes (n_in %d out %d ws %zu need %zu)\n", n_in, out_size, ws_size, (size_t)WS_END); grid = -1; return; }
        int dev = 0, cus = 0, per_cu = 0;
        hipGetDevice(&dev); hipDeviceGetAttribute(&cus, hipDeviceAttributeMultiprocessorCount, dev);
        if (hipFuncSetAttribute((const void*)fwd, hipFuncAttributeMaxDynamicSharedMemorySize, LDS_BYTES) != hipSuccess) { fprintf(stderr, "kernel_launch: hipFuncSetAttribute failed\n"); grid = -1; return; }
        if (hipOccupancyMaxActiveBlocksPerMultiprocessor(&per_cu, (const void*)fwd, 512, LDS_BYTES) != hipSuccess || per_cu < 1) { fprintf(stderr, "kernel_launch: occupancy query says %d\n", per_cu); per_cu = 1; }
        (void)hipGetLastError();
        grid = cus * per_cu;
        if (grid > 256) grid = 256;
    }
    if (grid < 0) return;
    Args a{};
    for (int i = 0; i < 23; ++i) a.in[i] = (const float*)d_in[i];
    a.out = (float*)d_out; a.ws = (unsigned char*)d_ws;
#if ONE_LAUNCH
    if (hipMemsetAsync((char*)d_ws + WS_BAR, 0, 16384, stream) != hipSuccess) { fprintf(stderr, "kernel_launch: memset of the barrier words failed\n"); return; }
    a.ph_lo = 0; a.ph_hi = NPH;
    void* args[] = {&a};
    hipError_t e = hipLaunchCooperativeKernel((const void*)fwd, dim3(grid), dim3(512), args, LDS_BYTES, stream);
    if (e != hipSuccess) fprintf(stderr, "cooperative launch failed: %s (grid %d)\n", hipGetErrorString(e), grid);
#else
    for (int ph = 0; ph < NPH; ++ph) { a.ph_lo = ph; a.ph_hi = ph + 1; hipLaunchKernelGGL(fwd, dim3(grid), dim3(512), LDS_BYTES, stream, a); }
#endif
}
```

```cpp
#include <hip/hip_runtime.h>
#include <hip/hip_cooperative_groups.h>
#include <cstdio>
#include <cstdint>
namespace cg = cooperative_groups;

#define DI __device__ __forceinline__
#define LAS __attribute__((address_space(3)))

constexpr int T = 16384, D = 2048, DFF = 5632, SEQ = 4096;
constexpr int NMOD = 9 * D;
constexpr int PW = 8192;
constexpr float EPS = 1e-6f;
constexpr float LOG2E = 1.4426950408889634f;
constexpr float QSCALE = 0.08838834764831845f * 1.4426950408889634f;
constexpr int LDS_MAIN = 131072;
constexpr int LDS_BYTES = LDS_MAIN + 16;

constexpr size_t WS_BAR   = 0;
constexpr size_t WS_MOD   = 16384;
constexpr size_t WS_LSUM  = WS_MOD + (size_t)4 * NMOD * 4;
constexpr size_t WS_W1IN  = WS_LSUM + (size_t)256 * 1024 * 8;
constexpr size_t WS_W1OUT = WS_W1IN + (size_t)2 * DFF * D * 2;
constexpr size_t WS_W2IN  = WS_W1OUT + (size_t)D * DFF * 2;
constexpr size_t WS_W2OUT = WS_W2IN + (size_t)2 * DFF * D * 2;
constexpr size_t WS_WINM  = WS_W2OUT + (size_t)D * DFF * 2;
constexpr size_t WS_WV    = WS_WINM + (size_t)8192 * D * 2;
constexpr size_t WS_WBR   = WS_WV + (size_t)1024 * D * 2;
constexpr size_t WS_WO    = WS_WBR + (size_t)D * D * 2;
constexpr size_t WS_WG    = WS_WO + (size_t)D * D * 2;
constexpr size_t WS_Y     = WS_WG + (size_t)2 * 8 * 128 * 128 * 2;
constexpr size_t WS_P     = WS_Y + (size_t)T * D * 2;
constexpr size_t WS_VT    = WS_P + (size_t)T * PW * 2;
constexpr size_t WS_YM    = WS_VT + (size_t)1024 * T * 2;
constexpr size_t WS_SS    = WS_YM + (size_t)T * D * 2;
constexpr size_t WS_SHW   = WS_SS + (size_t)2 * T * 4;
constexpr size_t WS_SS3   = WS_SHW + (size_t)4 * (9216 + 11264) * 4;
constexpr size_t WS_CNT3  = WS_SS3 + (size_t)T * 4;
constexpr size_t WS_CNTL  = WS_CNT3 + (size_t)64 * 256;
constexpr size_t WS_END   = WS_CNTL + (size_t)32 * 256;

typedef unsigned short bf16_t;
typedef short bf16x8 __attribute__((ext_vector_type(8)));
typedef float f32x4 __attribute__((ext_vector_type(4)));
typedef float f32x16 __attribute__((ext_vector_type(16)));
typedef float f32x2v __attribute__((ext_vector_type(2)));
typedef __bf16 bf16x2v __attribute__((ext_vector_type(2)));
typedef unsigned u32x4 __attribute__((ext_vector_type(4)));
typedef unsigned u32x2 __attribute__((ext_vector_type(2)));

DI unsigned pk_bf16(float lo, float hi) { f32x2v f = {lo, hi}; bf16x2v b = __builtin_convertvector(f, bf16x2v); return __builtin_bit_cast(unsigned, b); }
DI bf16_t to_bf16(float x) { return (bf16_t)(pk_bf16(x, 0.f) & 0xffffu); }
DI float bf_lo(unsigned u) { return __uint_as_float(u << 16); }
DI float bf_hi(unsigned u) { return __uint_as_float(u & 0xffff0000u); }
DI float bf_f(bf16_t h) { return __uint_as_float(((unsigned)h) << 16); }
DI float fast_exp2(float x) { return __builtin_amdgcn_exp2f(x); }
DI float fast_rcp(float x) { return __builtin_amdgcn_rcpf(x); }
DI float sigmoidf_(float x) { return fast_rcp(1.0f + fast_exp2(-x * LOG2E)); }

namespace pg8 {
#define PG8_LAS __attribute__((address_space(3)))
constexpr int BM = 256, BK = 64, HALF = 128, HTB = HALF * BK * 2, STAGE_BYTES = 8 * HTB, NXCD = 8, WGM = 8;
__host__ __device__ __forceinline__ int lds_byte(int r, int c) { const int st = (r >> 4) * 2 + (c >> 5), rr = r & 15, cc = c & 31, ob = rr * 64 + cc * 2; return st * 1024 + (ob ^ (((ob >> 9) & 1) << 5)); }
__host__ __device__ __forceinline__ void stage_rc(int b, int& R, int& C) { const int st = b / 1024, sb = b % 1024, swz = sb ^ (((sb >> 9) & 1) << 5); R = (st >> 1) * 16 + swz / 64; C = (st & 1) * 32 + (swz % 64) / 2; }
__host__ __device__ __forceinline__ int perm32(int rho) { const int n = rho >> 4, i = rho & 15; return 8 * (i >> 2) + 4 * n + (i & 3); }
struct Unit { int pm, pn; };
struct Gemm { const bf16_t* A; const bf16_t* Bt; int M, N, K; int rev = 0; };
struct StaticOrder {
    int nM, nN, nwg, G, c, wgm;
    __host__ __device__ void init(int M, int N, int G_, int c_, int wgm_ = WGM) { nM = M / BM; nN = N / BM; nwg = nM * nN; G = G_; c = c_; wgm = wgm_; }
    __host__ __device__ bool next(int i, Unit& u) const {
        const long L = (long)i * G + c; if (L >= nwg) return false;
        int wgid = (int)L; { const int q = nwg / NXCD, r = nwg % NXCD, xcd = wgid % NXCD, off = wgid / NXCD; wgid = (xcd < r ? xcd * (q + 1) : r * (q + 1) + (xcd - r) * q) + off; }
        const int nig = wgm * nN, gid = wgid / nig, fm = gid * wgm, gsz = (nM - fm) < wgm ? (nM - fm) : wgm;
        u.pm = fm + ((wgid % nig) % gsz); u.pn = (wgid % nig) / gsz; return true;
    }
    __device__ __forceinline__ void a_ready(const Unit&) const {}
    __device__ __forceinline__ void done(const Unit&) const {}
};

struct EpiSwiGLU {
    static constexpr bool PERM = true, AFTER_DRAIN = false, MID = false, PREFETCH = false, MUT = false;
    bf16_t* H;
    DI void mid(f32x4 (&)[2][2][4][2], const Unit&, int, int, int, int) const {}
    DI void operator()(const f32x4 (&acc)[2][2][4][2], const Unit& u, int wr, int wc, int fr, int fq) const {
        const int row0 = u.pm * BM + wr * 64 + fr, col0 = u.pn * HALF + wc * 32 + 8 * fq;
#pragma unroll
        for (int ai = 0; ai < 2; ++ai)
#pragma unroll
            for (int m = 0; m < 4; ++m) {
                float o[8];
#pragma unroll
                for (int n = 0; n < 2; ++n)
#pragma unroll
                    for (int j = 0; j < 4; ++j) { const float g = acc[ai][0][m][n][j], up = acc[ai][1][m][n][j]; o[n * 4 + j] = g * sigmoidf_(g) * up; }
                u32x4 w; w.x = pk_bf16(o[0], o[1]); w.y = pk_bf16(o[2], o[3]); w.z = pk_bf16(o[4], o[5]); w.w = pk_bf16(o[6], o[7]);
                *(u32x4*)(H + (size_t)(row0 + ai * HALF + m * 16) * DFF + col0) = w;
            }
    }
};
struct EpiResid {
    static constexpr bool PERM = false, AFTER_DRAIN = false, MID = false, PREFETCH = false, MUT = false;
    const float* resid; float* out; const float* gmod; float coef;
    DI void prefetch(unsigned (&pfv)[4], const Unit& u, int wr, int wc, int fr, int fq) const {
        int row0 = u.pm * BM + wr * 64 + fr, col0 = u.pn * BM + wc * 32;
        asm volatile("" : "+v"(row0), "+v"(col0));
#pragma unroll
        for (int j = 0; j < 4; ++j) { const int am = fq * 2 + (j & 1), bj = j >> 1;
            pfv[j] = *(const unsigned*)(resid + (size_t)(row0 + (am >> 2) * HALF + (am & 3) * 16) * D + col0 + bj * HALF); }
    }
    DI void mid(f32x4 (&)[2][2][4][2], const Unit&, int, int, int, int) const {}
    DI void operator()(const f32x4 (&acc)[2][2][4][2], const Unit& u, int wr, int wc, int fr, int fq) const {
        const int row0 = u.pm * BM + wr * 64 + fr, col0 = u.pn * BM + wc * 32 + 4 * fq;
        const float* gv = gmod + (size_t)(u.pm >> 4) * NMOD + col0;
        f32x4 g[2][2];
#pragma unroll
        for (int bj = 0; bj < 2; ++bj)
#pragma unroll
            for (int n = 0; n < 2; ++n) g[bj][n] = *(const f32x4*)(gv + bj * HALF + n * 16) * coef;
#pragma unroll
        for (int ai = 0; ai < 2; ++ai)
#pragma unroll
            for (int m = 0; m < 4; ++m) { const size_t off = (size_t)(row0 + ai * HALF + m * 16) * D + col0;
#pragma unroll
                for (int bj = 0; bj < 2; ++bj)
#pragma unroll
                    for (int n = 0; n < 2; ++n) { const f32x4 r = *(const f32x4*)(resid + off + bj * HALF + n * 16); *(f32x4*)(out + off + bj * HALF + n * 16) = r + g[bj][n] * acc[ai][bj][m][n]; }
                asm volatile("" ::: "memory"); }
    }
};
struct EpiResidN {
    static constexpr bool PERM = false, AFTER_DRAIN = false, MID = false, PREFETCH = false, MUT = false;
    const float* resid; float* out; const float* gmod; bf16_t* An; const float* gain; const float* scmod; float* ss; float coef; int pad_;
    DI void mid(f32x4 (&)[2][2][4][2], const Unit&, int, int, int, int) const {}
    DI void operator()(const f32x4 (&acc)[2][2][4][2], const Unit& u, int wr, int wc, int fr, int fq) const {
        const int row0 = u.pm * BM + wr * 64 + fr, col0 = u.pn * BM + wc * 32 + 4 * fq;
        const float* gv = gmod + (size_t)(u.pm >> 4) * NMOD + col0; const float* sv = scmod + (size_t)(u.pm >> 4) * NMOD + col0;
        f32x4 g[2][2], gm[2][2];
#pragma unroll
        for (int bj = 0; bj < 2; ++bj)
#pragma unroll
            for (int n = 0; n < 2; ++n) { g[bj][n] = *(const f32x4*)(gv + bj * HALF + n * 16) * coef; gm[bj][n] = *(const f32x4*)(gain + col0 + bj * HALF + n * 16) * (*(const f32x4*)(sv + bj * HALF + n * 16) + 1.0f); }
#pragma unroll
        for (int ai = 0; ai < 2; ++ai)
#pragma unroll
            for (int m = 0; m < 4; ++m) { const int r = row0 + ai * HALF + m * 16; const size_t off = (size_t)r * D + col0; float sq = 0.f;
#pragma unroll
                for (int bj = 0; bj < 2; ++bj)
#pragma unroll
                    for (int n = 0; n < 2; ++n) { const f32x4 rr = *(const f32x4*)(resid + off + bj * HALF + n * 16); const f32x4 h = rr + g[bj][n] * acc[ai][bj][m][n];
                        *(f32x4*)(out + off + bj * HALF + n * 16) = h; sq += h[0] * h[0] + h[1] * h[1] + h[2] * h[2] + h[3] * h[3];
                        const f32x4 a = h * gm[bj][n]; u32x2 w; w.x = pk_bf16(a[0], a[1]); w.y = pk_bf16(a[2], a[3]); *(u32x2*)(An + off + bj * HALF + n * 16) = w; }
                sq += __shfl_xor(sq, 16); sq += __shfl_xor(sq, 32);
                if (fq == 0) unsafeAtomicAdd(ss + r, sq);
                asm volatile("" ::: "memory"); }
    }
};
struct EpiFinal {
    static constexpr bool PERM = false, AFTER_DRAIN = false, MID = false, PREFETCH = false, MUT = true;
    const float* resid; float* out; const float* gmod; const float* gfin; float* ss; unsigned* cnt; float coef; int pad_;
    DI void mid(f32x4 (&)[2][2][4][2], const Unit&, int, int, int, int) const {}
    DI void fin(f32x4 (&acc)[2][2][4][2], const Unit& u, int wr, int wc, int fr, int fq) const {
        const int row0 = u.pm * BM + wr * 64 + fr, col0 = u.pn * BM + wc * 32 + 4 * fq;
        { const float* gv = gmod + (size_t)(u.pm >> 4) * NMOD + col0;
          f32x4 g[2][2]; float olds[2][4];
#pragma unroll
          for (int bj = 0; bj < 2; ++bj)
#pragma unroll
              for (int n = 0; n < 2; ++n) g[bj][n] = *(const f32x4*)(gv + bj * HALF + n * 16) * coef;
#pragma unroll
          for (int ai = 0; ai < 2; ++ai)
#pragma unroll
              for (int m = 0; m < 4; ++m) { const int r = row0 + ai * HALF + m * 16; const size_t off = (size_t)r * D + col0; float sq = 0.f;
#pragma unroll
                  for (int bj = 0; bj < 2; ++bj)
#pragma unroll
                      for (int n = 0; n < 2; ++n) { const f32x4 rr = *(const f32x4*)(resid + off + bj * HALF + n * 16); const f32x4 h = rr + g[bj][n] * acc[ai][bj][m][n];
                          acc[ai][bj][m][n] = h; sq += h[0] * h[0] + h[1] * h[1] + h[2] * h[2] + h[3] * h[3]; }
                  sq += __shfl_xor(sq, 16); sq += __shfl_xor(sq, 32);
                  olds[ai][m] = 0.f;
                  if (fq == 0) olds[ai][m] = unsafeAtomicAdd(ss + r, sq);
                  asm volatile("" ::: "memory"); }
#pragma unroll
          for (int ai = 0; ai < 2; ++ai)
#pragma unroll
              for (int m = 0; m < 4; ++m) asm volatile("" :: "v"(olds[ai][m])); }
        asm volatile("s_waitcnt vmcnt(0)" ::: "memory");
        unsigned* c = cnt + u.pm * 64;
        if (fr == 0 && fq == 0) __hip_atomic_fetch_add(c, 1u, __ATOMIC_RELAXED, __HIP_MEMORY_SCOPE_AGENT);
        { unsigned spins = 0;
          while (__hip_atomic_load(c, __ATOMIC_RELAXED, __HIP_MEMORY_SCOPE_AGENT) < 64u) { __builtin_amdgcn_s_sleep(2); if (++spins > (1u << 22)) break; } }
        asm volatile("" ::: "memory");
        f32x4 gf[2][2];
#pragma unroll
        for (int bj = 0; bj < 2; ++bj)
#pragma unroll
            for (int n = 0; n < 2; ++n) gf[bj][n] = *(const f32x4*)(gfin + col0 + bj * HALF + n * 16);
#pragma unroll
        for (int ai = 0; ai < 2; ++ai)
#pragma unroll
            for (int m = 0; m < 4; ++m) { const int r = row0 + ai * HALF + m * 16; const size_t off = (size_t)r * D + col0;
                const float rs = rsqrtf(__hip_atomic_load(ss + r, __ATOMIC_RELAXED, __HIP_MEMORY_SCOPE_AGENT) * (1.0f / D) + EPS);
#pragma unroll
                for (int bj = 0; bj < 2; ++bj)
#pragma unroll
                    for (int n = 0; n < 2; ++n) *(f32x4*)(out + off + bj * HALF + n * 16) = acc[ai][bj][m][n] * rs * gf[bj][n]; }
    }
};
DI float rstd_of(const float* ss, int r) { return rsqrtf(ss[r] * (1.0f / D) + EPS); }
struct EpiSwiGLUN {
    static constexpr bool PERM = true, AFTER_DRAIN = false, MID = false, PREFETCH = false, MUT = false;
    bf16_t* H; const float* ss; const float* shw;
    DI void mid(f32x4 (&)[2][2][4][2], const Unit&, int, int, int, int) const {}
    DI void operator()(const f32x4 (&acc)[2][2][4][2], const Unit& u, int wr, int wc, int fr, int fq) const {
        const int row0 = u.pm * BM + wr * 64 + fr, col0 = u.pn * HALF + wc * 32 + 8 * fq;
        const float* sp = shw + (size_t)(u.pm >> 4) * (2 * DFF) + u.pn * BM + wc * 32 + 8 * fq;
        f32x4 sg[2], su[2];
#pragma unroll
        for (int n = 0; n < 2; ++n) { sg[n] = *(const f32x4*)(sp + 4 * n); su[n] = *(const f32x4*)(sp + HALF + 4 * n); }
#pragma unroll
        for (int ai = 0; ai < 2; ++ai)
#pragma unroll
            for (int m = 0; m < 4; ++m) { const int r = row0 + ai * HALF + m * 16; const float rs = rstd_of(ss, r);
                float o[8];
#pragma unroll
                for (int n = 0; n < 2; ++n)
#pragma unroll
                    for (int j = 0; j < 4; ++j) { const float g = acc[ai][0][m][n][j] * rs + sg[n][j], up = acc[ai][1][m][n][j] * rs + su[n][j]; o[n * 4 + j] = g * sigmoidf_(g) * up; }
                u32x4 w; w.x = pk_bf16(o[0], o[1]); w.y = pk_bf16(o[2], o[3]); w.z = pk_bf16(o[4], o[5]); w.w = pk_bf16(o[6], o[7]);
                *(u32x4*)(H + (size_t)r * DFF + col0) = w; }
    }
};
struct EpiPN {
    static constexpr bool PERM = true, AFTER_DRAIN = false, MID = false, PREFETCH = false, MUT = false;
    bf16_t* O; int ldc; int nscale; float scale; const float* ss; const float* shw; int shld;
    DI void mid(f32x4 (&)[2][2][4][2], const Unit&, int, int, int, int) const {}
    DI void operator()(const f32x4 (&acc)[2][2][4][2], const Unit& u, int wr, int wc, int fr, int fq) const {
        const int row0 = u.pm * BM + wr * 64 + fr, col0 = u.pn * BM + wc * 32 + 8 * fq;
        const float s = (u.pn < nscale) ? scale : 1.0f;
        const float* sp = shw + (size_t)(u.pm >> 4) * shld + col0;
        f32x4 sh[2][2];
#pragma unroll
        for (int bj = 0; bj < 2; ++bj)
#pragma unroll
            for (int n = 0; n < 2; ++n) sh[bj][n] = *(const f32x4*)(sp + bj * HALF + 4 * n);
#pragma unroll
        for (int ai = 0; ai < 2; ++ai)
#pragma unroll
            for (int m = 0; m < 4; ++m) { const int r = row0 + ai * HALF + m * 16; const float rs = rstd_of(ss, r); bf16_t* p = O + (size_t)r * ldc + col0;
#pragma unroll
                for (int bj = 0; bj < 2; ++bj) { const f32x4 v0 = (acc[ai][bj][m][0] * rs + sh[bj][0]) * s, v1 = (acc[ai][bj][m][1] * rs + sh[bj][1]) * s;
                    u32x4 w; w.x = pk_bf16(v0[0], v0[1]); w.y = pk_bf16(v0[2], v0[3]); w.z = pk_bf16(v1[0], v1[1]); w.w = pk_bf16(v1[2], v1[3]);
                    *(u32x4*)(p + bj * HALF) = w; } }
    }
};
struct EpiVTN {
    static constexpr bool PERM = true, AFTER_DRAIN = false, MID = false, PREFETCH = false, MUT = false;
    bf16_t* O; const float* ss; const float* shw;
    DI void mid(f32x4 (&)[2][2][4][2], const Unit&, int, int, int, int) const {}
    DI void operator()(const f32x4 (&acc)[2][2][4][2], const Unit& u, int wr, int wc, int fr, int fq) const {
        const int row0 = u.pm * BM + wr * 64 + fr, col0 = u.pn * BM + wc * 32 + 8 * fq;
        const float* sp = shw + (size_t)(u.pn >> 4) * 9216;
        f32x4 rs[2][2];
#pragma unroll
        for (int bj = 0; bj < 2; ++bj)
#pragma unroll
            for (int n = 0; n < 2; ++n) { const f32x4 q = *(const f32x4*)(ss + col0 + bj * HALF + 4 * n);
#pragma unroll
                for (int j = 0; j < 4; ++j) rs[bj][n][j] = rsqrtf(q[j] * (1.0f / D) + EPS); }
#pragma unroll
        for (int ai = 0; ai < 2; ++ai)
#pragma unroll
            for (int m = 0; m < 4; ++m) { const int r = row0 + ai * HALF + m * 16; const float shv = sp[r]; bf16_t* p = O + (size_t)r * T + col0;
#pragma unroll
                for (int bj = 0; bj < 2; ++bj) { const f32x4 v0 = acc[ai][bj][m][0] * rs[bj][0] + shv, v1 = acc[ai][bj][m][1] * rs[bj][1] + shv;
                    u32x4 w; w.x = pk_bf16(v0[0], v0[1]); w.y = pk_bf16(v0[2], v0[3]); w.z = pk_bf16(v1[0], v1[1]); w.w = pk_bf16(v1[2], v1[3]);
                    *(u32x4*)(p + bj * HALF) = w; } }
    }
};
struct EpiP {
    static constexpr bool PERM = true, AFTER_DRAIN = false, MID = false, PREFETCH = false, MUT = false;
    bf16_t* O; int ldc; int nscale; float scale;
    DI void mid(f32x4 (&)[2][2][4][2], const Unit&, int, int, int, int) const {}
    DI void operator()(const f32x4 (&acc)[2][2][4][2], const Unit& u, int wr, int wc, int fr, int fq) const {
        const int row0 = u.pm * BM + wr * 64 + fr, col0 = u.pn * BM + wc * 32 + 8 * fq;
        const float s = (u.pn < nscale) ? scale : 1.0f;
#pragma unroll
        for (int ai = 0; ai < 2; ++ai)
#pragma unroll
            for (int m = 0; m < 4; ++m) { bf16_t* p = O + (size_t)(row0 + ai * HALF + m * 16) * ldc + col0;
#pragma unroll
                for (int bj = 0; bj < 2; ++bj) { const f32x4 v0 = acc[ai][bj][m][0] * s, v1 = acc[ai][bj][m][1] * s;
                    u32x4 w; w.x = pk_bf16(v0[0], v0[1]); w.y = pk_bf16(v0[2], v0[3]); w.z = pk_bf16(v1[0], v1[1]); w.w = pk_bf16(v1[2], v1[3]);
                    *(u32x4*)(p + bj * HALF) = w; } }
    }
};
struct EpiBranch {
    #ifdef TEST_NOMID
    static constexpr bool PERM = true, AFTER_DRAIN = false, MID = false, PREFETCH = false, MUT = false;
#else
    static constexpr bool PERM = true, AFTER_DRAIN = false, MID = true, PREFETCH = false, MUT = false;
#endif
    const bf16_t* P; bf16_t* O;
    DI static float cl(float x) { return fminf(fmaxf(x, -60.f), 60.f); }
    DI void mid(f32x4 (&acc)[2][2][4][2], const Unit& u, int wr, int wc, int fr, int fq) const {
        int row0 = u.pm * BM + wr * 64 + fr, col0 = u.pn * BM + wc * 32 + 8 * fq;
        asm volatile("" : "+v"(row0), "+v"(col0));
#pragma unroll
        for (int ai = 0; ai < 2; ++ai)
#pragma unroll
            for (int m = 0; m < 4; ++m) { const bf16_t* gp = P + (size_t)(row0 + ai * HALF + m * 16) * PW + 4096 + col0;
#pragma unroll
                for (int bj = 0; bj < 2; ++bj) { const u32x4 ga = *(const u32x4*)(gp + bj * HALF), gl = *(const u32x4*)(gp + 2048 + bj * HALF);
#pragma unroll
                    for (int q = 0; q < 4; ++q) { const float a0 = cl(bf_lo(ga[q])), a1 = cl(bf_hi(ga[q])), l0 = cl(bf_lo(gl[q])), l1 = cl(bf_hi(gl[q]));
                        const float r0 = (1.0f + fast_exp2(-l0 * LOG2E)) * fast_rcp(1.0f + fast_exp2(-a0 * LOG2E));
                        const float r1 = (1.0f + fast_exp2(-l1 * LOG2E)) * fast_rcp(1.0f + fast_exp2(-a1 * LOG2E));
                        acc[ai][bj][m][q >> 1][(q & 1) * 2] *= r0; acc[ai][bj][m][q >> 1][(q & 1) * 2 + 1] *= r1; } }
                asm volatile("" ::: "memory"); }
    }
    DI void operator()(const f32x4 (&acc)[2][2][4][2], const Unit& u, int wr, int wc, int fr, int fq) const {
        const int row0 = u.pm * BM + wr * 64 + fr, col0 = u.pn * BM + wc * 32 + 8 * fq;
#pragma unroll
        for (int ai = 0; ai < 2; ++ai)
#pragma unroll
            for (int m = 0; m < 4; ++m) { const size_t r = (size_t)(row0 + ai * HALF + m * 16); const bf16_t* gp = P + r * PW + 6144 + col0;
#pragma unroll
                for (int bj = 0; bj < 2; ++bj) { const u32x4 gl = *(const u32x4*)(gp + bj * HALF); float o[8];
#pragma unroll
                    for (int q = 0; q < 4; ++q) { const float l0 = cl(bf_lo(gl[q])), l1 = cl(bf_hi(gl[q]));
                        o[q * 2] = acc[ai][bj][m][q >> 1][(q & 1) * 2] * fast_rcp(1.0f + fast_exp2(-l0 * LOG2E));
                        o[q * 2 + 1] = acc[ai][bj][m][q >> 1][(q & 1) * 2 + 1] * fast_rcp(1.0f + fast_exp2(-l1 * LOG2E)); }
                    u32x4 w; w.x = pk_bf16(o[0], o[1]); w.y = pk_bf16(o[2], o[3]); w.z = pk_bf16(o[4], o[5]); w.w = pk_bf16(o[6], o[7]);
                    *(u32x4*)(O + r * D + col0 + bj * HALF) = w; }
                asm volatile("" ::: "memory"); }
    }
};

template <class Epi, class Sched, bool ALIGN_EPI = false, bool SP2 = false>
__device__ __forceinline__ void gemm_phase(PG8_LAS unsigned char* lds, const Gemm g, const Sched& S, const Epi& E) {
    const int tid = threadIdx.x, wid = __builtin_amdgcn_readfirstlane(tid >> 6), lane = tid & 63, wr = wid >> 2, wc = wid & 3, fr = lane & 15, fq = lane >> 4;
    const int K = g.K, nt = K / BK;
    unsigned voffA[2], voffB[2];
#pragma unroll
    for (int i = 0; i < 2; ++i) { int R, C; stage_rc(tid * 16 + i * 8192, R, C); const int Rb = Epi::PERM ? ((R & ~31) + perm32(R & 31)) : R;
        voffA[i] = (unsigned)(R * K + C) * 2u; voffB[i] = (unsigned)(Rb * K + C) * 2u; }
    const long kstep = g.rev ? -(long)(BK * 2) : (long)(BK * 2);
    const size_t kfirst = g.rev ? (size_t)(nt - 1) * (size_t)(BK * 2) : 0;
    const size_t hstep = (size_t)HALF * K * 2;
    const size_t tstep = 2 * hstep;
    const unsigned ldsw = (unsigned)wid * 1024u;
    const int aoff = lds_byte(wr * 64 + fr, fq * 8), boff = lds_byte(wc * 32 + fr, fq * 8);
#define PG8_SA(b, h) (((b) * 2 + (h)) * HTB)
#define PG8_SB(b, h) ((4 + (b) * 2 + (h)) * HTB)
#define PG8_STAGE(bufoff, gbase, voff) do { _Pragma("unroll") for (int _i = 0; _i < 2; ++_i) \
        __builtin_amdgcn_global_load_lds((const unsigned*)((const char*)(gbase) + (voff)[_i]), (PG8_LAS unsigned*)(lds + (bufoff) + ldsw + _i * 8192), 16, 0, 0); } while (0)
#define PG8_LDA(dst, b, h) do { _Pragma("unroll") for (int m = 0; m < 4; ++m) _Pragma("unroll") for (int k = 0; k < 2; ++k) dst[m][k] = *(const PG8_LAS bf16x8*)(lds + PG8_SA(b, h) + aoff + m * 2048 + k * 1024); } while (0)
#define PG8_LDB(dst, b, h) do { _Pragma("unroll") for (int n = 0; n < 2; ++n) _Pragma("unroll") for (int k = 0; k < 2; ++k) dst[n][k] = *(const PG8_LAS bf16x8*)(lds + PG8_SB(b, h) + boff + n * 2048 + k * 1024); } while (0)
#define PG8_MMA(ai, bj, At, Bt) do { __builtin_amdgcn_s_setprio(1); _Pragma("unroll") for (int m = 0; m < 4; ++m) _Pragma("unroll") for (int n = 0; n < 2; ++n) _Pragma("unroll") for (int k = 0; k < 2; ++k) \
        acc[ai][bj][m][n] = __builtin_amdgcn_mfma_f32_16x16x32_bf16(Bt[n][k], At[m][k], acc[ai][bj][m][n], 0, 0, 0); __builtin_amdgcn_s_setprio(0); } while (0)
#define PG8_WAIT_V(n) asm volatile("s_waitcnt vmcnt(" #n ")" ::: "memory")
#define PG8_WAIT_L(n) asm volatile("s_waitcnt lgkmcnt(" #n ")" ::: "memory")
#define PG8_BAR __builtin_amdgcn_s_barrier()
#define PG8_SCHED __builtin_amdgcn_sched_barrier(0)
    Unit cur, nxt; int ui = 0;
    if (!S.next(0, cur)) return;
    f32x4 acc[2][2][4][2];
#pragma unroll
    for (int a = 0; a < 2; ++a)
#pragma unroll
        for (int b = 0; b < 2; ++b)
#pragma unroll
            for (int m = 0; m < 4; ++m)
#pragma unroll
                for (int n = 0; n < 2; ++n) acc[a][b][m][n] = (f32x4){0.f, 0.f, 0.f, 0.f};
    bf16x8 At[4][2], B0[2][2], B1[2][2];
    unsigned pfv[4] = {0u, 0u, 0u, 0u};
    const char* cA = (const char*)g.A + (size_t)cur.pm * tstep + kfirst; const char* cB = (const char*)g.Bt + (size_t)cur.pn * tstep + kfirst;
    S.a_ready(cur);
    if constexpr (SP2) {
        PG8_STAGE(PG8_SB(0, 0), cB, voffB); PG8_STAGE(PG8_SB(0, 1), cB + hstep, voffB); PG8_STAGE(PG8_SA(0, 0), cA, voffA); PG8_STAGE(PG8_SA(0, 1), cA + hstep, voffA);
        if (wr == 1) PG8_BAR;
        PG8_WAIT_V(2); PG8_BAR;
        PG8_STAGE(PG8_SB(1, 0), cB + kstep, voffB); PG8_STAGE(PG8_SA(1, 0), cA + kstep, voffA); PG8_STAGE(PG8_SB(1, 1), cB + hstep + kstep, voffB);
        PG8_WAIT_V(6); PG8_BAR;
    } else {
        PG8_STAGE(PG8_SB(0, 0), cB, voffB); PG8_STAGE(PG8_SA(0, 0), cA, voffA); PG8_STAGE(PG8_SB(0, 1), cB + hstep, voffB); PG8_STAGE(PG8_SA(0, 1), cA + hstep, voffA);
        if (wr == 1) PG8_BAR;
        PG8_WAIT_V(4); PG8_BAR;
        PG8_STAGE(PG8_SB(1, 0), cB + kstep, voffB); PG8_STAGE(PG8_SA(1, 0), cA + kstep, voffA); PG8_STAGE(PG8_SB(1, 1), cB + hstep + kstep, voffB);
        PG8_WAIT_V(6); PG8_BAR;
    }
    for (;;) {
        const bool has_next = S.next(ui + 1, nxt);
        const char* nA = has_next ? (const char*)g.A + (size_t)nxt.pm * tstep + kfirst : cA; const char* nB = has_next ? (const char*)g.Bt + (size_t)nxt.pn * tstep + kfirst : cB;
        for (int t = 0; t < nt; t += 2) {
            const bool last = (t == nt - 2);
            const char* a1 = cA + (long)(t + 1) * kstep;
            const char* a2 = last ? nA : cA + (long)(t + 2) * kstep; const char* b2 = last ? nB : cB + (long)(t + 2) * kstep;
            const char* a3 = a2 + kstep; const char* b3 = b2 + kstep;
            if (last && has_next) S.a_ready(nxt);
            if constexpr (Epi::MID) { PG8_SCHED; if (t == nt / 2) E.mid(acc, cur, wr, wc, fr, fq); PG8_SCHED; }
            if constexpr (Epi::PREFETCH) { if (t == nt - 4) E.prefetch(pfv, cur, wr, wc, fr, fq); }
            if constexpr (SP2) {
            PG8_LDB(B0, 0, 0); PG8_LDB(B1, 0, 1); PG8_SCHED; PG8_LDA(At, 0, 0); PG8_STAGE(PG8_SA(1, 1), a1 + hstep, voffA);
            PG8_WAIT_V(8); PG8_WAIT_L(0); PG8_BAR; PG8_MMA(0, 0, At, B0); PG8_MMA(0, 1, At, B1); PG8_BAR; PG8_SCHED;
            PG8_LDA(At, 0, 1); PG8_STAGE(PG8_SB(0, 0), b2, voffB); PG8_STAGE(PG8_SB(0, 1), b2 + hstep, voffB); PG8_STAGE(PG8_SA(0, 0), a2, voffA);
            PG8_WAIT_V(8); PG8_WAIT_L(0); PG8_BAR; PG8_MMA(1, 0, At, B0); PG8_MMA(1, 1, At, B1); PG8_BAR; PG8_SCHED;
            PG8_LDB(B0, 1, 0); PG8_LDB(B1, 1, 1); PG8_SCHED; PG8_LDA(At, 1, 0); PG8_STAGE(PG8_SA(0, 1), a2 + hstep, voffA);
            PG8_WAIT_V(8); PG8_WAIT_L(0); PG8_BAR; PG8_MMA(0, 0, At, B0); PG8_MMA(0, 1, At, B1); PG8_BAR; PG8_SCHED;
            PG8_LDA(At, 1, 1); PG8_STAGE(PG8_SB(1, 0), b3, voffB); PG8_STAGE(PG8_SB(1, 1), b3 + hstep, voffB); PG8_STAGE(PG8_SA(1, 0), a3, voffA);
            PG8_WAIT_V(8); PG8_WAIT_L(0); PG8_BAR; PG8_MMA(1, 0, At, B0); PG8_MMA(1, 1, At, B1); PG8_BAR; PG8_SCHED;
            } else {
            PG8_LDB(B0, 0, 0); PG8_SCHED; PG8_LDA(At, 0, 0); PG8_STAGE(PG8_SA(1, 1), a1 + hstep, voffA);
            PG8_WAIT_L(8); PG8_BAR; PG8_WAIT_L(0); PG8_MMA(0, 0, At, B0); PG8_BAR; PG8_SCHED;
            PG8_LDB(B1, 0, 1); PG8_STAGE(PG8_SB(0, 0), b2, voffB);
            PG8_BAR; PG8_WAIT_L(0); PG8_MMA(0, 1, At, B1); PG8_BAR;
            PG8_LDA(At, 0, 1); PG8_STAGE(PG8_SA(0, 0), a2, voffA);
            PG8_BAR; PG8_WAIT_L(0); PG8_MMA(1, 0, At, B0); PG8_BAR; PG8_SCHED;
            PG8_STAGE(PG8_SB(0, 1), b2 + hstep, voffB);
            PG8_WAIT_V(6); PG8_BAR; PG8_MMA(1, 1, At, B1); PG8_BAR;
            PG8_LDB(B0, 1, 0); PG8_SCHED; PG8_LDA(At, 1, 0); PG8_STAGE(PG8_SA(0, 1), a2 + hstep, voffA);
            PG8_WAIT_L(8); PG8_BAR; PG8_WAIT_L(0); PG8_MMA(0, 0, At, B0); PG8_BAR; PG8_SCHED;
            PG8_LDB(B1, 1, 1); PG8_STAGE(PG8_SB(1, 0), b3, voffB);
            PG8_BAR; PG8_WAIT_L(0); PG8_MMA(0, 1, At, B1); PG8_BAR;
            PG8_LDA(At, 1, 1); PG8_STAGE(PG8_SA(1, 0), a3, voffA);
            PG8_BAR; PG8_WAIT_L(0); PG8_MMA(1, 0, At, B0); PG8_BAR; PG8_SCHED;
            PG8_STAGE(PG8_SB(1, 1), b3 + hstep, voffB);
            PG8_WAIT_V(6); PG8_BAR; PG8_MMA(1, 1, At, B1); PG8_BAR;
            }
        }
        if constexpr (Epi::PREFETCH) asm volatile("" :: "v"(pfv[0]), "v"(pfv[1]), "v"(pfv[2]), "v"(pfv[3]));
        if constexpr (ALIGN_EPI) { if (wr == 0) PG8_BAR; }
        if constexpr (!Epi::AFTER_DRAIN) { if constexpr (Epi::MUT) E.fin(acc, cur, wr, wc, fr, fq); else E(acc, cur, wr, wc, fr, fq); S.done(cur); }
        if (!has_next) break;
#pragma unroll
        for (int a = 0; a < 2; ++a)
#pragma unroll
            for (int b = 0; b < 2; ++b)
#pragma unroll
                for (int m = 0; m < 4; ++m)
#pragma unroll
                    for (int n = 0; n < 2; ++n) acc[a][b][m][n] = (f32x4){0.f, 0.f, 0.f, 0.f};
        cur = nxt; cA = nA; cB = nB; ++ui;
        if constexpr (ALIGN_EPI) { if (wr == 1) PG8_BAR; }
    }
    PG8_WAIT_V(0);
    if constexpr (!ALIGN_EPI) { if (wr == 0) PG8_BAR; }
    PG8_BAR;
    if constexpr (Epi::AFTER_DRAIN) { E.fused(acc, cur, wr, wc, fr, fq, lds, wid, lane); S.done(cur); }
#undef PG8_SA
#undef PG8_SB
#undef PG8_STAGE
#undef PG8_LDA
#undef PG8_LDB
#undef PG8_MMA
#undef PG8_WAIT_V
#undef PG8_WAIT_L
#undef PG8_BAR
#undef PG8_SCHED
}
}

#define XB_TMO      128
#define XB_XCNT(j)  (256  + 64 * (j))
#define XB_XSUB(j)  (1280 + 64 * (j))
#define XB_XGEN(j)  (2304 + 64 * (j))
#define XB_TOP      3328
#define XB_TOPGEN   3392
#define XCD_BAR_WORDS 3456
#define XB_SPIN_CAP (1u << 18)

__device__ __forceinline__ unsigned xb_ld(unsigned* p)              { return __hip_atomic_load(p, __ATOMIC_RELAXED, __HIP_MEMORY_SCOPE_AGENT); }
__device__ __forceinline__ unsigned xb_add(unsigned* p, unsigned v) { return __hip_atomic_fetch_add(p, v, __ATOMIC_RELAXED, __HIP_MEMORY_SCOPE_AGENT); }
__device__ __forceinline__ unsigned xb_xcc_id() { return (unsigned)__builtin_amdgcn_s_getreg((3 << 11) | 20) & 0xFu; }
#define XB_SPIN(cond, bar) do { unsigned _sp = 0; while (cond) { __builtin_amdgcn_s_sleep(1); \
    if ((++_sp & 255u) == 0u) { if (xb_ld(&(bar)[XB_TMO])) break; if (_sp > XB_SPIN_CAP) { atomicAdd(&(bar)[XB_TMO], 1u); break; } } } } while (0)

struct XcdBarrier {
    unsigned* bar; unsigned x;
    volatile LAS unsigned* st;
};

__device__ __forceinline__ XcdBarrier xcd_barrier_post(unsigned* bar, volatile LAS unsigned* st) {
    XcdBarrier b; b.bar = bar; b.x = xb_xcc_id(); b.st = st;
    if (threadIdx.x == 0) (void)xb_add(&bar[XB_XCNT(b.x)], 1u);
    return b;
}
__device__ __forceinline__ void xcd_barrier_complete(unsigned* bar, unsigned x, unsigned& nloc, unsigned& nx) {
    const unsigned G = gridDim.x * gridDim.y * gridDim.z;
    unsigned sum, cnt, mine, sp = 0u;
    for (;;) {
        sum = 0u; cnt = 0u; mine = 0u;
#pragma unroll
        for (unsigned j = 0; j < 16; ++j) { const unsigned c = xb_ld(&bar[XB_XCNT(j)]); sum += c; cnt += (c > 0u) ? 1u : 0u; mine = (j == x) ? c : mine; }
        if (sum == G) break;
        __builtin_amdgcn_s_sleep(1);
        if ((++sp & 255u) == 0u) { if (xb_ld(&bar[XB_TMO])) break; if (sp > XB_SPIN_CAP) { atomicAdd(&bar[XB_TMO], 1u); break; } }
    }
    nloc = mine > 0u ? mine : 1u; nx = cnt > 0u ? cnt : 1u;
}

__device__ __forceinline__ void xcd_barrier(const XcdBarrier& b) {
    asm volatile("s_waitcnt vmcnt(0)" ::: "memory");
    __syncthreads();
    if (threadIdx.x == 0) {
        unsigned* bar = b.bar;
        __builtin_amdgcn_s_waitcnt(0);
        unsigned nloc = b.st[0], nx = b.st[1];
        if (nloc == 0u) { xcd_barrier_complete(bar, b.x, nloc, nx); b.st[0] = nloc; b.st[1] = nx; }
        const unsigned old = xb_add(&bar[XB_XSUB(b.x)], 1u);
        const unsigned gen = old / nloc;
        if (old + 1u == (gen + 1u) * nloc) {
            __builtin_amdgcn_fence(__ATOMIC_RELEASE, "agent");
            asm volatile("s_waitcnt vmcnt(0)" ::: "memory");
            const unsigned og = xb_add(&bar[XB_TOP], 1u);
            const unsigned tg = og / nx;
            if (og + 1u == (tg + 1u) * nx) xb_add(&bar[XB_TOPGEN], 1u);
            else XB_SPIN(xb_ld(&bar[XB_TOPGEN]) == tg, bar);
            __builtin_amdgcn_fence(__ATOMIC_ACQUIRE, "agent");
            xb_add(&bar[XB_XGEN(b.x)], 1u);
            asm volatile("s_waitcnt vmcnt(0)" ::: "memory");
        } else {
            XB_SPIN(xb_ld(&bar[XB_XGEN(b.x)]) == gen, bar);
            __builtin_amdgcn_fence(__ATOMIC_ACQUIRE, "agent");
            asm volatile("s_waitcnt vmcnt(0)" ::: "memory");
        }
    }
    __syncthreads();
}


struct Args { const float* in[23]; float* out; unsigned char* ws; int ph_lo, ph_hi; };
enum { I_X = 0, I_C, I_WADA, I_BADA, I_N1, I_W1IN, I_W1OUT, I_NMIX, I_WIN, I_CONVW, I_CONVB, I_WRG, I_BRG, I_WIG, I_BIG, I_LAM, I_WBA, I_WBL, I_WOUT, I_N2, I_W2IN, I_W2OUT, I_NF };

DI void conv_tile(LAS float* buf, const float* src, int lds_, bf16_t* dst, int ldd) {
    const int tid = threadIdx.x;
    float4 v[8];
#pragma unroll
    for (int i = 0; i < 8; ++i) { const int k = (tid >> 4) + 32 * i, cgp = tid & 15; v[i] = *(const float4*)(src + (size_t)k * lds_ + cgp * 4); }
#pragma unroll
    for (int i = 0; i < 8; ++i) { const int k = (tid >> 4) + 32 * i, cgp = tid & 15; LAS float* p = buf + k * 65 + cgp * 4; p[0] = v[i].x; p[1] = v[i].y; p[2] = v[i].z; p[3] = v[i].w; }
    __syncthreads();
#pragma unroll
    for (int i = 0; i < 4; ++i) { const int q = tid + 512 * i, g = q >> 6, kg = (g & 3) * 8 + (q & 7), n = (g >> 2) * 8 + ((q >> 3) & 7); float f[8];
#pragma unroll
        for (int j = 0; j < 8; ++j) f[j] = buf[(kg * 8 + j) * 65 + n];
        u32x4 o; o.x = pk_bf16(f[0], f[1]); o.y = pk_bf16(f[2], f[3]); o.z = pk_bf16(f[4], f[5]); o.w = pk_bf16(f[6], f[7]);
        *(u32x4*)(dst + (size_t)n * ldd + kg * 8) = o; }
    __syncthreads();
}
DI void conv_tile64(LAS float* buf, const float* src, int lds_, bf16_t* dst, int ldd) {
    const int tid = threadIdx.x;
#pragma unroll
    for (int i = 0; i < 2; ++i) { const int k = (tid >> 4) + 32 * i, cgp = tid & 15; const float4 v = *(const float4*)(src + (size_t)k * lds_ + cgp * 4);
        LAS float* p = buf + k * 65 + cgp * 4; p[0] = v.x; p[1] = v.y; p[2] = v.z; p[3] = v.w; }
    __syncthreads();
    { const int kg = tid & 7, n = tid >> 3; float f[8];
#pragma unroll
        for (int j = 0; j < 8; ++j) f[j] = buf[(kg * 8 + j) * 65 + n];
        u32x4 o; o.x = pk_bf16(f[0], f[1]); o.y = pk_bf16(f[2], f[3]); o.z = pk_bf16(f[4], f[5]); o.w = pk_bf16(f[6], f[7]);
        *(u32x4*)(dst + (size_t)n * ldd + kg * 8) = o; }
    __syncthreads();
}
DI void conv_job(LAS float* buf, int& rot, const float* src, int ldsrc, int K, int Nd, bf16_t* dst, int lddst, int koff, int map) {
    const int G = gridDim.x, KT = (map == 4) ? 64 : 256, tn_n = Nd >> 6, ntile = tn_n * (K / KT);
    for (int t = (int)((blockIdx.x + rot) % G); t < ntile; t += G) {
        const int tn = t % tn_n, tk = t / tn_n, n0 = tn * 64, k0 = tk * KT;
        if (map == 4) { conv_tile64(buf, src + (size_t)(n0 >> 7) * 16384 + (size_t)k0 * 128 + (n0 & 127), ldsrc, dst + (size_t)n0 * lddst + koff + k0, lddst); continue; }
        int c0 = n0;
        if (map == 1) { const int pn = n0 >> 8, rr = n0 & 255; c0 = rr < 128 ? 128 * pn + rr : DFF + 128 * pn + rr - 128; }
        else if (map == 2) c0 = n0 < 2048 ? n0 : n0 + 1024;
        else if (map == 3) c0 = 2048 + n0;
        conv_tile(buf, src + (size_t)k0 * ldsrc + c0, ldsrc, dst + (size_t)n0 * lddst + koff + k0, lddst);
    }
    rot = (rot + G - ntile % G) % G;
}
DI void mod_items(LAS float* lf, const float* c, const float* w_ada, const float* b_ada, float* mod) {
    const int tid = threadIdx.x;
    if (blockIdx.x >= 256) return;
    for (int i = tid; i < 8192; i += 512) { const float v = c[i]; lf[i] = v * sigmoidf_(v); }
    __syncthreads();
    LAS float* part = lf + 8192;
    for (int it = blockIdx.x; it < 256; it += gridDim.x) {
        const int col0 = it * 72, cgp = tid % 18, ks = tid / 18;
        if (ks < 28) {
            const int k0 = (ks * 2048) / 28, k1 = ((ks + 1) * 2048) / 28;
            float acc[4][4];
#pragma unroll
            for (int b = 0; b < 4; ++b)
#pragma unroll
                for (int j = 0; j < 4; ++j) acc[b][j] = 0.f;
            const float* wp = w_ada + (size_t)k0 * NMOD + col0 + cgp * 4;
#pragma unroll 8
            for (int k = k0; k < k1; ++k) { const float4 w = *(const float4*)wp; wp += NMOD;
#pragma unroll
                for (int b = 0; b < 4; ++b) { const float cv = lf[b * 2048 + k]; acc[b][0] += cv * w.x; acc[b][1] += cv * w.y; acc[b][2] += cv * w.z; acc[b][3] += cv * w.w; } }
#pragma unroll
            for (int b = 0; b < 4; ++b)
#pragma unroll
                for (int j = 0; j < 4; ++j) part[(ks * 18 + cgp) * 16 + b * 4 + j] = acc[b][j];
        }
        __syncthreads();
        if (tid < 288) { const int b = tid / 72, cc = tid % 72; float s = 0.f;
            for (int k2 = 0; k2 < 28; ++k2) s += part[(k2 * 18 + (cc >> 2)) * 16 + b * 4 + (cc & 3)];
            mod[b * NMOD + col0 + cc] = s + b_ada[col0 + cc]; }
        __syncthreads();
    }
}

DI void shw_rows(LAS float* lsh, const bf16_t* Bt, int nrows, const float* mod, int ish, float* shw, int ld, int col_off) {
    const int tid = threadIdx.x, lane = tid & 63, wave = tid >> 6;
    __syncthreads();
    for (int i = tid; i < 4 * D; i += 512) lsh[i] = mod[(size_t)(i >> 11) * NMOD + ish * D + (i & (D - 1))];
    __syncthreads();
    for (int r = blockIdx.x * 8 + wave; r < nrows; r += gridDim.x * 8) {
        const bf16_t* wp = Bt + (size_t)r * D; u32x4 wv[4];
#pragma unroll
        for (int i = 0; i < 4; ++i) wv[i] = *(const u32x4*)(wp + (i * 64 + lane) * 8);
        float a0 = 0.f, a1 = 0.f, a2 = 0.f, a3 = 0.f;
#pragma unroll
        for (int i = 0; i < 4; ++i)
#pragma unroll
            for (int q = 0; q < 4; ++q) { const int k = (i * 64 + lane) * 8 + q * 2; const float w0 = bf_lo(wv[i][q]), w1 = bf_hi(wv[i][q]);
                a0 += lsh[k] * w0 + lsh[k + 1] * w1; a1 += lsh[D + k] * w0 + lsh[D + k + 1] * w1; a2 += lsh[2 * D + k] * w0 + lsh[2 * D + k + 1] * w1; a3 += lsh[3 * D + k] * w0 + lsh[3 * D + k + 1] * w1; }
#pragma unroll
        for (int off = 32; off >= 1; off >>= 1) { a0 += __shfl_xor(a0, off); a1 += __shfl_xor(a1, off); a2 += __shfl_xor(a2, off); a3 += __shfl_xor(a3, off); }
        if (lane == 0) { shw[col_off + r] = a0; shw[ld + col_off + r] = a1; shw[2 * ld + col_off + r] = a2; shw[3 * ld + col_off + r] = a3; }
    }
    __syncthreads();
}

template <bool FINAL>
DI void norm_phase(const float* src, const float* gain, const float* mod, int ish, bf16_t* dst, float* dstf) {
    const int lane = threadIdx.x & 63, wave = threadIdx.x >> 6;
    for (int r = blockIdx.x * 8 + wave; r < T; r += gridDim.x * 8) {
        const float* xp = src + (size_t)r * D; f32x4 v[8]; float ss = 0.f;
#pragma unroll
        for (int i = 0; i < 8; ++i) { v[i] = *(const f32x4*)(xp + (i * 64 + lane) * 4); ss += v[i][0] * v[i][0] + v[i][1] * v[i][1] + v[i][2] * v[i][2] + v[i][3] * v[i][3]; }
#pragma unroll
        for (int off = 32; off >= 1; off >>= 1) ss += __shfl_xor(ss, off);
        const float rstd = rsqrtf(ss * (1.0f / D) + EPS);
        const float* sh = mod + (size_t)(r >> 12) * NMOD + ish * D; const float* sc = sh + D;
#pragma unroll
        for (int i = 0; i < 8; ++i) { const int col = (i * 64 + lane) * 4; const f32x4 g = *(const f32x4*)(gain + col);
            f32x4 y = v[i] * rstd * g;
            if (FINAL) *(f32x4*)(dstf + (size_t)r * D + col) = y;
            else { const f32x4 s4 = *(const f32x4*)(sh + col), c4 = *(const f32x4*)(sc + col); y = y * (1.0f + c4) + s4;
                u32x2 w; w.x = pk_bf16(y[0], y[1]); w.y = pk_bf16(y[2], y[3]); *(u32x2*)(dst + (size_t)r * D + col) = w; } }
    }
}

constexpr int AT_KROW = 272, AT_VROW = 144, AT_KB = 64 * AT_KROW, AT_BUF = AT_KB + 128 * AT_VROW;
DI f32x16 attn_qk(const LAS unsigned char* kp, const bf16x8 (&qf)[8]) {
    f32x16 s;
#pragma unroll
    for (int i = 0; i < 16; ++i) s[i] = 0.f;
#pragma unroll
    for (int ks = 0; ks < 8; ++ks) { const bf16x8 a = *(const LAS bf16x8*)(kp + ks * 32); s = __builtin_amdgcn_mfma_f32_32x32x16_bf16(a, qf[ks], s, 0, 0, 0); }
    __builtin_amdgcn_sched_group_barrier(0x100, 4, 0);
#pragma unroll
    for (int i = 0; i < 4; ++i) { __builtin_amdgcn_sched_group_barrier(0x8, 1, 0); __builtin_amdgcn_sched_group_barrier(0x100, 1, 0); }
    __builtin_amdgcn_sched_group_barrier(0x8, 4, 0);
    return s;
}
DI void attn_ew(const f32x16& s, float& C, int half, int ks0, int tq, bool MASKED, bf16x8& pf0, bf16x8& pf1) {
    float kp_[16];
#pragma unroll
    for (int i = 0; i < 16; ++i) kp_[i] = fast_rcp(1.0f + fast_exp2(s[i]));
    if (MASKED) {
        asm volatile("" ::: "memory");
#pragma unroll
        for (int i = 0; i < 16; ++i) { const int key = ks0 + 16 * (i >> 3) + 8 * half + (i & 7); kp_[i] = key < tq ? kp_[i] : 1.0f; } }
    float d[16]; float PA = 1.0f, PB = 1.0f;
#pragma unroll
    for (int i = 15; i >= 8; --i) { const float nx = PB * kp_[i]; d[i] = PB - nx; PB = nx; }
#pragma unroll
    for (int i = 7; i >= 0; --i) { const float nx = PA * kp_[i]; d[i] = PA - nx; PA = nx; }
    const float PAo = __shfl_xor(PA, 32), PBo = __shfl_xor(PB, 32);
    const float t1 = C * PBo, t3 = C * (PB * PBo), t4 = t3 * PAo;
    const float stB = half ? C : t1;
    const float stA = half ? t3 : t4;
    C = C * ((PA * PAo) * (PB * PBo));
    float w[16];
#pragma unroll
    for (int i = 0; i < 8; ++i) { asm("v_mul_f32 %0, %1, %2" : "=v"(w[i]) : "v"(d[i]), "v"(stA)); asm("v_mul_f32 %0, %1, %2" : "=v"(w[8 + i]) : "v"(d[8 + i]), "v"(stB)); }
    u32x4 p0, p1;
    p0.x = pk_bf16(w[0], w[1]); p0.y = pk_bf16(w[2], w[3]); p0.z = pk_bf16(w[4], w[5]); p0.w = pk_bf16(w[6], w[7]);
    p1.x = pk_bf16(w[8], w[9]); p1.y = pk_bf16(w[10], w[11]); p1.z = pk_bf16(w[12], w[13]); p1.w = pk_bf16(w[14], w[15]);
    pf0 = __builtin_bit_cast(bf16x8, p0); pf1 = __builtin_bit_cast(bf16x8, p1);
}
DI void attn_pv(const LAS unsigned char* vp0, const bf16x8& pf0, const bf16x8& pf1, f32x16 (&o)[4]) {
#pragma unroll
    for (int d = 0; d < 4; ++d) { const LAS unsigned char* vp = vp0 + d * 32 * AT_VROW;
        const bf16x8 v0 = *(const LAS bf16x8*)(vp), v1 = *(const LAS bf16x8*)(vp + 32);
        o[d] = __builtin_amdgcn_mfma_f32_32x32x16_bf16(v0, pf0, o[d], 0, 0, 0);
        o[d] = __builtin_amdgcn_mfma_f32_32x32x16_bf16(v1, pf1, o[d], 0, 0, 0); }
}
DI void attn_item(LAS unsigned char* lds, const bf16_t* P, const bf16_t* VT, bf16_t* YM, int b, int h, int qb) {
    const int tid = threadIdx.x, lane = tid & 63, wave = __builtin_amdgcn_readfirstlane(tid >> 6), l32 = lane & 31, half = lane >> 5;
    const int t0 = qb * 256 + wave * 32, tq = t0 + l32;
    const size_t tokbase = (size_t)b * SEQ;
    bf16x8 qf[8];
    { const bf16_t* qp = P + (tokbase + tq) * PW + h * 128 + 8 * half;
#pragma unroll
      for (int ks = 0; ks < 8; ++ks) qf[ks] = *(const bf16x8*)(qp + 16 * ks); }
    f32x16 o[4];
#pragma unroll
    for (int d = 0; d < 4; ++d)
#pragma unroll
        for (int i = 0; i < 16; ++i) o[d][i] = 0.f;
    float C = 1.0f;
    const int ktmax = qb * 4 + 3;
    const bf16_t* Kg = P + tokbase * PW + 1024 + h * 128;
    const bf16_t* Vg = VT + (size_t)(h * 128) * T + tokbase;
    unsigned ko[2], vo[2]; int kl[2], vl[2];
#pragma unroll
    for (int i = 0; i < 2; ++i) { const int p = tid + 512 * i; const int key = p >> 4, part = p & 15; ko[i] = (unsigned)(key * PW + part * 8); kl[i] = key * AT_KROW + part * 16;
        const int d = p >> 3, pv = p & 7; vo[i] = (unsigned)(d * T + pv * 8); vl[i] = AT_KB + d * AT_VROW + pv * 16; }
    u32x4 rk[2], rv[2];
    { const bf16_t* kb = Kg + (size_t)ktmax * 64 * PW; const bf16_t* vb = Vg + ktmax * 64;
#pragma unroll
      for (int i = 0; i < 2; ++i) { rk[i] = *(const u32x4*)(kb + ko[i]); rv[i] = *(const u32x4*)(vb + vo[i]); } }
#pragma unroll
    for (int i = 0; i < 2; ++i) { *(LAS u32x4*)(lds + kl[i]) = rk[i]; *(LAS u32x4*)(lds + vl[i]) = rv[i]; }
#pragma unroll
    for (int ks = 0; ks < 8; ++ks) asm volatile("" : "+v"(qf[ks]));
    __syncthreads();
    const int pir = (l32 & 0x13) | ((l32 & 8) >> 1) | ((l32 & 4) << 1);
    const int koff = pir * AT_KROW + half * 16, voff = l32 * AT_VROW + half * 16;
    int cur = 0;
    for (int kt = ktmax; kt >= 0; --kt) {
        if (kt > 0) { const bf16_t* kb = Kg + (size_t)(kt - 1) * 64 * PW; const bf16_t* vb = Vg + (kt - 1) * 64;
#pragma unroll
            for (int i = 0; i < 2; ++i) { rk[i] = *(const u32x4*)(kb + ko[i]); rv[i] = *(const u32x4*)(vb + vo[i]); } }
        const LAS unsigned char* Kb = lds + cur * AT_BUF + koff; const LAS unsigned char* Vb = lds + cur * AT_BUF + AT_KB + voff;
        if (kt * 64 < t0 + 31) {
            const bool need_mask = (kt * 64 + 63 >= t0);
            bf16x8 pa0, pa1, pb0, pb1;
            const f32x16 s1 = attn_qk(Kb + 32 * AT_KROW, qf);
            const f32x16 s0 = attn_qk(Kb, qf);
            attn_ew(s1, C, half, kt * 64 + 32, tq, need_mask, pa0, pa1);
            attn_pv(Vb + 64, pa0, pa1, o);
            attn_ew(s0, C, half, kt * 64, tq, need_mask, pb0, pb1);
            attn_pv(Vb, pb0, pb1, o);
        }
        if (kt > 0) { LAS unsigned char* nb = lds + (cur ^ 1) * AT_BUF;
#pragma unroll
            for (int i = 0; i < 2; ++i) { *(LAS u32x4*)(nb + kl[i]) = rk[i]; *(LAS u32x4*)(nb + vl[i]) = rv[i]; } }
        __syncthreads();
        cur ^= 1;
    }
    bf16_t* yp = YM + (tokbase + tq) * D + h * 128 + 4 * half;
#pragma unroll
    for (int d = 0; d < 4; ++d)
#pragma unroll
        for (int q4 = 0; q4 < 4; ++q4) { u32x2 w; w.x = pk_bf16(o[d][q4 * 4], o[d][q4 * 4 + 1]); w.y = pk_bf16(o[d][q4 * 4 + 2], o[d][q4 * 4 + 3]); *(u32x2*)(yp + d * 32 + q4 * 8) = w; }
}

struct LruP { const bf16_t* P; const bf16_t* WG; const float* conv_w; const float* conv_b; const float* b_r; const float* b_i; const float* lam; float* lsum; bf16_t* YM; bf16_t* YA; };
DI void lru_phase(LAS unsigned char* lds, const LruP& q, int bx, int G, bool seq) {
    const int tid = threadIdx.x, lane = tid & 63, wave = __builtin_amdgcn_readfirstlane(tid >> 6);
    LAS float* xcf = (LAS float*)lds;
    LAS float* la = xcf + 64 * 129;
    LAS float* lu = la + 64 * 129;
    LAS float* sg = lu + 64 * 129;
    LAS unsigned char* xcb = (LAS unsigned char*)(sg + 2048);
    const int c = tid & 127, sgi = tid >> 7;
    const int fr = lane & 15, fq = lane >> 4;
    int n_loaded = -1;
    bf16x8 wbr[4], wbi[4]; float w0 = 0.f, w1 = 0.f, w2 = 0.f, w3 = 0.f, cb = 0.f, brv = 0.f, biv = 0.f, L = 0.f;
#pragma unroll
    for (int ks = 0; ks < 4; ++ks) { wbr[ks] = (bf16x8){0, 0, 0, 0, 0, 0, 0, 0}; wbi[ks] = wbr[ks]; }
    bf16_t xr[19];
    auto load_xr = [&](int it) { const int ck = it >> 3, n = it & 7, lc = ck & 63; const bf16_t* xp = q.P + ((size_t)ck * 64 + sgi * 16) * PW + 2048 + n * 128 + c;
        const bool has_prev = (lc * 64 + sgi * 16) > 0;
#pragma unroll
        for (int t = 0; t < 3; ++t) xr[t] = has_prev ? xp[(t - 3) * PW] : (bf16_t)0;
#pragma unroll
        for (int t = 0; t < 16; ++t) xr[3 + t] = xp[(size_t)t * PW]; };
    const int nit = seq ? 8 : (2048 - bx + G - 1) / G;
    const int it0 = seq ? ((((bx >> 6) * 64 + ((bx >> 3) & 7) * 8) << 3) | (bx & 7)) : bx, its = seq ? 8 : G;
    if (nit > 0) load_xr(it0);
    for (int k = 0; k < nit; ++k) { const int it = it0 + k * its;
        const int ck = it >> 3, n = it & 7; const size_t tok0 = (size_t)ck * 64; const int ch = n * 128 + c;
        if (n != n_loaded) {
            const bf16_t* wrp = q.WG + (size_t)(n * 128 + wave * 16 + fr) * 128 + fq * 8; const bf16_t* wip = wrp + 8 * 128 * 128;
#pragma unroll
            for (int ks = 0; ks < 4; ++ks) { wbr[ks] = *(const bf16x8*)(wrp + ks * 32); wbi[ks] = *(const bf16x8*)(wip + ks * 32); }
            w0 = q.conv_w[ch]; w1 = q.conv_w[1024 + ch]; w2 = q.conv_w[2048 + ch]; w3 = q.conv_w[3072 + ch]; cb = q.conv_b[ch];
            const int ch2 = n * 128 + wave * 16 + fr; brv = q.b_r[ch2]; biv = q.b_i[ch2]; L = -8.0f * log1pf(expf(-q.lam[ch2]));
            n_loaded = n; }
        bf16_t grv[16];
        { const bf16_t* gp = q.P + (tok0 + sgi * 16) * PW + 3072 + ch;
#pragma unroll
          for (int t = 0; t < 16; ++t) grv[t] = gp[(size_t)t * PW]; }
#pragma unroll
        for (int t = 0; t < 16; ++t) { const float y = w0 * bf_f(xr[t]) + w1 * bf_f(xr[t + 1]) + w2 * bf_f(xr[t + 2]) + w3 * bf_f(xr[t + 3]) + cb;
            xcf[(sgi * 16 + t) * 129 + c] = y; *(LAS bf16_t*)(xcb + (sgi * 16 + t) * 272 + c * 2) = to_bf16(y); }
        if (k + 1 < nit) load_xr(it + its);
        __syncthreads();
        const int c2 = wave * 16 + fr;
        f32x4 ar[4], ai[4];
#pragma unroll
        for (int m = 0; m < 4; ++m) { ar[m] = (f32x4){0.f, 0.f, 0.f, 0.f}; ai[m] = (f32x4){0.f, 0.f, 0.f, 0.f}; }
#pragma unroll
        for (int ks = 0; ks < 4; ++ks)
#pragma unroll
            for (int m = 0; m < 4; ++m) { const bf16x8 av = *(const LAS bf16x8*)(xcb + (m * 16 + fr) * 272 + (ks * 32 + fq * 8) * 2);
                ar[m] = __builtin_amdgcn_mfma_f32_16x16x32_bf16(av, wbr[ks], ar[m], 0, 0, 0); ai[m] = __builtin_amdgcn_mfma_f32_16x16x32_bf16(av, wbi[ks], ai[m], 0, 0, 0); }
#pragma unroll
        for (int m = 0; m < 4; ++m)
#pragma unroll
            for (int j = 0; j < 4; ++j) { const int t = m * 16 + fq * 4 + j; const float r = sigmoidf_(ar[m][j] + brv), ig = sigmoidf_(ai[m][j] + biv);
                const float lga = r * L; const float av = fast_exp2(lga * LOG2E); const float x = 2.0f * lga;
                const float om = -x * (1.0f + x * 0.5f * (1.0f + x * (1.0f / 3.0f) * (1.0f + x * 0.25f * (1.0f + x * 0.2f * (1.0f + x * (1.0f / 6.0f))))));
                la[t * 129 + c2] = av; lu[t * 129 + c2] = sqrtf(om) * ig * xcf[t * 129 + c2]; }
        __syncthreads();
        float av_[16], uv_[16];
#pragma unroll
        for (int t = 0; t < 16; ++t) { av_[t] = la[(sgi * 16 + t) * 129 + c]; uv_[t] = lu[(sgi * 16 + t) * 129 + c]; }
        { float A = 1.0f, H = 0.f;
#pragma unroll
          for (int t = 0; t < 16; ++t) { H = av_[t] * H + uv_[t]; A *= av_[t]; }
          sg[sgi * 128 + c] = A; sg[512 + sgi * 128 + c] = H; }
        __syncthreads();
        float Ar = 1.0f, Hr = 0.f;
#pragma unroll
        for (int s2 = 0; s2 < 3; ++s2) { if (s2 < sgi) { const float as = sg[s2 * 128 + c], hs = sg[512 + s2 * 128 + c]; Hr = as * Hr + hs; Ar *= as; } }
        bf16_t* yl = q.YM + (tok0 + sgi * 16) * D + 1024 + ch;
        bf16_t* ya = q.YA + (tok0 + sgi * 16) * 1024 + ch;
#pragma unroll
        for (int t = 0; t < 16; ++t) { Hr = av_[t] * Hr + uv_[t]; Ar *= av_[t];
            const float g = bf_f(grv[t]); const float ge = g * sigmoidf_(1.5957691216057308f * (g + 0.044715f * g * g * g));
            yl[(size_t)t * D] = to_bf16(Hr * ge); ya[(size_t)t * 1024] = to_bf16(Ar * ge); }
        if (sgi == 3) __hip_atomic_store((unsigned long long*)(q.lsum + ((size_t)ck * 1024 + ch) * 2), ((unsigned long long)__float_as_uint(Hr) << 32) | __float_as_uint(Ar), __ATOMIC_RELAXED, __HIP_MEMORY_SCOPE_AGENT);
        __syncthreads();
    }
}
DI void lru_fix(LAS unsigned char* lds, const LruP& q, int ck, int n) {
    const int tid = threadIdx.x; const int bq = ck >> 6, lc = ck & 63; const size_t tok0 = (size_t)ck * 64;
    LAS float* sg = (LAS float*)lds;
    const int c = tid & 127, sgi = tid >> 7, ch = n * 128 + c;
    if (lc == 0) return;
    bf16_t* yl = q.YM + (tok0 + sgi * 16) * D + 1024 + ch;
    const bf16_t* ya = q.YA + (tok0 + sgi * 16) * 1024 + ch;
    bf16_t l[16], a[16];
#pragma unroll
    for (int t = 0; t < 16; ++t) { l[t] = yl[(size_t)t * D]; a[t] = ya[(size_t)t * 1024]; }
    const float* sp = q.lsum + ((size_t)(bq * 64 + sgi * 16) * 1024 + ch) * 2;
    f32x2v sv[16];
#pragma unroll
    for (int j = 0; j < 16; ++j) { const unsigned long long w = __hip_atomic_load((const unsigned long long*)(sp + (size_t)j * 2048), __ATOMIC_RELAXED, __HIP_MEMORY_SCOPE_AGENT); sv[j] = (f32x2v){__uint_as_float((unsigned)w), __uint_as_float((unsigned)(w >> 32))}; }
    float cA = 1.0f, cH = 0.f;
#pragma unroll
    for (int j = 0; j < 16; ++j) { const bool ok = (sgi * 16 + j) < lc; const float aj = ok ? sv[j][0] : 1.0f, hj = ok ? sv[j][1] : 0.f; cH = aj * cH + hj; cA *= aj; }
    sg[sgi * 128 + c] = cA; sg[512 + sgi * 128 + c] = cH;
    __syncthreads();
    float hc = 0.f;
#pragma unroll
    for (int s2 = 0; s2 < 4; ++s2) hc = sg[s2 * 128 + c] * hc + sg[512 + s2 * 128 + c];
#pragma unroll
    for (int t = 0; t < 16; ++t) yl[(size_t)t * D] = to_bf16(bf_f(l[t]) + bf_f(a[t]) * hc);
    __syncthreads();
}

constexpr int NPH = 14;
__global__ void __launch_bounds__(512, 2) fwd(Args a) {
    extern __shared__ __attribute__((aligned(16))) unsigned char lds_raw[];
    LAS unsigned char* lds = (LAS unsigned char*)lds_raw;
    cg::grid_group grid = cg::this_grid();
    const int lo = a.ph_lo, hi = a.ph_hi, G = gridDim.x, bx = blockIdx.x;
    unsigned char* ws = a.ws;
    float* mod = (float*)(ws + WS_MOD); float* lsum = (float*)(ws + WS_LSUM);
    bf16_t* W1IN = (bf16_t*)(ws + WS_W1IN); bf16_t* W1OUT = (bf16_t*)(ws + WS_W1OUT); bf16_t* W2IN = (bf16_t*)(ws + WS_W2IN); bf16_t* W2OUT = (bf16_t*)(ws + WS_W2OUT);
    bf16_t* WINM = (bf16_t*)(ws + WS_WINM); bf16_t* WV = (bf16_t*)(ws + WS_WV); bf16_t* WBR = (bf16_t*)(ws + WS_WBR); bf16_t* WO = (bf16_t*)(ws + WS_WO); bf16_t* WG = (bf16_t*)(ws + WS_WG);
    bf16_t* Y = (bf16_t*)(ws + WS_Y); bf16_t* P = (bf16_t*)(ws + WS_P); bf16_t* Hb = P; bf16_t* VT = (bf16_t*)(ws + WS_VT); bf16_t* YM = (bf16_t*)(ws + WS_YM); bf16_t* MG = Y;
    float* out = a.out;
    float* ss1 = (float*)(ws + WS_SS); float* ss2 = ss1 + T; float* shw_in = (float*)(ws + WS_SHW); float* shw_f2 = shw_in + 4 * 9216; float* ss3 = (float*)(ws + WS_SS3); unsigned* cnt3 = (unsigned*)(ws + WS_CNT3);
#ifndef PHASE_MASK
#define PHASE_MASK 0x3fff
#endif
#define IN(k) (((PHASE_MASK >> (k)) & 1) && lo <= (k) && (k) < hi)
#ifndef DUPMASK
#define DUPMASK 0
#endif
#ifndef DUPCNT
#define DUPCNT 1
#endif
#define REP(k) for (int rep_ = 0; rep_ < 1 + DUPCNT * ((DUPMASK >> (k)) & 1); ++rep_)
#define SEAM(k) do { if (IN(k) && IN((k) + 1)) xcd_barrier(xbar); } while (0)
    if (threadIdx.x < 4) ((LAS unsigned*)(lds + LDS_MAIN))[threadIdx.x] = 0u;
    __syncthreads();
    XcdBarrier xbar; xbar.bar = (unsigned*)(ws + WS_BAR); xbar.x = 0; xbar.st = (volatile LAS unsigned*)(lds + LDS_MAIN);
    if (hi - lo > 1) xbar = xcd_barrier_post((unsigned*)(ws + WS_BAR), (volatile LAS unsigned*)(lds + LDS_MAIN));
    if (hi > 1000) grid.sync();
    using namespace pg8;
    if (IN(0)) REP(0) {
        for (int i = bx * 512 + (int)threadIdx.x; i < 2 * T; i += G * 512) ss1[i] = 0.f;
        for (int i = bx * 512 + (int)threadIdx.x; i < T + 64 * 64 + 32 * 64; i += G * 512) ss3[i] = 0.f;
        mod_items((LAS float*)lds, a.in[I_C], a.in[I_WADA], a.in[I_BADA], mod);
        LAS float* buf = (LAS float*)lds; int rot = 0;
        conv_job(buf, rot, a.in[I_W1IN], 2 * DFF, D, 2 * DFF, W1IN, D, 0, 1);
        conv_job(buf, rot, a.in[I_W1OUT], D, DFF, D, W1OUT, DFF, 0, 0);
        conv_job(buf, rot, a.in[I_WIN], 9216, D, 8192, WINM, D, 0, 2);
        conv_job(buf, rot, a.in[I_WIN], 9216, D, 1024, WV, D, 0, 3);
        conv_job(buf, rot, a.in[I_WBA], D, 1024, D, WBR, D, 0, 0);
        conv_job(buf, rot, a.in[I_WBL], D, 1024, D, WBR, D, 1024, 0);
        conv_job(buf, rot, a.in[I_WOUT], D, D, D, WO, D, 0, 0);
        conv_job(buf, rot, a.in[I_WRG], 128, 128, 1024, WG, 128, 0, 4);
        conv_job(buf, rot, a.in[I_WIG], 128, 128, 1024, WG + 8 * 128 * 128, 128, 0, 4);
        conv_job(buf, rot, a.in[I_W2IN], 2 * DFF, D, 2 * DFF, W2IN, D, 0, 1);
        conv_job(buf, rot, a.in[I_W2OUT], D, DFF, D, W2OUT, DFF, 0, 0);
    }
    SEAM(0);
#ifdef EXTRA_SYNCS
    for (int es = 0; es < EXTRA_SYNCS; ++es) xcd_barrier(xbar);
#endif
    if (IN(1)) REP(1) { norm_phase<false>(a.in[I_X], a.in[I_N1], mod, 0, Y, nullptr);
        shw_rows((LAS float*)lds, WINM, 8192, mod, 3, shw_in, 9216, 0); shw_rows((LAS float*)lds, WV, 1024, mod, 3, shw_in, 9216, 8192); shw_rows((LAS float*)lds, W2IN, 2 * DFF, mod, 6, shw_f2, 2 * DFF, 0); }
    SEAM(1);
    if (IN(2) && ((DUPMASK >> 2) & 1)) { Gemm g{Y, W1IN, T, 2 * DFF, D}; StaticOrder S; S.init(T, 2 * DFF, G, bx, 4); EpiSwiGLU E{Hb}; gemm_phase<EpiSwiGLU, StaticOrder, true, true>(lds, g, S, E); }
#ifdef CLKPROBE
    long long cp_c0 = 0, cp_r0 = 0, cp_c1 = 0, cp_r1 = 0;
    if (bx == 0 && threadIdx.x == 0) { cp_c0 = clock64(); cp_r0 = wall_clock64(); }
#endif
    if (IN(2)) { Gemm g{Y, W1IN, T, 2 * DFF, D}; StaticOrder S; S.init(T, 2 * DFF, G, bx, 4); EpiSwiGLU E{Hb}; gemm_phase<EpiSwiGLU, StaticOrder, true, true>(lds, g, S, E); }
#ifdef CLKPROBE
    if (bx == 0 && threadIdx.x == 0) { cp_c1 = clock64(); cp_r1 = wall_clock64(); }
#endif
    SEAM(2);
    if (IN(3)) { Gemm g{Hb, W1OUT, T, D, DFF, 0}; StaticOrder S; S.init(T, D, G, bx, 4); EpiResidN E{a.in[I_X], out, mod + 2 * D, Y, a.in[I_NMIX], mod + 4 * D, ss1, 0.5f, 0}; gemm_phase<EpiResidN, StaticOrder, true, true>(lds, g, S, E); }
    SEAM(3);
    if (IN(5)) {
        { Gemm g{Y, WINM, T, 8192, D}; StaticOrder S; S.init(T, 8192, G, bx, 4); EpiPN E{P, PW, 4, QSCALE, ss1, shw_in, 9216}; gemm_phase<EpiPN, StaticOrder, true, true>(lds, g, S, E); }
        { Gemm g{WV, Y, 1024, T, D}; StaticOrder S; S.init(1024, T, G, bx); EpiVTN E{VT, ss1, shw_in + 8192}; gemm_phase<EpiVTN, StaticOrder, true, true>(lds, g, S, E); }
    }
    SEAM(5);
    LruP lq{P, WG, a.in[I_CONVW], a.in[I_CONVB], a.in[I_BRG], a.in[I_BIG], a.in[I_LAM], lsum, YM, Y};
    if (IN(6)) {
        REP(6) for (int p0 = bx; p0 < 256; p0 += G) { const int p = (G == 256) ? ((p0 & 7) * 32 + (p0 >> 3)) : p0;
            const int bh = p >> 3, jp = p & 7; attn_item(lds, P, VT, YM, bh >> 3, bh & 7, 15 - jp); attn_item(lds, P, VT, YM, bh >> 3, bh & 7, jp); }
        if (G == 256) {
            lru_phase(lds, lq, bx, G, true);
            asm volatile("s_waitcnt vmcnt(0)" ::: "memory");
            __syncthreads();
            if (threadIdx.x == 0) { unsigned* c = (unsigned*)(ws + WS_CNTL) + ((bx >> 6) * 8 + (bx & 7)) * 64;
                __hip_atomic_fetch_add(c, 1u, __ATOMIC_RELAXED, __HIP_MEMORY_SCOPE_AGENT);
                unsigned spins = 0; while (__hip_atomic_load(c, __ATOMIC_RELAXED, __HIP_MEMORY_SCOPE_AGENT) < 8u) { __builtin_amdgcn_s_sleep(2); if (++spins > (1u << 22)) break; } }
            __syncthreads();
            for (int k = 0; k < 8; ++k) lru_fix(lds, lq, (bx >> 6) * 64 + ((bx >> 3) & 7) * 8 + k, bx & 7);
        } else REP(14) lru_phase(lds, lq, bx, G, false);
    }
    SEAM(6);
    if (G != 256) { if (IN(7)) { for (int it = bx; it < 2048; it += G) lru_fix(lds, lq, it >> 3, it & 7); }
        SEAM(7); }
    if (IN(8)) { Gemm g{YM, WBR, T, D, D}; StaticOrder S; S.init(T, D, G, bx, 4); EpiBranch E{P, MG}; gemm_phase<EpiBranch, StaticOrder, true, true>(lds, g, S, E); }
    SEAM(8);
    if (IN(9)) { Gemm g{MG, WO, T, D, D}; StaticOrder S; S.init(T, D, G, bx, 4); EpiResidN E{out, out, mod + 5 * D, YM, a.in[I_N2], mod + 7 * D, ss2, 1.0f, 0}; gemm_phase<EpiResidN, StaticOrder, true, true>(lds, g, S, E); }
    SEAM(9);
    if (IN(11)) { Gemm g{YM, W2IN, T, 2 * DFF, D}; StaticOrder S; S.init(T, 2 * DFF, G, bx, 4); EpiSwiGLUN E{Hb, ss2, shw_f2}; gemm_phase<EpiSwiGLUN, StaticOrder, true, true>(lds, g, S, E); }
    SEAM(11);
    if (G == 256) {
        if (IN(12)) { Gemm g{Hb, W2OUT, T, D, DFF, 0}; StaticOrder S; S.init(T, D, G, bx, 4); EpiFinal E{out, out, mod + 8 * D, a.in[I_NF], ss3, cnt3, 0.5f, 0}; gemm_phase<EpiFinal, StaticOrder, true, true>(lds, g, S, E); }
    } else {
        if (IN(12)) { Gemm g{Hb, W2OUT, T, D, DFF, 0}; StaticOrder S; S.init(T, D, G, bx, 4); EpiResid E{out, out, mod + 8 * D, 0.5f}; gemm_phase<EpiResid, StaticOrder, true, true>(lds, g, S, E); }
        SEAM(12);
        if (IN(13)) norm_phase<true>(out, a.in[I_NF], mod, 0, nullptr, out);
    }
#ifdef CLKPROBE
    if (bx == 0 && threadIdx.x == 0) {
        const long long us = (cp_r1 - cp_r0) / 100; const long long mhz = us > 0 ? (cp_c1 - cp_c0) / us : 0;
        const long long st = wall_clock64(); while (wall_clock64() - st < mhz * 100) __builtin_amdgcn_s_sleep(8); }
#endif
}

#ifndef ONE_LAUNCH
#define ONE_LAUNCH 1
#endif
extern "C" void kernel_launch(void* const* d_in, const int* in_sizes, int n_in, void* d_out, int out_size, void* d_ws, size_t ws_size, hipStream_t stream) {
    static int grid = 0;
    if (grid == 0) {
        if (n_in != 23 || out_size != T * D || ws_size < WS_END) { fprintf(stderr, "kernel_launch: unexpected shapes (n_in %d out %d ws %zu need %zu)\n", n_in, out_size, ws_size, (size_t)WS_END); grid = -1; return; }
        int dev = 0, cus = 0, per_cu = 0;
        hipGetDevice(&dev); hipDeviceGetAttribute(&cus, hipDeviceAttributeMultiprocessorCount, dev);
        if (hipFuncSetAttribute((const void*)fwd, hipFuncAttributeMaxDynamicSharedMemorySize, LDS_BYTES) != hipSuccess) { fprintf(stderr, "kernel_launch: hipFuncSetAttribute failed\n"); grid = -1; return; }
        if (hipOccupancyMaxActiveBlocksPerMultiprocessor(&per_cu, (const void*)fwd, 512, LDS_BYTES) != hipSuccess || per_cu < 1) { fprintf(stderr, "kernel_launch: occupancy query says %d\n", per_cu); per_cu = 1; }
        (void)hipGetLastError();
        grid = cus * per_cu;
        if (grid > 256) grid = 256;
    }
    if (grid < 0) return;
    Args a{};
    for (int i = 0; i < 23; ++i) a.in[i] = (const float*)d_in[i];
    a.out = (float*)d_out; a.ws = (unsigned char*)d_ws;
#if ONE_LAUNCH
    if (hipMemsetAsync((char*)d_ws + WS_BAR, 0, 16384, stream) != hipSuccess) { fprintf(stderr, "kernel_launch: memset of the barrier words failed\n"); return; }
    a.ph_lo = 0; a.ph_hi = NPH;
    void* args[] = {&a};
    hipError_t e = hipLaunchCooperativeKernel((const void*)fwd, dim3(grid), dim3(512), args, LDS_BYTES, stream);
    if (e != hipSuccess) fprintf(stderr, "cooperative launch failed: %s (grid %d)\n", hipGetErrorString(e), grid);
#else
    for (int ph = 0; ph < NPH; ++ph) { a.ph_lo = ph; a.ph_hi = ph + 1; hipLaunchKernelGGL(fwd, dim3(grid), dim3(512), LDS_BYTES, stream, a); }
#endif
}
```

```cpp
#include <hip/hip_runtime.h>
#include <hip/hip_cooperative_groups.h>
#include <cstdio>
#include <cstdint>
namespace cg = cooperative_groups;

#define DI __device__ __forceinline__
#define LAS __attribute__((address_space(3)))

constexpr int T = 16384, D = 2048, DFF = 5632, SEQ = 4096;
constexpr int NMOD = 9 * D;
constexpr int PW = 8192;
constexpr float EPS = 1e-6f;
constexpr float LOG2E = 1.4426950408889634f;
constexpr float QSCALE = 0.08838834764831845f * 1.4426950408889634f;
constexpr int LDS_MAIN = 131072;
constexpr int LDS_BYTES = LDS_MAIN + 16;

constexpr size_t WS_BAR   = 0;
constexpr size_t WS_MOD   = 16384;
constexpr size_t WS_LSUM  = WS_MOD + (size_t)4 * NMOD * 4;
constexpr size_t WS_W1IN  = WS_LSUM + (size_t)256 * 1024 * 8;
constexpr size_t WS_W1OUT = WS_W1IN + (size_t)2 * DFF * D * 2;
constexpr size_t WS_W2IN  = WS_W1OUT + (size_t)D * DFF * 2;
constexpr size_t WS_W2OUT = WS_W2IN + (size_t)2 * DFF * D * 2;
constexpr size_t WS_WINM  = WS_W2OUT + (size_t)D * DFF * 2;
constexpr size_t WS_WV    = WS_WINM + (size_t)8192 * D * 2;
constexpr size_t WS_WBR   = WS_WV + (size_t)1024 * D * 2;
constexpr size_t WS_WO    = WS_WBR + (size_t)D * D * 2;
constexpr size_t WS_WG    = WS_WO + (size_t)D * D * 2;
constexpr size_t WS_Y     = WS_WG + (size_t)2 * 8 * 128 * 128 * 2;
constexpr size_t WS_P     = WS_Y + (size_t)T * D * 2;
constexpr size_t WS_VT    = WS_P + (size_t)T * PW * 2;
constexpr size_t WS_YM    = WS_VT + (size_t)1024 * T * 2;
constexpr size_t WS_SS    = WS_YM + (size_t)T * D * 2;
constexpr size_t WS_SHW   = WS_SS + (size_t)2 * T * 4;
constexpr size_t WS_SS3   = WS_SHW + (size_t)4 * (9216 + 11264) * 4;
constexpr size_t WS_CNT3  = WS_SS3 + (size_t)T * 4;
constexpr size_t WS_END   = WS_CNT3 + (size_t)64 * 256;

typedef unsigned short bf16_t;
typedef short bf16x8 __attribute__((ext_vector_type(8)));
typedef float f32x4 __attribute__((ext_vector_type(4)));
typedef float f32x16 __attribute__((ext_vector_type(16)));
typedef float f32x2v __attribute__((ext_vector_type(2)));
typedef __bf16 bf16x2v __attribute__((ext_vector_type(2)));
typedef unsigned u32x4 __attribute__((ext_vector_type(4)));
typedef unsigned u32x2 __attribute__((ext_vector_type(2)));

DI unsigned pk_bf16(float lo, float hi) { f32x2v f = {lo, hi}; bf16x2v b = __builtin_convertvector(f, bf16x2v); return __builtin_bit_cast(unsigned, b); }
DI bf16_t to_bf16(float x) { return (bf16_t)(pk_bf16(x, 0.f) & 0xffffu); }
DI float bf_lo(unsigned u) { return __uint_as_float(u << 16); }
DI float bf_hi(unsigned u) { return __uint_as_float(u & 0xffff0000u); }
DI float bf_f(bf16_t h) { return __uint_as_float(((unsigned)h) << 16); }
DI float fast_exp2(float x) { return __builtin_amdgcn_exp2f(x); }
DI float fast_rcp(float x) { return __builtin_amdgcn_rcpf(x); }
DI float sigmoidf_(float x) { return fast_rcp(1.0f + fast_exp2(-x * LOG2E)); }

namespace pg8 {
#define PG8_LAS __attribute__((address_space(3)))
constexpr int BM = 256, BK = 64, HALF = 128, HTB = HALF * BK * 2, STAGE_BYTES = 8 * HTB, NXCD = 8, WGM = 8;
__host__ __device__ __forceinline__ int lds_byte(int r, int c) { const int st = (r >> 4) * 2 + (c >> 5), rr = r & 15, cc = c & 31, ob = rr * 64 + cc * 2; return st * 1024 + (ob ^ (((ob >> 9) & 1) << 5)); }
__host__ __device__ __forceinline__ void stage_rc(int b, int& R, int& C) { const int st = b / 1024, sb = b % 1024, swz = sb ^ (((sb >> 9) & 1) << 5); R = (st >> 1) * 16 + swz / 64; C = (st & 1) * 32 + (swz % 64) / 2; }
__host__ __device__ __forceinline__ int perm32(int rho) { const int n = rho >> 4, i = rho & 15; return 8 * (i >> 2) + 4 * n + (i & 3); }
struct Unit { int pm, pn; };
struct Gemm { const bf16_t* A; const bf16_t* Bt; int M, N, K; int rev = 0; };
struct StaticOrder {
    int nM, nN, nwg, G, c, wgm;
    __host__ __device__ void init(int M, int N, int G_, int c_, int wgm_ = WGM) { nM = M / BM; nN = N / BM; nwg = nM * nN; G = G_; c = c_; wgm = wgm_; }
    __host__ __device__ bool next(int i, Unit& u) const {
        const long L = (long)i * G + c; if (L >= nwg) return false;
        int wgid = (int)L; { const int q = nwg / NXCD, r = nwg % NXCD, xcd = wgid % NXCD, off = wgid / NXCD; wgid = (xcd < r ? xcd * (q + 1) : r * (q + 1) + (xcd - r) * q) + off; }
        const int nig = wgm * nN, gid = wgid / nig, fm = gid * wgm, gsz = (nM - fm) < wgm ? (nM - fm) : wgm;
        u.pm = fm + ((wgid % nig) % gsz); u.pn = (wgid % nig) / gsz; return true;
    }
    __device__ __forceinline__ void a_ready(const Unit&) const {}
    __device__ __forceinline__ void done(const Unit&) const {}
};

DI f32x4 ld_bf4(const bf16_t* p) { const u32x2 w = *(const u32x2*)p; return (f32x4){bf_lo(w.x), bf_hi(w.x), bf_lo(w.y), bf_hi(w.y)}; }
DI void st_bf4(bf16_t* p, f32x4 v) { u32x2 w; w.x = pk_bf16(v[0], v[1]); w.y = pk_bf16(v[2], v[3]); *(u32x2*)p = w; }
struct EpiSwiGLU {
    static constexpr bool PERM = true, AFTER_DRAIN = false, MID = false, PREFETCH = false, MUT = false;
    bf16_t* H;
    DI void mid(f32x4 (&)[2][2][4][2], const Unit&, int, int, int, int) const {}
    DI void operator()(const f32x4 (&acc)[2][2][4][2], const Unit& u, int wr, int wc, int fr, int fq) const {
        const int row0 = u.pm * BM + wr * 64 + fr, col0 = u.pn * HALF + wc * 32 + 8 * fq;
#pragma unroll
        for (int ai = 0; ai < 2; ++ai)
#pragma unroll
            for (int m = 0; m < 4; ++m) {
                float o[8];
#pragma unroll
                for (int n = 0; n < 2; ++n)
#pragma unroll
                    for (int j = 0; j < 4; ++j) { const float g = acc[ai][0][m][n][j], up = acc[ai][1][m][n][j]; o[n * 4 + j] = g * sigmoidf_(g) * up; }
                u32x4 w; w.x = pk_bf16(o[0], o[1]); w.y = pk_bf16(o[2], o[3]); w.z = pk_bf16(o[4], o[5]); w.w = pk_bf16(o[6], o[7]);
                *(u32x4*)(H + (size_t)(row0 + ai * HALF + m * 16) * DFF + col0) = w;
            }
    }
};
struct EpiResid {
    static constexpr bool PERM = false, AFTER_DRAIN = false, MID = false, PREFETCH = false, MUT = false;
    const float* resid; float* out; const float* gmod; const bf16_t* residb; float coef; int pad_;
    DI void prefetch(unsigned (&pfv)[4], const Unit& u, int wr, int wc, int fr, int fq) const {
        int row0 = u.pm * BM + wr * 64 + fr, col0 = u.pn * BM + wc * 32;
        asm volatile("" : "+v"(row0), "+v"(col0));
#pragma unroll
        for (int j = 0; j < 4; ++j) { const int am = fq * 2 + (j & 1), bj = j >> 1;
            pfv[j] = *(const unsigned*)(resid + (size_t)(row0 + (am >> 2) * HALF + (am & 3) * 16) * D + col0 + bj * HALF); }
    }
    DI void mid(f32x4 (&)[2][2][4][2], const Unit&, int, int, int, int) const {}
    DI void operator()(const f32x4 (&acc)[2][2][4][2], const Unit& u, int wr, int wc, int fr, int fq) const {
        const int row0 = u.pm * BM + wr * 64 + fr, col0 = u.pn * BM + wc * 32 + 4 * fq;
        const float* gv = gmod + (size_t)(u.pm >> 4) * NMOD + col0;
        f32x4 g[2][2];
#pragma unroll
        for (int bj = 0; bj < 2; ++bj)
#pragma unroll
            for (int n = 0; n < 2; ++n) g[bj][n] = *(const f32x4*)(gv + bj * HALF + n * 16) * coef;
#pragma unroll
        for (int ai = 0; ai < 2; ++ai)
#pragma unroll
            for (int m = 0; m < 4; ++m) { const size_t off = (size_t)(row0 + ai * HALF + m * 16) * D + col0;
#pragma unroll
                for (int bj = 0; bj < 2; ++bj)
#pragma unroll
                    for (int n = 0; n < 2; ++n) { const f32x4 r = residb ? ld_bf4(residb + off + bj * HALF + n * 16) : *(const f32x4*)(resid + off + bj * HALF + n * 16); *(f32x4*)(out + off + bj * HALF + n * 16) = r + g[bj][n] * acc[ai][bj][m][n]; }
                asm volatile("" ::: "memory"); }
    }
};
struct EpiResidN {
    static constexpr bool PERM = false, AFTER_DRAIN = false, MID = false, PREFETCH = false, MUT = false;
    const float* resid; const bf16_t* residb; bf16_t* hb; const float* gmod; bf16_t* An; const float* gain; const float* scmod; float* ss; float coef; int pad_;
    DI void mid(f32x4 (&)[2][2][4][2], const Unit&, int, int, int, int) const {}
    DI void operator()(const f32x4 (&acc)[2][2][4][2], const Unit& u, int wr, int wc, int fr, int fq) const {
        const int row0 = u.pm * BM + wr * 64 + fr, col0 = u.pn * BM + wc * 32 + 4 * fq;
        const float* gv = gmod + (size_t)(u.pm >> 4) * NMOD + col0; const float* sv = scmod + (size_t)(u.pm >> 4) * NMOD + col0;
        f32x4 g[2][2], gm[2][2];
#pragma unroll
        for (int bj = 0; bj < 2; ++bj)
#pragma unroll
            for (int n = 0; n < 2; ++n) { g[bj][n] = *(const f32x4*)(gv + bj * HALF + n * 16) * coef; gm[bj][n] = *(const f32x4*)(gain + col0 + bj * HALF + n * 16) * (*(const f32x4*)(sv + bj * HALF + n * 16) + 1.0f); }
#pragma unroll
        for (int ai = 0; ai < 2; ++ai)
#pragma unroll
            for (int m = 0; m < 4; ++m) { const int r = row0 + ai * HALF + m * 16; const size_t off = (size_t)r * D + col0; float sq = 0.f;
#pragma unroll
                for (int bj = 0; bj < 2; ++bj)
#pragma unroll
                    for (int n = 0; n < 2; ++n) { const f32x4 rr = residb ? ld_bf4(residb + off + bj * HALF + n * 16) : *(const f32x4*)(resid + off + bj * HALF + n * 16); const f32x4 h = rr + g[bj][n] * acc[ai][bj][m][n];
                        st_bf4(hb + off + bj * HALF + n * 16, h); sq += h[0] * h[0] + h[1] * h[1] + h[2] * h[2] + h[3] * h[3];
                        const f32x4 a = h * gm[bj][n]; u32x2 w; w.x = pk_bf16(a[0], a[1]); w.y = pk_bf16(a[2], a[3]); *(u32x2*)(An + off + bj * HALF + n * 16) = w; }
                sq += __shfl_xor(sq, 16); sq += __shfl_xor(sq, 32);
                if (fq == 0) unsafeAtomicAdd(ss + r, sq);
                asm volatile("" ::: "memory"); }
    }
};
struct EpiFinal {
    static constexpr bool PERM = false, AFTER_DRAIN = false, MID = false, PREFETCH = false, MUT = true;
    const bf16_t* residb; float* out; const float* gmod; const float* gfin; float* ss; unsigned* cnt; float coef; int pad_;
    DI void mid(f32x4 (&)[2][2][4][2], const Unit&, int, int, int, int) const {}
    DI void fin(f32x4 (&acc)[2][2][4][2], const Unit& u, int wr, int wc, int fr, int fq) const {
        const int row0 = u.pm * BM + wr * 64 + fr, col0 = u.pn * BM + wc * 32 + 4 * fq;
        { const float* gv = gmod + (size_t)(u.pm >> 4) * NMOD + col0;
          f32x4 g[2][2]; float olds[2][4];
#pragma unroll
          for (int bj = 0; bj < 2; ++bj)
#pragma unroll
              for (int n = 0; n < 2; ++n) g[bj][n] = *(const f32x4*)(gv + bj * HALF + n * 16) * coef;
#pragma unroll
          for (int ai = 0; ai < 2; ++ai)
#pragma unroll
              for (int m = 0; m < 4; ++m) { const int r = row0 + ai * HALF + m * 16; const size_t off = (size_t)r * D + col0; float sq = 0.f;
#pragma unroll
                  for (int bj = 0; bj < 2; ++bj)
#pragma unroll
                      for (int n = 0; n < 2; ++n) { const f32x4 rr = ld_bf4(residb + off + bj * HALF + n * 16); const f32x4 h = rr + g[bj][n] * acc[ai][bj][m][n];
                          acc[ai][bj][m][n] = h; sq += h[0] * h[0] + h[1] * h[1] + h[2] * h[2] + h[3] * h[3]; }
                  sq += __shfl_xor(sq, 16); sq += __shfl_xor(sq, 32);
                  olds[ai][m] = 0.f;
                  if (fq == 0) olds[ai][m] = unsafeAtomicAdd(ss + r, sq);
                  asm volatile("" ::: "memory"); }
#pragma unroll
          for (int ai = 0; ai < 2; ++ai)
#pragma unroll
              for (int m = 0; m < 4; ++m) asm volatile("" :: "v"(olds[ai][m])); }
        asm volatile("s_waitcnt vmcnt(0)" ::: "memory");
        unsigned* c = cnt + u.pm * 64;
        if (fr == 0 && fq == 0) __hip_atomic_fetch_add(c, 1u, __ATOMIC_RELAXED, __HIP_MEMORY_SCOPE_AGENT);
        { unsigned spins = 0;
          while (__hip_atomic_load(c, __ATOMIC_RELAXED, __HIP_MEMORY_SCOPE_AGENT) < 64u) { __builtin_amdgcn_s_sleep(2); if (++spins > (1u << 22)) break; } }
        asm volatile("" ::: "memory");
        f32x4 gf[2][2];
#pragma unroll
        for (int bj = 0; bj < 2; ++bj)
#pragma unroll
            for (int n = 0; n < 2; ++n) gf[bj][n] = *(const f32x4*)(gfin + col0 + bj * HALF + n * 16);
#pragma unroll
        for (int ai = 0; ai < 2; ++ai)
#pragma unroll
            for (int m = 0; m < 4; ++m) { const int r = row0 + ai * HALF + m * 16; const size_t off = (size_t)r * D + col0;
                const float rs = rsqrtf(__hip_atomic_load(ss + r, __ATOMIC_RELAXED, __HIP_MEMORY_SCOPE_AGENT) * (1.0f / D) + EPS);
#pragma unroll
                for (int bj = 0; bj < 2; ++bj)
#pragma unroll
                    for (int n = 0; n < 2; ++n) *(f32x4*)(out + off + bj * HALF + n * 16) = acc[ai][bj][m][n] * rs * gf[bj][n]; }
    }
};
DI float rstd_of(const float* ss, int r) { return rsqrtf(ss[r] * (1.0f / D) + EPS); }
struct EpiSwiGLUN {
    static constexpr bool PERM = true, AFTER_DRAIN = false, MID = false, PREFETCH = false, MUT = false;
    bf16_t* H; const float* ss; const float* shw;
    DI void mid(f32x4 (&)[2][2][4][2], const Unit&, int, int, int, int) const {}
    DI void operator()(const f32x4 (&acc)[2][2][4][2], const Unit& u, int wr, int wc, int fr, int fq) const {
        const int row0 = u.pm * BM + wr * 64 + fr, col0 = u.pn * HALF + wc * 32 + 8 * fq;
        const float* sp = shw + (size_t)(u.pm >> 4) * (2 * DFF) + u.pn * BM + wc * 32 + 8 * fq;
        f32x4 sg[2], su[2];
#pragma unroll
        for (int n = 0; n < 2; ++n) { sg[n] = *(const f32x4*)(sp + 4 * n); su[n] = *(const f32x4*)(sp + HALF + 4 * n); }
#pragma unroll
        for (int ai = 0; ai < 2; ++ai)
#pragma unroll
            for (int m = 0; m < 4; ++m) { const int r = row0 + ai * HALF + m * 16; const float rs = rstd_of(ss, r);
                float o[8];
#pragma unroll
                for (int n = 0; n < 2; ++n)
#pragma unroll
                    for (int j = 0; j < 4; ++j) { const float g = acc[ai][0][m][n][j] * rs + sg[n][j], up = acc[ai][1][m][n][j] * rs + su[n][j]; o[n * 4 + j] = g * sigmoidf_(g) * up; }
                u32x4 w; w.x = pk_bf16(o[0], o[1]); w.y = pk_bf16(o[2], o[3]); w.z = pk_bf16(o[4], o[5]); w.w = pk_bf16(o[6], o[7]);
                *(u32x4*)(H + (size_t)r * DFF + col0) = w; }
    }
};
struct EpiPN {
    static constexpr bool PERM = true, AFTER_DRAIN = false, MID = false, PREFETCH = false, MUT = false;
    bf16_t* O; int ldc; int nscale; float scale; const float* ss; const float* shw; int shld;
    DI void mid(f32x4 (&)[2][2][4][2], const Unit&, int, int, int, int) const {}
    DI void operator()(const f32x4 (&acc)[2][2][4][2], const Unit& u, int wr, int wc, int fr, int fq) const {
        const int row0 = u.pm * BM + wr * 64 + fr, col0 = u.pn * BM + wc * 32 + 8 * fq;
        const float s = (u.pn < nscale) ? scale : 1.0f;
        const float* sp = shw + (size_t)(u.pm >> 4) * shld + col0;
        f32x4 sh[2][2];
#pragma unroll
        for (int bj = 0; bj < 2; ++bj)
#pragma unroll
            for (int n = 0; n < 2; ++n) sh[bj][n] = *(const f32x4*)(sp + bj * HALF + 4 * n);
#pragma unroll
        for (int ai = 0; ai < 2; ++ai)
#pragma unroll
            for (int m = 0; m < 4; ++m) { const int r = row0 + ai * HALF + m * 16; const float rs = rstd_of(ss, r); bf16_t* p = O + (size_t)r * ldc + col0;
#pragma unroll
                for (int bj = 0; bj < 2; ++bj) { const f32x4 v0 = (acc[ai][bj][m][0] * rs + sh[bj][0]) * s, v1 = (acc[ai][bj][m][1] * rs + sh[bj][1]) * s;
                    u32x4 w; w.x = pk_bf16(v0[0], v0[1]); w.y = pk_bf16(v0[2], v0[3]); w.z = pk_bf16(v1[0], v1[1]); w.w = pk_bf16(v1[2], v1[3]);
                    *(u32x4*)(p + bj * HALF) = w; } }
    }
};
struct EpiVTN {
    static constexpr bool PERM = true, AFTER_DRAIN = false, MID = false, PREFETCH = false, MUT = false;
    bf16_t* O; const float* ss; const float* shw;
    DI void mid(f32x4 (&)[2][2][4][2], const Unit&, int, int, int, int) const {}
    DI void operator()(const f32x4 (&acc)[2][2][4][2], const Unit& u, int wr, int wc, int fr, int fq) const {
        const int row0 = u.pm * BM + wr * 64 + fr, col0 = u.pn * BM + wc * 32 + 8 * fq;
        const float* sp = shw + (size_t)(u.pn >> 4) * 9216;
        f32x4 rs[2][2];
#pragma unroll
        for (int bj = 0; bj < 2; ++bj)
#pragma unroll
            for (int n = 0; n < 2; ++n) { const f32x4 q = *(const f32x4*)(ss + col0 + bj * HALF + 4 * n);
#pragma unroll
                for (int j = 0; j < 4; ++j) rs[bj][n][j] = rsqrtf(q[j] * (1.0f / D) + EPS); }
#pragma unroll
        for (int ai = 0; ai < 2; ++ai)
#pragma unroll
            for (int m = 0; m < 4; ++m) { const int r = row0 + ai * HALF + m * 16; const float shv = sp[r]; bf16_t* p = O + (size_t)r * T + col0;
#pragma unroll
                for (int bj = 0; bj < 2; ++bj) { const f32x4 v0 = acc[ai][bj][m][0] * rs[bj][0] + shv, v1 = acc[ai][bj][m][1] * rs[bj][1] + shv;
                    u32x4 w; w.x = pk_bf16(v0[0], v0[1]); w.y = pk_bf16(v0[2], v0[3]); w.z = pk_bf16(v1[0], v1[1]); w.w = pk_bf16(v1[2], v1[3]);
                    *(u32x4*)(p + bj * HALF) = w; } }
    }
};
struct EpiP {
    static constexpr bool PERM = true, AFTER_DRAIN = false, MID = false, PREFETCH = false, MUT = false;
    bf16_t* O; int ldc; int nscale; float scale;
    DI void mid(f32x4 (&)[2][2][4][2], const Unit&, int, int, int, int) const {}
    DI void operator()(const f32x4 (&acc)[2][2][4][2], const Unit& u, int wr, int wc, int fr, int fq) const {
        const int row0 = u.pm * BM + wr * 64 + fr, col0 = u.pn * BM + wc * 32 + 8 * fq;
        const float s = (u.pn < nscale) ? scale : 1.0f;
#pragma unroll
        for (int ai = 0; ai < 2; ++ai)
#pragma unroll
            for (int m = 0; m < 4; ++m) { bf16_t* p = O + (size_t)(row0 + ai * HALF + m * 16) * ldc + col0;
#pragma unroll
                for (int bj = 0; bj < 2; ++bj) { const f32x4 v0 = acc[ai][bj][m][0] * s, v1 = acc[ai][bj][m][1] * s;
                    u32x4 w; w.x = pk_bf16(v0[0], v0[1]); w.y = pk_bf16(v0[2], v0[3]); w.z = pk_bf16(v1[0], v1[1]); w.w = pk_bf16(v1[2], v1[3]);
                    *(u32x4*)(p + bj * HALF) = w; } }
    }
};
struct EpiBranch {
    #ifdef TEST_NOMID
    static constexpr bool PERM = true, AFTER_DRAIN = false, MID = false, PREFETCH = false, MUT = false;
#else
    static constexpr bool PERM = true, AFTER_DRAIN = false, MID = true, PREFETCH = false, MUT = false;
#endif
    const bf16_t* P; bf16_t* O;
    DI static float cl(float x) { return fminf(fmaxf(x, -60.f), 60.f); }
    DI void mid(f32x4 (&acc)[2][2][4][2], const Unit& u, int wr, int wc, int fr, int fq) const {
        int row0 = u.pm * BM + wr * 64 + fr, col0 = u.pn * BM + wc * 32 + 8 * fq;
        asm volatile("" : "+v"(row0), "+v"(col0));
#pragma unroll
        for (int ai = 0; ai < 2; ++ai)
#pragma unroll
            for (int m = 0; m < 4; ++m) { const bf16_t* gp = P + (size_t)(row0 + ai * HALF + m * 16) * PW + 4096 + col0;
#pragma unroll
                for (int bj = 0; bj < 2; ++bj) { const u32x4 ga = *(const u32x4*)(gp + bj * HALF), gl = *(const u32x4*)(gp + 2048 + bj * HALF);
#pragma unroll
                    for (int q = 0; q < 4; ++q) { const float a0 = cl(bf_lo(ga[q])), a1 = cl(bf_hi(ga[q])), l0 = cl(bf_lo(gl[q])), l1 = cl(bf_hi(gl[q]));
                        const float r0 = (1.0f + fast_exp2(-l0 * LOG2E)) * fast_rcp(1.0f + fast_exp2(-a0 * LOG2E));
                        const float r1 = (1.0f + fast_exp2(-l1 * LOG2E)) * fast_rcp(1.0f + fast_exp2(-a1 * LOG2E));
                        acc[ai][bj][m][q >> 1][(q & 1) * 2] *= r0; acc[ai][bj][m][q >> 1][(q & 1) * 2 + 1] *= r1; } }
                asm volatile("" ::: "memory"); }
    }
    DI void operator()(const f32x4 (&acc)[2][2][4][2], const Unit& u, int wr, int wc, int fr, int fq) const {
        const int row0 = u.pm * BM + wr * 64 + fr, col0 = u.pn * BM + wc * 32 + 8 * fq;
#pragma unroll
        for (int ai = 0; ai < 2; ++ai)
#pragma unroll
            for (int m = 0; m < 4; ++m) { const size_t r = (size_t)(row0 + ai * HALF + m * 16); const bf16_t* gp = P + r * PW + 6144 + col0;
#pragma unroll
                for (int bj = 0; bj < 2; ++bj) { const u32x4 gl = *(const u32x4*)(gp + bj * HALF); float o[8];
#pragma unroll
                    for (int q = 0; q < 4; ++q) { const float l0 = cl(bf_lo(gl[q])), l1 = cl(bf_hi(gl[q]));
                        o[q * 2] = acc[ai][bj][m][q >> 1][(q & 1) * 2] * fast_rcp(1.0f + fast_exp2(-l0 * LOG2E));
                        o[q * 2 + 1] = acc[ai][bj][m][q >> 1][(q & 1) * 2 + 1] * fast_rcp(1.0f + fast_exp2(-l1 * LOG2E)); }
                    u32x4 w; w.x = pk_bf16(o[0], o[1]); w.y = pk_bf16(o[2], o[3]); w.z = pk_bf16(o[4], o[5]); w.w = pk_bf16(o[6], o[7]);
                    *(u32x4*)(O + r * D + col0 + bj * HALF) = w; }
                asm volatile("" ::: "memory"); }
    }
};

template <class Epi, class Sched, bool ALIGN_EPI = false, bool SP2 = false>
__device__ __forceinline__ void gemm_phase(PG8_LAS unsigned char* lds, const Gemm g, const Sched& S, const Epi& E) {
    const int tid = threadIdx.x, wid = __builtin_amdgcn_readfirstlane(tid >> 6), lane = tid & 63, wr = wid >> 2, wc = wid & 3, fr = lane & 15, fq = lane >> 4;
    const int K = g.K, nt = K / BK;
    unsigned voffA[2], voffB[2];
#pragma unroll
    for (int i = 0; i < 2; ++i) { int R, C; stage_rc(tid * 16 + i * 8192, R, C); const int Rb = Epi::PERM ? ((R & ~31) + perm32(R & 31)) : R;
        voffA[i] = (unsigned)(R * K + C) * 2u; voffB[i] = (unsigned)(Rb * K + C) * 2u; }
    const long kstep = g.rev ? -(long)(BK * 2) : (long)(BK * 2);
    const size_t kfirst = g.rev ? (size_t)(nt - 1) * (size_t)(BK * 2) : 0;
    const size_t hstep = (size_t)HALF * K * 2;
    const size_t tstep = 2 * hstep;
    const unsigned ldsw = (unsigned)wid * 1024u;
    const int aoff = lds_byte(wr * 64 + fr, fq * 8), boff = lds_byte(wc * 32 + fr, fq * 8);
#define PG8_SA(b, h) (((b) * 2 + (h)) * HTB)
#define PG8_SB(b, h) ((4 + (b) * 2 + (h)) * HTB)
#define PG8_STAGE(bufoff, gbase, voff) do { _Pragma("unroll") for (int _i = 0; _i < 2; ++_i) \
        __builtin_amdgcn_global_load_lds((const unsigned*)((const char*)(gbase) + (voff)[_i]), (PG8_LAS unsigned*)(lds + (bufoff) + ldsw + _i * 8192), 16, 0, 0); } while (0)
#define PG8_LDA(dst, b, h) do { _Pragma("unroll") for (int m = 0; m < 4; ++m) _Pragma("unroll") for (int k = 0; k < 2; ++k) dst[m][k] = *(const PG8_LAS bf16x8*)(lds + PG8_SA(b, h) + aoff + m * 2048 + k * 1024); } while (0)
#define PG8_LDB(dst, b, h) do { _Pragma("unroll") for (int n = 0; n < 2; ++n) _Pragma("unroll") for (int k = 0; k < 2; ++k) dst[n][k] = *(const PG8_LAS bf16x8*)(lds + PG8_SB(b, h) + boff + n * 2048 + k * 1024); } while (0)
#define PG8_MMA(ai, bj, At, Bt) do { __builtin_amdgcn_s_setprio(1); _Pragma("unroll") for (int m = 0; m < 4; ++m) _Pragma("unroll") for (int n = 0; n < 2; ++n) _Pragma("unroll") for (int k = 0; k < 2; ++k) \
        acc[ai][bj][m][n] = __builtin_amdgcn_mfma_f32_16x16x32_bf16(Bt[n][k], At[m][k], acc[ai][bj][m][n], 0, 0, 0); __builtin_amdgcn_s_setprio(0); } while (0)
#define PG8_WAIT_V(n) asm volatile("s_waitcnt vmcnt(" #n ")" ::: "memory")
#define PG8_WAIT_L(n) asm volatile("s_waitcnt lgkmcnt(" #n ")" ::: "memory")
#define PG8_BAR __builtin_amdgcn_s_barrier()
#define PG8_SCHED __builtin_amdgcn_sched_barrier(0)
    Unit cur, nxt; int ui = 0;
    if (!S.next(0, cur)) return;
    f32x4 acc[2][2][4][2];
#pragma unroll
    for (int a = 0; a < 2; ++a)
#pragma unroll
        for (int b = 0; b < 2; ++b)
#pragma unroll
            for (int m = 0; m < 4; ++m)
#pragma unroll
                for (int n = 0; n < 2; ++n) acc[a][b][m][n] = (f32x4){0.f, 0.f, 0.f, 0.f};
    bf16x8 At[4][2], B0[2][2], B1[2][2];
    unsigned pfv[4] = {0u, 0u, 0u, 0u};
    const char* cA = (const char*)g.A + (size_t)cur.pm * tstep + kfirst; const char* cB = (const char*)g.Bt + (size_t)cur.pn * tstep + kfirst;
    S.a_ready(cur);
    if constexpr (SP2) {
        PG8_STAGE(PG8_SB(0, 0), cB, voffB); PG8_STAGE(PG8_SB(0, 1), cB + hstep, voffB); PG8_STAGE(PG8_SA(0, 0), cA, voffA); PG8_STAGE(PG8_SA(0, 1), cA + hstep, voffA);
        if (wr == 1) PG8_BAR;
        PG8_WAIT_V(2); PG8_BAR;
        PG8_STAGE(PG8_SB(1, 0), cB + kstep, voffB); PG8_STAGE(PG8_SA(1, 0), cA + kstep, voffA); PG8_STAGE(PG8_SB(1, 1), cB + hstep + kstep, voffB);
        PG8_WAIT_V(6); PG8_BAR;
    } else {
        PG8_STAGE(PG8_SB(0, 0), cB, voffB); PG8_STAGE(PG8_SA(0, 0), cA, voffA); PG8_STAGE(PG8_SB(0, 1), cB + hstep, voffB); PG8_STAGE(PG8_SA(0, 1), cA + hstep, voffA);
        if (wr == 1) PG8_BAR;
        PG8_WAIT_V(4); PG8_BAR;
        PG8_STAGE(PG8_SB(1, 0), cB + kstep, voffB); PG8_STAGE(PG8_SA(1, 0), cA + kstep, voffA); PG8_STAGE(PG8_SB(1, 1), cB + hstep + kstep, voffB);
        PG8_WAIT_V(6); PG8_BAR;
    }
    for (;;) {
        const bool has_next = S.next(ui + 1, nxt);
        const char* nA = has_next ? (const char*)g.A + (size_t)nxt.pm * tstep + kfirst : cA; const char* nB = has_next ? (const char*)g.Bt + (size_t)nxt.pn * tstep + kfirst : cB;
        for (int t = 0; t < nt; t += 2) {
            const bool last = (t == nt - 2);
            const char* a1 = cA + (long)(t + 1) * kstep;
            const char* a2 = last ? nA : cA + (long)(t + 2) * kstep; const char* b2 = last ? nB : cB + (long)(t + 2) * kstep;
            const char* a3 = a2 + kstep; const char* b3 = b2 + kstep;
            if (last && has_next) S.a_ready(nxt);
            if constexpr (Epi::MID) { PG8_SCHED; if (t == nt / 2) E.mid(acc, cur, wr, wc, fr, fq); PG8_SCHED; }
            if constexpr (Epi::PREFETCH) { if (t == nt - 4) E.prefetch(pfv, cur, wr, wc, fr, fq); }
            if constexpr (SP2) {
            PG8_LDB(B0, 0, 0); PG8_LDB(B1, 0, 1); PG8_SCHED; PG8_LDA(At, 0, 0); PG8_STAGE(PG8_SA(1, 1), a1 + hstep, voffA);
            PG8_WAIT_V(8); PG8_WAIT_L(0); PG8_BAR; PG8_MMA(0, 0, At, B0); PG8_MMA(0, 1, At, B1); PG8_BAR; PG8_SCHED;
            PG8_LDA(At, 0, 1); PG8_STAGE(PG8_SB(0, 0), b2, voffB); PG8_STAGE(PG8_SB(0, 1), b2 + hstep, voffB); PG8_STAGE(PG8_SA(0, 0), a2, voffA);
            PG8_WAIT_V(8); PG8_WAIT_L(0); PG8_BAR; PG8_MMA(1, 0, At, B0); PG8_MMA(1, 1, At, B1); PG8_BAR; PG8_SCHED;
            PG8_LDB(B0, 1, 0); PG8_LDB(B1, 1, 1); PG8_SCHED; PG8_LDA(At, 1, 0); PG8_STAGE(PG8_SA(0, 1), a2 + hstep, voffA);
            PG8_WAIT_V(8); PG8_WAIT_L(0); PG8_BAR; PG8_MMA(0, 0, At, B0); PG8_MMA(0, 1, At, B1); PG8_BAR; PG8_SCHED;
            PG8_LDA(At, 1, 1); PG8_STAGE(PG8_SB(1, 0), b3, voffB); PG8_STAGE(PG8_SB(1, 1), b3 + hstep, voffB); PG8_STAGE(PG8_SA(1, 0), a3, voffA);
            PG8_WAIT_V(8); PG8_WAIT_L(0); PG8_BAR; PG8_MMA(1, 0, At, B0); PG8_MMA(1, 1, At, B1); PG8_BAR; PG8_SCHED;
            } else {
            PG8_LDB(B0, 0, 0); PG8_SCHED; PG8_LDA(At, 0, 0); PG8_STAGE(PG8_SA(1, 1), a1 + hstep, voffA);
            PG8_WAIT_L(8); PG8_BAR; PG8_WAIT_L(0); PG8_MMA(0, 0, At, B0); PG8_BAR; PG8_SCHED;
            PG8_LDB(B1, 0, 1); PG8_STAGE(PG8_SB(0, 0), b2, voffB);
            PG8_BAR; PG8_WAIT_L(0); PG8_MMA(0, 1, At, B1); PG8_BAR;
            PG8_LDA(At, 0, 1); PG8_STAGE(PG8_SA(0, 0), a2, voffA);
            PG8_BAR; PG8_WAIT_L(0); PG8_MMA(1, 0, At, B0); PG8_BAR; PG8_SCHED;
            PG8_STAGE(PG8_SB(0, 1), b2 + hstep, voffB);
            PG8_WAIT_V(6); PG8_BAR; PG8_MMA(1, 1, At, B1); PG8_BAR;
            PG8_LDB(B0, 1, 0); PG8_SCHED; PG8_LDA(At, 1, 0); PG8_STAGE(PG8_SA(0, 1), a2 + hstep, voffA);
            PG8_WAIT_L(8); PG8_BAR; PG8_WAIT_L(0); PG8_MMA(0, 0, At, B0); PG8_BAR; PG8_SCHED;
            PG8_LDB(B1, 1, 1); PG8_STAGE(PG8_SB(1, 0), b3, voffB);
            PG8_BAR; PG8_WAIT_L(0); PG8_MMA(0, 1, At, B1); PG8_BAR;
            PG8_LDA(At, 1, 1); PG8_STAGE(PG8_SA(1, 0), a3, voffA);
            PG8_BAR; PG8_WAIT_L(0); PG8_MMA(1, 0, At, B0); PG8_BAR; PG8_SCHED;
            PG8_STAGE(PG8_SB(1, 1), b3 + hstep, voffB);
            PG8_WAIT_V(6); PG8_BAR; PG8_MMA(1, 1, At, B1); PG8_BAR;
            }
        }
        if constexpr (Epi::PREFETCH) asm volatile("" :: "v"(pfv[0]), "v"(pfv[1]), "v"(pfv[2]), "v"(pfv[3]));
        if constexpr (ALIGN_EPI) { if (wr == 0) PG8_BAR; }
        if constexpr (!Epi::AFTER_DRAIN) { if constexpr (Epi::MUT) E.fin(acc, cur, wr, wc, fr, fq); else E(acc, cur, wr, wc, fr, fq); S.done(cur); }
        if (!has_next) break;
#pragma unroll
        for (int a = 0; a < 2; ++a)
#pragma unroll
            for (int b = 0; b < 2; ++b)
#pragma unroll
                for (int m = 0; m < 4; ++m)
#pragma unroll
                    for (int n = 0; n < 2; ++n) acc[a][b][m][n] = (f32x4){0.f, 0.f, 0.f, 0.f};
        cur = nxt; cA = nA; cB = nB; ++ui;
        if constexpr (ALIGN_EPI) { if (wr == 1) PG8_BAR; }
    }
    PG8_WAIT_V(0);
    if constexpr (!ALIGN_EPI) { if (wr == 0) PG8_BAR; }
    PG8_BAR;
    if constexpr (Epi::AFTER_DRAIN) { E.fused(acc, cur, wr, wc, fr, fq, lds, wid, lane); S.done(cur); }
#undef PG8_SA
#undef PG8_SB
#undef PG8_STAGE
#undef PG8_LDA
#undef PG8_LDB
#undef PG8_MMA
#undef PG8_WAIT_V
#undef PG8_WAIT_L
#undef PG8_BAR
#undef PG8_SCHED
}
}

#define XB_TMO      128
#define XB_XCNT(j)  (256  + 64 * (j))
#define XB_XSUB(j)  (1280 + 64 * (j))
#define XB_XGEN(j)  (2304 + 64 * (j))
#define XB_TOP      3328
#define XB_TOPGEN   3392
#define XCD_BAR_WORDS 3456
#define XB_SPIN_CAP (1u << 18)

__device__ __forceinline__ unsigned xb_ld(unsigned* p)              { return __hip_atomic_load(p, __ATOMIC_RELAXED, __HIP_MEMORY_SCOPE_AGENT); }
__device__ __forceinline__ unsigned xb_add(unsigned* p, unsigned v) { return __hip_atomic_fetch_add(p, v, __ATOMIC_RELAXED, __HIP_MEMORY_SCOPE_AGENT); }
__device__ __forceinline__ unsigned xb_xcc_id() { return (unsigned)__builtin_amdgcn_s_getreg((3 << 11) | 20) & 0xFu; }
#define XB_SPIN(cond, bar) do { unsigned _sp = 0; while (cond) { __builtin_amdgcn_s_sleep(1); \
    if ((++_sp & 255u) == 0u) { if (xb_ld(&(bar)[XB_TMO])) break; if (_sp > XB_SPIN_CAP) { atomicAdd(&(bar)[XB_TMO], 1u); break; } } } } while (0)

struct XcdBarrier {
    unsigned* bar; unsigned x;
    volatile LAS unsigned* st;
};

__device__ __forceinline__ XcdBarrier xcd_barrier_post(unsigned* bar, volatile LAS unsigned* st) {
    XcdBarrier b; b.bar = bar; b.x = xb_xcc_id(); b.st = st;
    if (threadIdx.x == 0) (void)xb_add(&bar[XB_XCNT(b.x)], 1u);
    return b;
}
__device__ __forceinline__ void xcd_barrier_complete(unsigned* bar, unsigned x, unsigned& nloc, unsigned& nx) {
    const unsigned G = gridDim.x * gridDim.y * gridDim.z;
    unsigned sum, cnt, mine, sp = 0u;
    for (;;) {
        sum = 0u; cnt = 0u; mine = 0u;
#pragma unroll
        for (unsigned j = 0; j < 16; ++j) { const unsigned c = xb_ld(&bar[XB_XCNT(j)]); sum += c; cnt += (c > 0u) ? 1u : 0u; mine = (j == x) ? c : mine; }
        if (sum == G) break;
        __builtin_amdgcn_s_sleep(1);
        if ((++sp & 255u) == 0u) { if (xb_ld(&bar[XB_TMO])) break; if (sp > XB_SPIN_CAP) { atomicAdd(&bar[XB_TMO], 1u); break; } }
    }
    nloc = mine > 0u ? mine : 1u; nx = cnt > 0u ? cnt : 1u;
}

__device__ __forceinline__ void xcd_barrier(const XcdBarrier& b) {
    asm volatile("s_waitcnt vmcnt(0)" ::: "memory");
    __syncthreads();
    if (threadIdx.x == 0) {
        unsigned* bar = b.bar;
        __builtin_amdgcn_s_waitcnt(0);
        unsigned nloc = b.st[0], nx = b.st[1];
        if (nloc == 0u) { xcd_barrier_complete(bar, b.x, nloc, nx); b.st[0] = nloc; b.st[1] = nx; }
        const unsigned old = xb_add(&bar[XB_XSUB(b.x)], 1u);
        const unsigned gen = old / nloc;
        if (old + 1u == (gen + 1u) * nloc) {
            __builtin_amdgcn_fence(__ATOMIC_RELEASE, "agent");
            asm volatile("s_waitcnt vmcnt(0)" ::: "memory");
            const unsigned og = xb_add(&bar[XB_TOP], 1u);
            const unsigned tg = og / nx;
            if (og + 1u == (tg + 1u) * nx) xb_add(&bar[XB_TOPGEN], 1u);
            else XB_SPIN(xb_ld(&bar[XB_TOPGEN]) == tg, bar);
            __builtin_amdgcn_fence(__ATOMIC_ACQUIRE, "agent");
            xb_add(&bar[XB_XGEN(b.x)], 1u);
            asm volatile("s_waitcnt vmcnt(0)" ::: "memory");
        } else {
            XB_SPIN(xb_ld(&bar[XB_XGEN(b.x)]) == gen, bar);
            __builtin_amdgcn_fence(__ATOMIC_ACQUIRE, "agent");
            asm volatile("s_waitcnt vmcnt(0)" ::: "memory");
        }
    }
    __syncthreads();
}


struct Args { const float* in[23]; float* out; unsigned char* ws; int ph_lo, ph_hi; };
enum { I_X = 0, I_C, I_WADA, I_BADA, I_N1, I_W1IN, I_W1OUT, I_NMIX, I_WIN, I_CONVW, I_CONVB, I_WRG, I_BRG, I_WIG, I_BIG, I_LAM, I_WBA, I_WBL, I_WOUT, I_N2, I_W2IN, I_W2OUT, I_NF };

DI void conv_tile(LAS float* buf, const float* src, int lds_, bf16_t* dst, int ldd) {
    const int tid = threadIdx.x;
    float4 v[8];
#pragma unroll
    for (int i = 0; i < 8; ++i) { const int k = (tid >> 4) + 32 * i, cgp = tid & 15; v[i] = *(const float4*)(src + (size_t)k * lds_ + cgp * 4); }
#pragma unroll
    for (int i = 0; i < 8; ++i) { const int k = (tid >> 4) + 32 * i, cgp = tid & 15; LAS float* p = buf + k * 65 + cgp * 4; p[0] = v[i].x; p[1] = v[i].y; p[2] = v[i].z; p[3] = v[i].w; }
    __syncthreads();
#pragma unroll
    for (int i = 0; i < 4; ++i) { const int q = tid + 512 * i, g = q >> 6, kg = (g & 3) * 8 + (q & 7), n = (g >> 2) * 8 + ((q >> 3) & 7); float f[8];
#pragma unroll
        for (int j = 0; j < 8; ++j) f[j] = buf[(kg * 8 + j) * 65 + n];
        u32x4 o; o.x = pk_bf16(f[0], f[1]); o.y = pk_bf16(f[2], f[3]); o.z = pk_bf16(f[4], f[5]); o.w = pk_bf16(f[6], f[7]);
        *(u32x4*)(dst + (size_t)n * ldd + kg * 8) = o; }
    __syncthreads();
}
DI void conv_tile64(LAS float* buf, const float* src, int lds_, bf16_t* dst, int ldd) {
    const int tid = threadIdx.x;
#pragma unroll
    for (int i = 0; i < 2; ++i) { const int k = (tid >> 4) + 32 * i, cgp = tid & 15; const float4 v = *(const float4*)(src + (size_t)k * lds_ + cgp * 4);
        LAS float* p = buf + k * 65 + cgp * 4; p[0] = v.x; p[1] = v.y; p[2] = v.z; p[3] = v.w; }
    __syncthreads();
    { const int kg = tid & 7, n = tid >> 3; float f[8];
#pragma unroll
        for (int j = 0; j < 8; ++j) f[j] = buf[(kg * 8 + j) * 65 + n];
        u32x4 o; o.x = pk_bf16(f[0], f[1]); o.y = pk_bf16(f[2], f[3]); o.z = pk_bf16(f[4], f[5]); o.w = pk_bf16(f[6], f[7]);
        *(u32x4*)(dst + (size_t)n * ldd + kg * 8) = o; }
    __syncthreads();
}
DI void conv_job(LAS float* buf, int& rot, const float* src, int ldsrc, int K, int Nd, bf16_t* dst, int lddst, int koff, int map) {
    const int G = gridDim.x, KT = (map == 4) ? 64 : 256, tn_n = Nd >> 6, ntile = tn_n * (K / KT);
    for (int t = (int)((blockIdx.x + rot) % G); t < ntile; t += G) {
        const int tn = t % tn_n, tk = t / tn_n, n0 = tn * 64, k0 = tk * KT;
        if (map == 4) { conv_tile64(buf, src + (size_t)(n0 >> 7) * 16384 + (size_t)k0 * 128 + (n0 & 127), ldsrc, dst + (size_t)n0 * lddst + koff + k0, lddst); continue; }
        int c0 = n0;
        if (map == 1) { const int pn = n0 >> 8, rr = n0 & 255; c0 = rr < 128 ? 128 * pn + rr : DFF + 128 * pn + rr - 128; }
        else if (map == 2) c0 = n0 < 2048 ? n0 : n0 + 1024;
        else if (map == 3) c0 = 2048 + n0;
        conv_tile(buf, src + (size_t)k0 * ldsrc + c0, ldsrc, dst + (size_t)n0 * lddst + koff + k0, lddst);
    }
    rot = (rot + G - ntile % G) % G;
}
DI void mod_items(LAS float* lf, const float* c, const float* w_ada, const float* b_ada, float* mod) {
    const int tid = threadIdx.x;
    if (blockIdx.x >= 256) return;
    for (int i = tid; i < 8192; i += 512) { const float v = c[i]; lf[i] = v * sigmoidf_(v); }
    __syncthreads();
    LAS float* part = lf + 8192;
    for (int it = blockIdx.x; it < 256; it += gridDim.x) {
        const int col0 = it * 72, cgp = tid % 18, ks = tid / 18;
        if (ks < 28) {
            const int k0 = (ks * 2048) / 28, k1 = ((ks + 1) * 2048) / 28;
            float acc[4][4];
#pragma unroll
            for (int b = 0; b < 4; ++b)
#pragma unroll
                for (int j = 0; j < 4; ++j) acc[b][j] = 0.f;
            const float* wp = w_ada + (size_t)k0 * NMOD + col0 + cgp * 4;
#pragma unroll 8
            for (int k = k0; k < k1; ++k) { const float4 w = *(const float4*)wp; wp += NMOD;
#pragma unroll
                for (int b = 0; b < 4; ++b) { const float cv = lf[b * 2048 + k]; acc[b][0] += cv * w.x; acc[b][1] += cv * w.y; acc[b][2] += cv * w.z; acc[b][3] += cv * w.w; } }
#pragma unroll
            for (int b = 0; b < 4; ++b)
#pragma unroll
                for (int j = 0; j < 4; ++j) part[(ks * 18 + cgp) * 16 + b * 4 + j] = acc[b][j];
        }
        __syncthreads();
        if (tid < 288) { const int b = tid / 72, cc = tid % 72; float s = 0.f;
            for (int k2 = 0; k2 < 28; ++k2) s += part[(k2 * 18 + (cc >> 2)) * 16 + b * 4 + (cc & 3)];
            mod[b * NMOD + col0 + cc] = s + b_ada[col0 + cc]; }
        __syncthreads();
    }
}

DI void shw_rows(LAS float* lsh, const bf16_t* Bt, int nrows, const float* mod, int ish, float* shw, int ld, int col_off) {
    const int tid = threadIdx.x, lane = tid & 63, wave = tid >> 6;
    __syncthreads();
    for (int i = tid; i < 4 * D; i += 512) lsh[i] = mod[(size_t)(i >> 11) * NMOD + ish * D + (i & (D - 1))];
    __syncthreads();
    for (int r = blockIdx.x * 8 + wave; r < nrows; r += gridDim.x * 8) {
        const bf16_t* wp = Bt + (size_t)r * D; u32x4 wv[4];
#pragma unroll
        for (int i = 0; i < 4; ++i) wv[i] = *(const u32x4*)(wp + (i * 64 + lane) * 8);
        float a0 = 0.f, a1 = 0.f, a2 = 0.f, a3 = 0.f;
#pragma unroll
        for (int i = 0; i < 4; ++i)
#pragma unroll
            for (int q = 0; q < 4; ++q) { const int k = (i * 64 + lane) * 8 + q * 2; const float w0 = bf_lo(wv[i][q]), w1 = bf_hi(wv[i][q]);
                a0 += lsh[k] * w0 + lsh[k + 1] * w1; a1 += lsh[D + k] * w0 + lsh[D + k + 1] * w1; a2 += lsh[2 * D + k] * w0 + lsh[2 * D + k + 1] * w1; a3 += lsh[3 * D + k] * w0 + lsh[3 * D + k + 1] * w1; }
#pragma unroll
        for (int off = 32; off >= 1; off >>= 1) { a0 += __shfl_xor(a0, off); a1 += __shfl_xor(a1, off); a2 += __shfl_xor(a2, off); a3 += __shfl_xor(a3, off); }
        if (lane == 0) { shw[col_off + r] = a0; shw[ld + col_off + r] = a1; shw[2 * ld + col_off + r] = a2; shw[3 * ld + col_off + r] = a3; }
    }
    __syncthreads();
}

template <bool FINAL>
DI void norm_phase(const float* src, const float* gain, const float* mod, int ish, bf16_t* dst, float* dstf) {
    const int lane = threadIdx.x & 63, wave = threadIdx.x >> 6;
    for (int r = blockIdx.x * 8 + wave; r < T; r += gridDim.x * 8) {
        const float* xp = src + (size_t)r * D; f32x4 v[8]; float ss = 0.f;
#pragma unroll
        for (int i = 0; i < 8; ++i) { v[i] = *(const f32x4*)(xp + (i * 64 + lane) * 4); ss += v[i][0] * v[i][0] + v[i][1] * v[i][1] + v[i][2] * v[i][2] + v[i][3] * v[i][3]; }
#pragma unroll
        for (int off = 32; off >= 1; off >>= 1) ss += __shfl_xor(ss, off);
        const float rstd = rsqrtf(ss * (1.0f / D) + EPS);
        const float* sh = mod + (size_t)(r >> 12) * NMOD + ish * D; const float* sc = sh + D;
#pragma unroll
        for (int i = 0; i < 8; ++i) { const int col = (i * 64 + lane) * 4; const f32x4 g = *(const f32x4*)(gain + col);
            f32x4 y = v[i] * rstd * g;
            if (FINAL) *(f32x4*)(dstf + (size_t)r * D + col) = y;
            else { const f32x4 s4 = *(const f32x4*)(sh + col), c4 = *(const f32x4*)(sc + col); y = y * (1.0f + c4) + s4;
                u32x2 w; w.x = pk_bf16(y[0], y[1]); w.y = pk_bf16(y[2], y[3]); *(u32x2*)(dst + (size_t)r * D + col) = w; } }
    }
}

constexpr int AT_KROW = 272, AT_VROW = 144, AT_KB = 64 * AT_KROW, AT_BUF = AT_KB + 128 * AT_VROW;
DI f32x16 attn_qk(const LAS unsigned char* kp, const bf16x8 (&qf)[8]) {
    f32x16 s;
#pragma unroll
    for (int i = 0; i < 16; ++i) s[i] = 0.f;
#pragma unroll
    for (int ks = 0; ks < 8; ++ks) { const bf16x8 a = *(const LAS bf16x8*)(kp + ks * 32); s = __builtin_amdgcn_mfma_f32_32x32x16_bf16(a, qf[ks], s, 0, 0, 0); }
    return s;
}
DI void attn_ew(const f32x16& s, float& C, int half, int ks0, int tq, bool MASKED, bf16x8& pf0, bf16x8& pf1) {
    float kp_[16];
#pragma unroll
    for (int i = 0; i < 16; ++i) kp_[i] = fast_rcp(1.0f + fast_exp2(s[i]));
    if (MASKED) {
        asm volatile("" ::: "memory");
#pragma unroll
        for (int i = 0; i < 16; ++i) { const int key = ks0 + 16 * (i >> 3) + 8 * half + (i & 7); kp_[i] = key < tq ? kp_[i] : 1.0f; } }
    float d[16]; float PA = 1.0f, PB = 1.0f;
#pragma unroll
    for (int i = 15; i >= 8; --i) { const float nx = PB * kp_[i]; d[i] = PB - nx; PB = nx; }
#pragma unroll
    for (int i = 7; i >= 0; --i) { const float nx = PA * kp_[i]; d[i] = PA - nx; PA = nx; }
    const float PAo = __shfl_xor(PA, 32), PBo = __shfl_xor(PB, 32);
    const float t1 = C * PBo, t3 = C * (PB * PBo), t4 = t3 * PAo;
    const float stB = half ? C : t1;
    const float stA = half ? t3 : t4;
    C = C * ((PA * PAo) * (PB * PBo));
    float w[16];
#pragma unroll
    for (int i = 0; i < 8; ++i) { asm("v_mul_f32 %0, %1, %2" : "=v"(w[i]) : "v"(d[i]), "v"(stA)); asm("v_mul_f32 %0, %1, %2" : "=v"(w[8 + i]) : "v"(d[8 + i]), "v"(stB)); }
    u32x4 p0, p1;
    p0.x = pk_bf16(w[0], w[1]); p0.y = pk_bf16(w[2], w[3]); p0.z = pk_bf16(w[4], w[5]); p0.w = pk_bf16(w[6], w[7]);
    p1.x = pk_bf16(w[8], w[9]); p1.y = pk_bf16(w[10], w[11]); p1.z = pk_bf16(w[12], w[13]); p1.w = pk_bf16(w[14], w[15]);
    pf0 = __builtin_bit_cast(bf16x8, p0); pf1 = __builtin_bit_cast(bf16x8, p1);
}
DI void attn_pv(const LAS unsigned char* vp0, const bf16x8& pf0, const bf16x8& pf1, f32x16 (&o)[4]) {
#pragma unroll
    for (int d = 0; d < 4; ++d) { const LAS unsigned char* vp = vp0 + d * 32 * AT_VROW;
        const bf16x8 v0 = *(const LAS bf16x8*)(vp), v1 = *(const LAS bf16x8*)(vp + 32);
        o[d] = __builtin_amdgcn_mfma_f32_32x32x16_bf16(v0, pf0, o[d], 0, 0, 0);
        o[d] = __builtin_amdgcn_mfma_f32_32x32x16_bf16(v1, pf1, o[d], 0, 0, 0); }
}
DI void attn_item(LAS unsigned char* lds, const bf16_t* P, const bf16_t* VT, bf16_t* YM, int b, int h, int qb) {
    const int tid = threadIdx.x, lane = tid & 63, wave = __builtin_amdgcn_readfirstlane(tid >> 6), l32 = lane & 31, half = lane >> 5;
    const int t0 = qb * 256 + wave * 32, tq = t0 + l32;
    const size_t tokbase = (size_t)b * SEQ;
    bf16x8 qf[8];
    { const bf16_t* qp = P + (tokbase + tq) * PW + h * 128 + 8 * half;
#pragma unroll
      for (int ks = 0; ks < 8; ++ks) qf[ks] = *(const bf16x8*)(qp + 16 * ks); }
    f32x16 o[4];
#pragma unroll
    for (int d = 0; d < 4; ++d)
#pragma unroll
        for (int i = 0; i < 16; ++i) o[d][i] = 0.f;
    float C = 1.0f;
    const int ktmax = qb * 4 + 3;
    const bf16_t* Kg = P + tokbase * PW + 1024 + h * 128;
    const bf16_t* Vg = VT + (size_t)(h * 128) * T + tokbase;
    unsigned ko[2], vo[2]; int kl[2], vl[2];
#pragma unroll
    for (int i = 0; i < 2; ++i) { const int p = tid + 512 * i; const int key = p >> 4, part = p & 15; ko[i] = (unsigned)(key * PW + part * 8); kl[i] = key * AT_KROW + part * 16;
        const int d = p >> 3, pv = p & 7; vo[i] = (unsigned)(d * T + pv * 8); vl[i] = AT_KB + d * AT_VROW + pv * 16; }
    u32x4 rk[2], rv[2];
    { const bf16_t* kb = Kg + (size_t)ktmax * 64 * PW; const bf16_t* vb = Vg + ktmax * 64;
#pragma unroll
      for (int i = 0; i < 2; ++i) { rk[i] = *(const u32x4*)(kb + ko[i]); rv[i] = *(const u32x4*)(vb + vo[i]); } }
#pragma unroll
    for (int i = 0; i < 2; ++i) { *(LAS u32x4*)(lds + kl[i]) = rk[i]; *(LAS u32x4*)(lds + vl[i]) = rv[i]; }
#pragma unroll
    for (int ks = 0; ks < 8; ++ks) asm volatile("" : "+v"(qf[ks]));
    __syncthreads();
    const int pir = (l32 & 0x13) | ((l32 & 8) >> 1) | ((l32 & 4) << 1);
    const int koff = pir * AT_KROW + half * 16, voff = l32 * AT_VROW + half * 16;
    int cur = 0;
    for (int kt = ktmax; kt >= 0; --kt) {
        if (kt > 0) { const bf16_t* kb = Kg + (size_t)(kt - 1) * 64 * PW; const bf16_t* vb = Vg + (kt - 1) * 64;
#pragma unroll
            for (int i = 0; i < 2; ++i) { rk[i] = *(const u32x4*)(kb + ko[i]); rv[i] = *(const u32x4*)(vb + vo[i]); } }
        const LAS unsigned char* Kb = lds + cur * AT_BUF + koff; const LAS unsigned char* Vb = lds + cur * AT_BUF + AT_KB + voff;
        if (kt * 64 < t0 + 31) {
            const bool need_mask = (kt * 64 + 63 >= t0);
            bf16x8 pa0, pa1, pb0, pb1;
            const f32x16 s1 = attn_qk(Kb + 32 * AT_KROW, qf);
            const f32x16 s0 = attn_qk(Kb, qf);
            attn_ew(s1, C, half, kt * 64 + 32, tq, need_mask, pa0, pa1);
            attn_pv(Vb + 64, pa0, pa1, o);
            attn_ew(s0, C, half, kt * 64, tq, need_mask, pb0, pb1);
            attn_pv(Vb, pb0, pb1, o);
        }
        if (kt > 0) { LAS unsigned char* nb = lds + (cur ^ 1) * AT_BUF;
#pragma unroll
            for (int i = 0; i < 2; ++i) { *(LAS u32x4*)(nb + kl[i]) = rk[i]; *(LAS u32x4*)(nb + vl[i]) = rv[i]; } }
        __syncthreads();
        cur ^= 1;
    }
    bf16_t* yp = YM + (tokbase + tq) * D + h * 128 + 4 * half;
#pragma unroll
    for (int d = 0; d < 4; ++d)
#pragma unroll
        for (int q4 = 0; q4 < 4; ++q4) { u32x2 w; w.x = pk_bf16(o[d][q4 * 4], o[d][q4 * 4 + 1]); w.y = pk_bf16(o[d][q4 * 4 + 2], o[d][q4 * 4 + 3]); *(u32x2*)(yp + d * 32 + q4 * 8) = w; }
}

struct LruP { const bf16_t* P; const bf16_t* WG; const float* conv_w; const float* conv_b; const float* b_r; const float* b_i; const float* lam; float* lsum; bf16_t* YM; bf16_t* YA; };
DI void lru_phase(LAS unsigned char* lds, const LruP& q, int bx, int G) {
    const int tid = threadIdx.x, lane = tid & 63, wave = __builtin_amdgcn_readfirstlane(tid >> 6);
    LAS float* xcf = (LAS float*)lds;
    LAS float* la = xcf + 64 * 129;
    LAS float* lu = la + 64 * 129;
    LAS float* sg = lu + 64 * 129;
    LAS unsigned char* xcb = (LAS unsigned char*)(sg + 2048);
    const int c = tid & 127, sgi = tid >> 7;
    const int fr = lane & 15, fq = lane >> 4;
    int n_loaded = -1;
    bf16x8 wbr[4], wbi[4]; float w0 = 0.f, w1 = 0.f, w2 = 0.f, w3 = 0.f, cb = 0.f, brv = 0.f, biv = 0.f, L = 0.f;
#pragma unroll
    for (int ks = 0; ks < 4; ++ks) { wbr[ks] = (bf16x8){0, 0, 0, 0, 0, 0, 0, 0}; wbi[ks] = wbr[ks]; }
    bf16_t xr[19];
    auto load_xr = [&](int it) { const int ck = it >> 3, n = it & 7, lc = ck & 63; const bf16_t* xp = q.P + ((size_t)ck * 64 + sgi * 16) * PW + 2048 + n * 128 + c;
        const bool has_prev = (lc * 64 + sgi * 16) > 0;
#pragma unroll
        for (int t = 0; t < 3; ++t) xr[t] = has_prev ? xp[(t - 3) * PW] : (bf16_t)0;
#pragma unroll
        for (int t = 0; t < 16; ++t) xr[3 + t] = xp[(size_t)t * PW]; };
    if (bx < 2048) load_xr(bx);
    for (int it = bx; it < 2048; it += G) {
        const int ck = it >> 3, n = it & 7; const size_t tok0 = (size_t)ck * 64; const int ch = n * 128 + c;
        if (n != n_loaded) {
            const bf16_t* wrp = q.WG + (size_t)(n * 128 + wave * 16 + fr) * 128 + fq * 8; const bf16_t* wip = wrp + 8 * 128 * 128;
#pragma unroll
            for (int ks = 0; ks < 4; ++ks) { wbr[ks] = *(const bf16x8*)(wrp + ks * 32); wbi[ks] = *(const bf16x8*)(wip + ks * 32); }
            w0 = q.conv_w[ch]; w1 = q.conv_w[1024 + ch]; w2 = q.conv_w[2048 + ch]; w3 = q.conv_w[3072 + ch]; cb = q.conv_b[ch];
            const int ch2 = n * 128 + wave * 16 + fr; brv = q.b_r[ch2]; biv = q.b_i[ch2]; L = -8.0f * log1pf(expf(-q.lam[ch2]));
            n_loaded = n; }
        bf16_t grv[16];
        { const bf16_t* gp = q.P + (tok0 + sgi * 16) * PW + 3072 + ch;
#pragma unroll
          for (int t = 0; t < 16; ++t) grv[t] = gp[(size_t)t * PW]; }
#pragma unroll
        for (int t = 0; t < 16; ++t) { const float y = w0 * bf_f(xr[t]) + w1 * bf_f(xr[t + 1]) + w2 * bf_f(xr[t + 2]) + w3 * bf_f(xr[t + 3]) + cb;
            xcf[(sgi * 16 + t) * 129 + c] = y; *(LAS bf16_t*)(xcb + (sgi * 16 + t) * 272 + c * 2) = to_bf16(y); }
        if (it + G < 2048) load_xr(it + G);
        __syncthreads();
        const int c2 = wave * 16 + fr;
        f32x4 ar[4], ai[4];
#pragma unroll
        for (int m = 0; m < 4; ++m) { ar[m] = (f32x4){0.f, 0.f, 0.f, 0.f}; ai[m] = (f32x4){0.f, 0.f, 0.f, 0.f}; }
#pragma unroll
        for (int ks = 0; ks < 4; ++ks)
#pragma unroll
            for (int m = 0; m < 4; ++m) { const bf16x8 av = *(const LAS bf16x8*)(xcb + (m * 16 + fr) * 272 + (ks * 32 + fq * 8) * 2);
                ar[m] = __builtin_amdgcn_mfma_f32_16x16x32_bf16(av, wbr[ks], ar[m], 0, 0, 0); ai[m] = __builtin_amdgcn_mfma_f32_16x16x32_bf16(av, wbi[ks], ai[m], 0, 0, 0); }
#pragma unroll
        for (int m = 0; m < 4; ++m)
#pragma unroll
            for (int j = 0; j < 4; ++j) { const int t = m * 16 + fq * 4 + j; const float r = sigmoidf_(ar[m][j] + brv), ig = sigmoidf_(ai[m][j] + biv);
                const float lga = r * L; const float av = fast_exp2(lga * LOG2E); const float x = 2.0f * lga;
                const float om = -x * (1.0f + x * 0.5f * (1.0f + x * (1.0f / 3.0f) * (1.0f + x * 0.25f * (1.0f + x * 0.2f * (1.0f + x * (1.0f / 6.0f))))));
                la[t * 129 + c2] = av; lu[t * 129 + c2] = sqrtf(om) * ig * xcf[t * 129 + c2]; }
        __syncthreads();
        float av_[16], uv_[16];
#pragma unroll
        for (int t = 0; t < 16; ++t) { av_[t] = la[(sgi * 16 + t) * 129 + c]; uv_[t] = lu[(sgi * 16 + t) * 129 + c]; }
        { float A = 1.0f, H = 0.f;
#pragma unroll
          for (int t = 0; t < 16; ++t) { H = av_[t] * H + uv_[t]; A *= av_[t]; }
          sg[sgi * 128 + c] = A; sg[512 + sgi * 128 + c] = H; }
        __syncthreads();
        float Ar = 1.0f, Hr = 0.f;
#pragma unroll
        for (int s2 = 0; s2 < 3; ++s2) { if (s2 < sgi) { const float as = sg[s2 * 128 + c], hs = sg[512 + s2 * 128 + c]; Hr = as * Hr + hs; Ar *= as; } }
        bf16_t* yl = q.YM + (tok0 + sgi * 16) * D + 1024 + ch;
        bf16_t* ya = q.YA + (tok0 + sgi * 16) * 1024 + ch;
#pragma unroll
        for (int t = 0; t < 16; ++t) { Hr = av_[t] * Hr + uv_[t]; Ar *= av_[t];
            const float g = bf_f(grv[t]); const float ge = g * sigmoidf_(1.5957691216057308f * (g + 0.044715f * g * g * g));
            yl[(size_t)t * D] = to_bf16(Hr * ge); ya[(size_t)t * 1024] = to_bf16(Ar * ge); }
        if (sgi == 3) *(f32x2v*)(q.lsum + ((size_t)ck * 1024 + ch) * 2) = (f32x2v){Ar, Hr};
        __syncthreads();
    }
}
DI void lru_fix(LAS unsigned char* lds, const LruP& q, int ck, int n) {
    const int tid = threadIdx.x; const int bq = ck >> 6, lc = ck & 63; const size_t tok0 = (size_t)ck * 64;
    LAS float* sg = (LAS float*)lds;
    const int c = tid & 127, sgi = tid >> 7, ch = n * 128 + c;
    if (lc == 0) return;
    bf16_t* yl = q.YM + (tok0 + sgi * 16) * D + 1024 + ch;
    const bf16_t* ya = q.YA + (tok0 + sgi * 16) * 1024 + ch;
    bf16_t l[16], a[16];
#pragma unroll
    for (int t = 0; t < 16; ++t) { l[t] = yl[(size_t)t * D]; a[t] = ya[(size_t)t * 1024]; }
    const float* sp = q.lsum + ((size_t)(bq * 64 + sgi * 16) * 1024 + ch) * 2;
    f32x2v sv[16];
#pragma unroll
    for (int j = 0; j < 16; ++j) sv[j] = *(const f32x2v*)(sp + (size_t)j * 2048);
    float cA = 1.0f, cH = 0.f;
#pragma unroll
    for (int j = 0; j < 16; ++j) { const bool ok = (sgi * 16 + j) < lc; const float aj = ok ? sv[j][0] : 1.0f, hj = ok ? sv[j][1] : 0.f; cH = aj * cH + hj; cA *= aj; }
    sg[sgi * 128 + c] = cA; sg[512 + sgi * 128 + c] = cH;
    __syncthreads();
    float hc = 0.f;
#pragma unroll
    for (int s2 = 0; s2 < 4; ++s2) hc = sg[s2 * 128 + c] * hc + sg[512 + s2 * 128 + c];
#pragma unroll
    for (int t = 0; t < 16; ++t) yl[(size_t)t * D] = to_bf16(bf_f(l[t]) + bf_f(a[t]) * hc);
    __syncthreads();
}

constexpr int NPH = 14;
__global__ void __launch_bounds__(512, 2) fwd(Args a) {
    extern __shared__ __attribute__((aligned(16))) unsigned char lds_raw[];
    LAS unsigned char* lds = (LAS unsigned char*)lds_raw;
    cg::grid_group grid = cg::this_grid();
    const int lo = a.ph_lo, hi = a.ph_hi, G = gridDim.x, bx = blockIdx.x;
    unsigned char* ws = a.ws;
    float* mod = (float*)(ws + WS_MOD); float* lsum = (float*)(ws + WS_LSUM);
    bf16_t* W1IN = (bf16_t*)(ws + WS_W1IN); bf16_t* W1OUT = (bf16_t*)(ws + WS_W1OUT); bf16_t* W2IN = (bf16_t*)(ws + WS_W2IN); bf16_t* W2OUT = (bf16_t*)(ws + WS_W2OUT);
    bf16_t* WINM = (bf16_t*)(ws + WS_WINM); bf16_t* WV = (bf16_t*)(ws + WS_WV); bf16_t* WBR = (bf16_t*)(ws + WS_WBR); bf16_t* WO = (bf16_t*)(ws + WS_WO); bf16_t* WG = (bf16_t*)(ws + WS_WG);
    bf16_t* Y = (bf16_t*)(ws + WS_Y); bf16_t* P = (bf16_t*)(ws + WS_P); bf16_t* Hb = P; bf16_t* VT = (bf16_t*)(ws + WS_VT); bf16_t* YM = (bf16_t*)(ws + WS_YM); bf16_t* MG = Y;
    float* out = a.out;
    bf16_t* h1b = (bf16_t*)a.out; bf16_t* h2b = (bf16_t*)(ws + WS_P) + (size_t)T * DFF;
    float* ss1 = (float*)(ws + WS_SS); float* ss2 = ss1 + T; float* shw_in = (float*)(ws + WS_SHW); float* shw_f2 = shw_in + 4 * 9216; float* ss3 = (float*)(ws + WS_SS3); unsigned* cnt3 = (unsigned*)(ws + WS_CNT3);
#ifndef PHASE_MASK
#define PHASE_MASK 0x3fff
#endif
#define IN(k) (((PHASE_MASK >> (k)) & 1) && lo <= (k) && (k) < hi)
#ifndef DUPMASK
#define DUPMASK 0
#endif
#ifndef DUPCNT
#define DUPCNT 1
#endif
#define REP(k) for (int rep_ = 0; rep_ < 1 + DUPCNT * ((DUPMASK >> (k)) & 1); ++rep_)
#define SEAM(k) do { if (IN(k) && IN((k) + 1)) xcd_barrier(xbar); } while (0)
    if (threadIdx.x < 4) ((LAS unsigned*)(lds + LDS_MAIN))[threadIdx.x] = 0u;
    __syncthreads();
    XcdBarrier xbar; xbar.bar = (unsigned*)(ws + WS_BAR); xbar.x = 0; xbar.st = (volatile LAS unsigned*)(lds + LDS_MAIN);
    if (hi - lo > 1) xbar = xcd_barrier_post((unsigned*)(ws + WS_BAR), (volatile LAS unsigned*)(lds + LDS_MAIN));
    if (hi > 1000) grid.sync();
    using namespace pg8;
    if (IN(0)) REP(0) {
        for (int i = bx * 512 + (int)threadIdx.x; i < 2 * T; i += G * 512) ss1[i] = 0.f;
        for (int i = bx * 512 + (int)threadIdx.x; i < T + 64 * 64; i += G * 512) ss3[i] = 0.f;
        mod_items((LAS float*)lds, a.in[I_C], a.in[I_WADA], a.in[I_BADA], mod);
        LAS float* buf = (LAS float*)lds; int rot = 0;
        conv_job(buf, rot, a.in[I_W1IN], 2 * DFF, D, 2 * DFF, W1IN, D, 0, 1);
        conv_job(buf, rot, a.in[I_W1OUT], D, DFF, D, W1OUT, DFF, 0, 0);
        conv_job(buf, rot, a.in[I_WIN], 9216, D, 8192, WINM, D, 0, 2);
        conv_job(buf, rot, a.in[I_WIN], 9216, D, 1024, WV, D, 0, 3);
        conv_job(buf, rot, a.in[I_WBA], D, 1024, D, WBR, D, 0, 0);
        conv_job(buf, rot, a.in[I_WBL], D, 1024, D, WBR, D, 1024, 0);
        conv_job(buf, rot, a.in[I_WOUT], D, D, D, WO, D, 0, 0);
        conv_job(buf, rot, a.in[I_WRG], 128, 128, 1024, WG, 128, 0, 4);
        conv_job(buf, rot, a.in[I_WIG], 128, 128, 1024, WG + 8 * 128 * 128, 128, 0, 4);
        conv_job(buf, rot, a.in[I_W2IN], 2 * DFF, D, 2 * DFF, W2IN, D, 0, 1);
        conv_job(buf, rot, a.in[I_W2OUT], D, DFF, D, W2OUT, DFF, 0, 0);
    }
    SEAM(0);
#ifdef EXTRA_SYNCS
    for (int es = 0; es < EXTRA_SYNCS; ++es) xcd_barrier(xbar);
#endif
    if (IN(1)) REP(1) { norm_phase<false>(a.in[I_X], a.in[I_N1], mod, 0, Y, nullptr);
        shw_rows((LAS float*)lds, WINM, 8192, mod, 3, shw_in, 9216, 0); shw_rows((LAS float*)lds, WV, 1024, mod, 3, shw_in, 9216, 8192); }
    SEAM(1);
    if (IN(2) && ((DUPMASK >> 2) & 1)) { Gemm g{Y, W1IN, T, 2 * DFF, D}; StaticOrder S; S.init(T, 2 * DFF, G, bx); EpiSwiGLU E{Hb}; gemm_phase<EpiSwiGLU, StaticOrder, true, true>(lds, g, S, E); }
#ifdef CLKPROBE
    long long cp_c0 = 0, cp_r0 = 0, cp_c1 = 0, cp_r1 = 0;
    if (bx == 0 && threadIdx.x == 0) { cp_c0 = clock64(); cp_r0 = wall_clock64(); }
#endif
    if (IN(2)) { Gemm g{Y, W1IN, T, 2 * DFF, D}; StaticOrder S; S.init(T, 2 * DFF, G, bx); EpiSwiGLU E{Hb}; gemm_phase<EpiSwiGLU, StaticOrder, true, true>(lds, g, S, E); }
#ifdef CLKPROBE
    if (bx == 0 && threadIdx.x == 0) { cp_c1 = clock64(); cp_r1 = wall_clock64(); }
#endif
    SEAM(2);
    if (IN(3)) { Gemm g{Hb, W1OUT, T, D, DFF, 0}; StaticOrder S; S.init(T, D, G, bx, 4); EpiResidN E{a.in[I_X], nullptr, h1b, mod + 2 * D, Y, a.in[I_NMIX], mod + 4 * D, ss1, 0.5f, 0}; gemm_phase<EpiResidN, StaticOrder, true, true>(lds, g, S, E); }
    SEAM(3);
    if (IN(5)) {
        { Gemm g{Y, WINM, T, 8192, D}; StaticOrder S; S.init(T, 8192, G, bx); EpiPN E{P, PW, 4, QSCALE, ss1, shw_in, 9216}; gemm_phase<EpiPN, StaticOrder, true, true>(lds, g, S, E); }
        { Gemm g{WV, Y, 1024, T, D}; StaticOrder S; S.init(1024, T, G, bx); EpiVTN E{VT, ss1, shw_in + 8192}; gemm_phase<EpiVTN, StaticOrder, true, true>(lds, g, S, E); }
    }
    SEAM(5);
    LruP lq{P, WG, a.in[I_CONVW], a.in[I_CONVB], a.in[I_BRG], a.in[I_BIG], a.in[I_LAM], lsum, YM, Y};
    if (IN(6)) {
        REP(6) for (int p0 = bx; p0 < 256; p0 += G) { const int p = (G == 256) ? ((p0 & 7) * 32 + (p0 >> 3)) : p0;
            const int bh = p >> 3, jp = p & 7; attn_item(lds, P, VT, YM, bh >> 3, bh & 7, 15 - jp); attn_item(lds, P, VT, YM, bh >> 3, bh & 7, jp); }
        REP(14) lru_phase(lds, lq, bx, G);
    }
    SEAM(6);
    if (IN(7)) { for (int it = bx; it < 2048; it += G) lru_fix(lds, lq, it >> 3, it & 7); shw_rows((LAS float*)lds, W2IN, 2 * DFF, mod, 6, shw_f2, 2 * DFF, 0); }
    SEAM(7);
    if (IN(8)) { Gemm g{YM, WBR, T, D, D}; StaticOrder S; S.init(T, D, G, bx, 4); EpiBranch E{P, MG}; gemm_phase<EpiBranch, StaticOrder, true, true>(lds, g, S, E); }
    SEAM(8);
    if (IN(9)) { Gemm g{MG, WO, T, D, D}; StaticOrder S; S.init(T, D, G, bx, 4); EpiResidN E{nullptr, h1b, h2b, mod + 5 * D, YM, a.in[I_N2], mod + 7 * D, ss2, 1.0f, 0}; gemm_phase<EpiResidN, StaticOrder, true, true>(lds, g, S, E); }
    SEAM(9);
    if (IN(11)) { Gemm g{YM, W2IN, T, 2 * DFF, D}; StaticOrder S; S.init(T, 2 * DFF, G, bx); EpiSwiGLUN E{Hb, ss2, shw_f2}; gemm_phase<EpiSwiGLUN, StaticOrder, true, true>(lds, g, S, E); }
    SEAM(11);
    if (G == 256) {
        if (IN(12)) { Gemm g{Hb, W2OUT, T, D, DFF, 0}; StaticOrder S; S.init(T, D, G, bx, 4); EpiFinal E{h2b, out, mod + 8 * D, a.in[I_NF], ss3, cnt3, 0.5f, 0}; gemm_phase<EpiFinal, StaticOrder, true, true>(lds, g, S, E); }
    } else {
        if (IN(12)) { Gemm g{Hb, W2OUT, T, D, DFF, 0}; StaticOrder S; S.init(T, D, G, bx, 4); EpiResid E{nullptr, out, mod + 8 * D, h2b, 0.5f, 0}; gemm_phase<EpiResid, StaticOrder, true, true>(lds, g, S, E); }
        SEAM(12);
        if (IN(13)) norm_phase<true>(out, a.in[I_NF], mod, 0, nullptr, out);
    }
#ifdef CLKPROBE
    if (bx == 0 && threadIdx.x == 0) {
        const long long us = (cp_r1 - cp_r0) / 100; const long long mhz = us > 0 ? (cp_c1 - cp_c0) / us : 0;
        const long long st = wall_clock64(); while (wall_clock64() - st < mhz * 100) __builtin_amdgcn_s_sleep(8); }
#endif
}

#ifndef ONE_LAUNCH
#define ONE_LAUNCH 1
#endif
extern "C" void kernel_launch(void* const* d_in, const int* in_sizes, int n_in, void* d_out, int out_size, void* d_ws, size_t ws_size, hipStream_t stream) {
    static int grid = 0;
    if (grid == 0) {
        if (n_in != 23 || out_size != T * D || ws_size < WS_END) { fprintf(stderr, "kernel_launch: unexpected shapes (n_in %d out %d ws %zu need %zu)\n", n_in, out_size, ws_size, (size_t)WS_END); grid = -1; return; }
        int dev = 0, cus = 0, per_cu = 0;
        hipGetDevice(&dev); hipDeviceGetAttribute(&cus, hipDeviceAttributeMultiprocessorCount, dev);
        if (hipFuncSetAttribute((const void*)fwd, hipFuncAttributeMaxDynamicSharedMemorySize, LDS_BYTES) != hipSuccess) { fprintf(stderr, "kernel_launch: hipFuncSetAttribute failed\n"); grid = -1; return; }
        if (hipOccupancyMaxActiveBlocksPerMultiprocessor(&per_cu, (const void*)fwd, 512, LDS_BYTES) != hipSuccess || per_cu < 1) { fprintf(stderr, "kernel_launch: occupancy query says %d\n", per_cu); per_cu = 1; }
        (void)hipGetLastError();
        grid = cus * per_cu;
        if (grid > 256) grid = 256;
    }
    if (grid < 0) return;
    Args a{};
    for (int i = 0; i < 23; ++i) a.in[i] = (const float*)d_in[i];
    a.out = (float*)d_out; a.ws = (unsigned char*)d_ws;
#if ONE_LAUNCH
    if (hipMemsetAsync((char*)d_ws + WS_BAR, 0, 16384, stream) != hipSuccess) { fprintf(stderr, "kernel_launch: memset of the barrier words failed\n"); return; }
    a.ph_lo = 0; a.ph_hi = NPH;
    void* args[] = {&a};
    hipError_t e = hipLaunchCooperativeKernel((const void*)fwd, dim3(grid), dim3(512), args, LDS_BYTES, stream);
    if (e != hipSuccess) fprintf(stderr, "cooperative launch failed: %s (grid %d)\n", hipGetErrorString(e), grid);
#else
    for (int ph = 0; ph < NPH; ++ph) { a.ph_lo = ph; a.ph_hi = ph + 1; hipLaunchKernelGGL(fwd, dim3(grid), dim3(512), LDS_BYTES, stream, a); }
#endif
}
```
